# Optimizing an MI355X kernel written in HIP

```python
import jax, jax.numpy as jnp
from jax import lax
import numpy as np

D_MODEL = 1024
BATCH = 8
SEQ = 2048
DEPTH = 1
DEC_BATCH = 32
DEC_SEQ = 4
PAST_LEN = 8192
PAGE_SIZE = 128

N_MEM = 256
MEM_HEADS = 4
MEM_HD = 128
RET_HEADS = 4
RET_DK = 64
RET_DV = 128
RET_CHUNK = 128
SWA_HEADS = 8
SWA_HD = 64
SWA_PATTERNS = ((128, 1), (512, 4), (2048, 16))
SWA_SPAN = 2048
SWA_BLOCK = 128
ROPE_THETA = 10000.0
LN_EPS = 1e-5
GN_EPS = 1e-5
RET_W = RET_HEADS * RET_DV
SWA_W = SWA_HEADS * SWA_HD
MEM_W = MEM_HEADS * MEM_HD
D_MIX = RET_W + SWA_W + MEM_W
IN_SPLITS = (RET_HEADS * RET_DK, RET_HEADS * RET_DK, RET_W, RET_W, SWA_W, SWA_W, SWA_W, SWA_W, MEM_W, MEM_W)
D_IN = sum(IN_SPLITS)
DEEPNORM_ALPHA = (2.0 * DEPTH) ** 0.25
DEEPNORM_BETA = (8.0 * DEPTH) ** -0.25

kernel_name = "hymba_retention_dilated_swa_memory_deepnorm_step"

F32 = jnp.float32


def _rope(x, pos):
    d = x.shape[-1]
    half = d // 2
    inv = ROPE_THETA ** (-jnp.arange(half, dtype=F32) * 2.0 / d)
    ang = pos.astype(F32)[:, None] * inv[None, :]
    cos = jnp.cos(ang)[:, None, :]
    sin = jnp.sin(ang)[:, None, :]
    x32 = x.astype(F32)
    x1, x2 = x32[..., :half], x32[..., half:]
    return jnp.concatenate([x1 * cos - x2 * sin, x2 * cos + x1 * sin], axis=-1).astype(x.dtype)


def _layernorm(z, g, b):
    z32 = z.astype(F32)
    mu = z32.mean(-1, keepdims=True)
    var = jnp.square(z32 - mu).mean(-1, keepdims=True)
    return (z32 - mu) * lax.rsqrt(var + LN_EPS) * g.astype(F32) + b.astype(F32)


def _head_norm(o):
    mu = o.mean(-1, keepdims=True)
    var = jnp.square(o - mu).mean(-1, keepdims=True)
    return (o - mu) * lax.rsqrt(var + GN_EPS)


def _project(x, w_in, pos):
    B, T, _ = x.shape
    h = jnp.einsum('btd,de->bte', x, w_in)
    offsets = np.cumsum(IN_SPLITS)[:-1].tolist()
    rq, rk, rv, rg, sq, sk, sv, sg, mq, mg = jnp.split(h, offsets, axis=-1)
    rq = _rope(rq.reshape(B, T, RET_HEADS, RET_DK), pos)
    rk = _rope(rk.reshape(B, T, RET_HEADS, RET_DK), pos) * (RET_DK ** -0.5)
    rv = rv.reshape(B, T, RET_HEADS, RET_DV)
    sq = _rope(sq.reshape(B, T, SWA_HEADS, SWA_HD), pos)
    sk = _rope(sk.reshape(B, T, SWA_HEADS, SWA_HD), pos)
    sv = sv.reshape(B, T, SWA_HEADS, SWA_HD)
    mq = mq.reshape(B, T, MEM_HEADS, MEM_HD)
    return (rq, rk, rv, sq, sk, sv, mq), (rg, sg, mg)


def _retention(q, k, v, state0, chunk):
    B, T, H, dk = q.shape
    dv = v.shape[-1]
    n = T // chunk
    lg = jnp.log1p(-jnp.exp2(-5.0 - jnp.arange(H, dtype=F32)))
    idx = jnp.arange(chunk, dtype=F32)
    rel = idx[:, None] - idx[None, :]
    dmat = jnp.where(rel >= 0, jnp.exp(jnp.maximum(rel, 0.0)[None] * lg[:, None, None]), 0.0)
    qc = q.astype(F32).reshape(B, n, chunk, H, dk)
    kc = k.astype(F32).reshape(B, n, chunk, H, dk)
    vc = v.astype(F32).reshape(B, n, chunk, H, dv)
    s = jnp.einsum('bnihk,bnjhk->bnhij', qc, kc) * dmat
    intra = jnp.einsum('bnhij,bnjhv->bnihv', s, vc)
    k_dec = kc * jnp.exp((chunk - 1.0 - idx)[:, None] * lg[None, :])[..., None]
    kv = jnp.einsum('bnjhk,bnjhv->nbhkv', k_dec, vc)
    g_chunk = jnp.exp(chunk * lg)[:, None, None]

    def step(r, kv_c):
        return g_chunk * r + kv_c, r

    r_fin, r_prev = lax.scan(step, state0, kv)
    q_dec = qc * jnp.exp((idx + 1.0)[:, None] * lg[None, :])[..., None]
    cross = jnp.einsum('bnihk,nbhkv->bnihv', q_dec, r_prev)
    return (intra + cross).reshape(B, T, H, dv), r_fin


def _dilated_prompt(q, k, v, dil, steps):
    B, S, H, D = q.shape
    L = S // dil
    nblk = -(-L // SWA_BLOCK)
    Lp = nblk * SWA_BLOCK

    def to_res(a):
        a = a.reshape(B, L, dil, H, D).transpose(0, 2, 1, 3, 4).reshape(B * dil, L, H, D)
        return jnp.pad(a, ((0, 0), (0, Lp - L), (0, 0), (0, 0)))

    bd = B * dil
    qb = to_res(q).reshape(bd, nblk, SWA_BLOCK, H, D)
    kb = to_res(k).reshape(bd, nblk, SWA_BLOCK, H, D)
    vb = to_res(v).reshape(bd, nblk, SWA_BLOCK, H, D)

    def with_prev(a):
        prev = jnp.concatenate([jnp.zeros_like(a[:, :1]), a[:, :-1]], axis=1)
        return jnp.concatenate([prev, a], axis=2)

    kk, vv = with_prev(kb), with_prev(vb)
    s = jnp.einsum('bnqhd,bnkhd->bnhqk', qb, kk).astype(F32) * (D ** -0.5)
    qi = jnp.arange(SWA_BLOCK)[:, None] + SWA_BLOCK
    kj = jnp.arange(2 * SWA_BLOCK)[None, :]
    rel = qi - kj
    band = (rel >= 0) & (rel <= steps)
    first = (jnp.arange(nblk)[:, None, None] > 0) | (kj >= SWA_BLOCK)[None]
    mask = band[None] & first
    s = jnp.where(mask[None, :, None], s, -jnp.inf)
    m = s.max(-1)
    p = jnp.exp(s - m[..., None])
    l = p.sum(-1)
    m_t = jnp.swapaxes(m, -1, -2)
    l_t = jnp.swapaxes(l, -1, -2)
    o = jnp.einsum('bnhqk,bnkhd->bnqhd', p, vv.astype(F32)) / l_t[..., None]

    def back(a):
        a = a.reshape(B, dil, Lp, *a.shape[3:])[:, :, :L]
        a = jnp.moveaxis(a, 1, 2)
        return a.reshape(B, S, *a.shape[3:])

    return back(o), back(m_t), back(l_t)


def _dilated_sample(q, keys, vals, wb, dil, steps):
    D = q.shape[-1]
    T = q.shape[1]
    idx = wb + jnp.arange(T)[:, None] - dil * jnp.arange(steps + 1)[None, :]
    valid = idx >= 0
    idx_c = jnp.maximum(idx, 0)
    kg = keys[:, idx_c]
    vg = vals[:, idx_c]
    s = jnp.einsum('bthd,btnhd->bthn', q, kg).astype(F32) * (D ** -0.5)
    s = jnp.where(valid[None, :, None, :], s, -jnp.inf)
    m = s.max(-1)
    p = jnp.exp(s - m[..., None])
    l = p.sum(-1)
    o = jnp.einsum('bthn,btnhd->bthd', p, vg.astype(F32)) / l[..., None]
    return o, m, l


def _combine(parts):
    ms = jnp.stack([p[1] for p in parts])
    ls = jnp.stack([p[2] for p in parts])
    os_ = jnp.stack([p[0] for p in parts])
    w = ls * jnp.exp(ms - ms.max(0))
    return (w[..., None] * os_).sum(0) / w.sum(0)[..., None]


def _mem_attn(q, k, v):
    s = jnp.einsum('bthd,bmhd->bhtm', q, k).astype(F32) * (MEM_HD ** -0.5)
    p = jax.nn.softmax(s, axis=-1)
    return jnp.einsum('bhtm,bmhd->bthd', p, v.astype(F32))


def _finish(x, ret_o, swa_o, mem_o, gates, w_out, g, b):
    B, T, _ = x.shape
    rg, sg, mg = gates
    silu = lambda a: jax.nn.silu(a.astype(F32))
    mix = jnp.concatenate([
        silu(rg) * _head_norm(ret_o).reshape(B, T, RET_W),
        silu(sg) * swa_o.reshape(B, T, SWA_W),
        silu(mg) * mem_o.reshape(B, T, MEM_W)], axis=-1).astype(x.dtype)
    h = jnp.einsum('bte,ed->btd', mix, w_out)
    return _layernorm(DEEPNORM_ALPHA * x + h, g, b).astype(x.dtype)


def _prompt_layer(x, mem, w_in, w_mem_kv, w_out, g, b):
    B, S, _ = x.shape
    pos = jnp.arange(S)
    (rq, rk, rv, sq, sk, sv, mq), gates = _project(x, w_in, pos)
    state0 = jnp.zeros((B, RET_HEADS, RET_DK, RET_DV), F32)
    ret_o, ret_state = _retention(rq, rk, rv, state0, min(RET_CHUNK, S))
    swa_o = _combine([_dilated_prompt(sq, sk, sv, d, w // d) for (w, d) in SWA_PATTERNS])
    mkv = jnp.einsum('bmd,de->bme', mem, w_mem_kv)
    mk, mv = jnp.split(mkv, 2, axis=-1)
    mk = mk.reshape(B, mem.shape[1], MEM_HEADS, MEM_HD)
    mv = mv.reshape(B, mem.shape[1], MEM_HEADS, MEM_HD)
    mem_o = _mem_attn(mq, mk, mv)
    y = _finish(x, ret_o, swa_o, mem_o, gates, w_out, g, b)
    wb = min(SWA_SPAN, S)
    return y, ret_state.astype(x.dtype), sk[:, S - wb:], sv[:, S - wb:], mk, mv


def _sample_layer(x, state_ret, ck, cv, mk, mv, w_in, w_out, g, b):
    B, T, _ = x.shape
    wb = ck.shape[1]
    pos = PAST_LEN + jnp.arange(T)
    (rq, rk, rv, sq, sk, sv, mq), gates = _project(x, w_in, pos)
    ret_o, ret_state = _retention(rq, rk, rv, state_ret.astype(F32), T)
    keys = jnp.concatenate([ck, sk.astype(ck.dtype)], axis=1)
    vals = jnp.concatenate([cv, sv.astype(cv.dtype)], axis=1)
    swa_o = _combine([_dilated_sample(sq, keys, vals, wb, d, w // d) for (w, d) in SWA_PATTERNS])
    mem_o = _mem_attn(mq, mk, mv)
    y = _finish(x, ret_o, swa_o, mem_o, gates, w_out, g, b)
    return y, ret_state.astype(state_ret.dtype), sk, sv


def setup_inputs(seed: int = 0) -> dict:
    key = jax.random.key(seed)
    ks = jax.random.split(key, 13)
    wb = min(SWA_SPAN, PAST_LEN)
    nrm = jax.random.normal
    in_gains = (1.0, 1.0, DEEPNORM_BETA, 1.0, 1.0, 1.0, DEEPNORM_BETA, 1.0, 1.0, 1.0)
    col_scale = jnp.concatenate([jnp.full((w,), s, F32) for w, s in zip(IN_SPLITS, in_gains)])
    mem_scale = jnp.concatenate([jnp.ones((MEM_W,), F32), jnp.full((MEM_W,), DEEPNORM_BETA, F32)])
    return {
        'x_prompt': nrm(ks[0], (BATCH, SEQ, D_MODEL), F32),
        'x_sample': nrm(ks[1], (DEC_BATCH, DEC_SEQ, D_MODEL), F32),
        'state_ret': nrm(ks[2], (DEPTH, DEC_BATCH, RET_HEADS, RET_DK, RET_DV), F32),
        'cache_swa_k': nrm(ks[3], (DEPTH, DEC_BATCH, wb, SWA_HEADS, SWA_HD), F32),
        'cache_swa_v': nrm(ks[4], (DEPTH, DEC_BATCH, wb, SWA_HEADS, SWA_HD), F32),
        'cache_mem_k': nrm(ks[5], (DEPTH, DEC_BATCH, N_MEM, MEM_HEADS, MEM_HD), F32),
        'cache_mem_v': nrm(ks[6], (DEPTH, DEC_BATCH, N_MEM, MEM_HEADS, MEM_HD), F32),
        'mem_prompt': nrm(ks[7], (BATCH, N_MEM, D_MODEL), F32),
        'w_in': nrm(ks[8], (DEPTH, D_MODEL, D_IN), F32) * (D_MODEL ** -0.5) * col_scale,
        'w_mem_kv': nrm(ks[9], (DEPTH, D_MODEL, 2 * MEM_W), F32) * (D_MODEL ** -0.5) * mem_scale,
        'w_out': nrm(ks[10], (DEPTH, D_MIX, D_MODEL), F32) * (D_MIX ** -0.5) * DEEPNORM_BETA,
        'ln_gain': 1.0 + 0.02 * nrm(ks[11], (DEPTH, D_MODEL), F32),
        'ln_bias': 0.02 * nrm(ks[12], (DEPTH, D_MODEL), F32),
    }


def reference(x_prompt, x_sample, state_ret, cache_swa_k, cache_swa_v, cache_mem_k, cache_mem_v,
              mem_prompt, w_in, w_mem_kv, w_out, ln_gain, ln_bias):
    yp, ys = x_prompt, x_sample
    rp_l, rs_l, kp_l, vp_l, ks_l, vs_l, mkp_l, mvp_l = [], [], [], [], [], [], [], []
    for layer in range(DEPTH):
        yp, rp, kp, vp, mkp, mvp = _prompt_layer(yp, mem_prompt, w_in[layer], w_mem_kv[layer],
                                                 w_out[layer], ln_gain[layer], ln_bias[layer])
        ys, rs, ksn, vsn = _sample_layer(ys, state_ret[layer], cache_swa_k[layer], cache_swa_v[layer],
                                         cache_mem_k[layer], cache_mem_v[layer], w_in[layer],
                                         w_out[layer], ln_gain[layer], ln_bias[layer])
        rp_l.append(rp); rs_l.append(rs); kp_l.append(kp); vp_l.append(vp)
        ks_l.append(ksn); vs_l.append(vsn); mkp_l.append(mkp); mvp_l.append(mvp)
    return (yp, ys, jnp.stack(rp_l), jnp.stack(rs_l), jnp.stack(kp_l), jnp.stack(vp_l),
            jnp.stack(ks_l), jnp.stack(vs_l), jnp.stack(mkp_l), jnp.stack(mvp_l))
```

```cpp
#include <hip/hip_runtime.h>
#include <hip/hip_cooperative_groups.h>
#include <cstdio>
#include <cstdint>
namespace cg = cooperative_groups;

#define LAS __attribute__((address_space(3)))
typedef unsigned short bf16_t;
typedef short bf16x8 __attribute__((ext_vector_type(8)));
typedef float f32x4 __attribute__((ext_vector_type(4)));
typedef float f32x2 __attribute__((ext_vector_type(2)));
typedef unsigned u32x4 __attribute__((ext_vector_type(4)));
typedef unsigned u32x2 __attribute__((ext_vector_type(2)));
typedef __bf16 bf16x2_t __attribute__((ext_vector_type(2)));

constexpr int DM = 1024, NB = 8, SEQ = 2048, DECB = 32, DECT = 4;
constexpr int NMEM = 256, DIN = 4608, DMIX = 1536;
constexpr int M_PROMPT = NB * SEQ;
constexpr int M_SAMPLE = DECB * DECT;
constexpr int ROWS_IN = M_PROMPT + 256;
constexpr int ROWS_ALL = ROWS_IN + NB * NMEM;
constexpr int HP = DIN;
constexpr int C_RQ = 0, C_RK = 256, C_RV = 512, C_RG = 1024, C_SQ = 1536, C_SK = 2048, C_SV = 2560, C_SG = 3072, C_MQ = 3584, C_MG = 4096;
constexpr size_t O_YP = 0, O_YS = 16777216, O_RP = 16908288, O_RS = 17170432, O_KP = 18219008, O_VP = 26607616,
                 O_KS = 34996224, O_VS = 35061760, O_MK = 35127296, O_MV = 36175872;
constexpr size_t MiB = 1u << 20;
constexpr size_t WS_CTL = 0, WS_ROPE = 1 * MiB, WS_WTIN = 2 * MiB, WS_WTMKV = 12 * MiB, WS_WTOUT = 14 * MiB,
                 WS_XB = 20 * MiB, WS_HB = 64 * MiB, WS_MKV = 212 * MiB, WS_MIX = 216 * MiB, WS_END = 268 * MiB;
constexpr int LDS_BYTES = 135168;
constexpr float LOG2E = 1.4426950408889634f;
constexpr float SQ_SCALE = 0.18033688011112042f;
constexpr float MQ_SCALE = 0.12751743082459868f;
constexpr float ALPHA = 1.189207115002721f;

struct Params {
    const float *x_prompt, *x_sample, *state_ret, *cache_k, *cache_v, *cmem_k, *cmem_v, *mem_prompt, *w_in, *w_mkv, *w_out, *ln_g, *ln_b;
    float* out;
    unsigned char* ws;
};

__device__ __forceinline__ unsigned pk_bf16(float lo, float hi) { f32x2 v = {lo, hi}; bf16x2_t b = __builtin_convertvector(v, bf16x2_t); return __builtin_bit_cast(unsigned, b); }
__device__ __forceinline__ float bf_lo(unsigned u) { return __uint_as_float(u << 16); }
__device__ __forceinline__ float bf_hi(unsigned u) { return __uint_as_float(u & 0xffff0000u); }
__device__ __forceinline__ float bf2f(bf16_t h) { return __uint_as_float(((unsigned)h) << 16); }
__device__ __forceinline__ float fexp2(float x) { return __builtin_amdgcn_exp2f(x); }
__device__ __forceinline__ float frcp(float x) { return __builtin_amdgcn_rcpf(x); }
__device__ __forceinline__ float silu(float x) { return x * frcp(1.0f + fexp2(-x * LOG2E)); }
__device__ __forceinline__ float wave_max(float v) {
#pragma unroll
    for (int o = 1; o < 64; o <<= 1) v = fmaxf(v, __shfl_xor(v, o));
    return v;
}
__device__ __forceinline__ float wave_sum(float v) {
#pragma unroll
    for (int o = 1; o < 64; o <<= 1) v += __shfl_xor(v, o);
    return v;
}
#define LDS_WAIT() asm volatile("s_waitcnt lgkmcnt(0)" ::: "memory")
__device__ __forceinline__ int perm32(int rho) { const int n = rho >> 4, i = rho & 15; return 8 * (i >> 2) + 4 * n + (i & 3); }
__device__ __forceinline__ int dmap(int p) { return 16 * (p >> 5) + 32 * ((p >> 2) & 1) + 4 * ((p >> 3) & 3) + (p & 3); }
__device__ __forceinline__ int src_col_in(int c) {
    const int rho = c & 31;
    const bool rope = (c < 512) || (c >= 1536 && c < 2560);
    if (rope) return (c & ~63) + 16 * ((c >> 5) & 1) + 32 * (rho >> 4) + (rho & 15);
    return (c & ~31) + perm32(rho);
}

__device__ __forceinline__ void transpose_item(const float* W, int K, int N, bf16_t* WT, int mode, LAS float* scr, int item, int lane) {
    const int nblk = N / 32, kb = item / nblk, nb = item % nblk, k0 = 64 * kb, n0 = 32 * nb;
    const int cl = lane & 31;
    const int sc = (mode == 0) ? (n0 + cl) : (mode == 1) ? (n0 + perm32(cl)) : src_col_in(n0 + cl);
#pragma unroll 8
    for (int i = 0; i < 32; ++i) { const int kk = 2 * i + (lane >> 5); scr[kk * 33 + cl] = W[(size_t)(k0 + kk) * N + sc]; }
    LDS_WAIT();
    const int c = lane & 7;
#pragma unroll
    for (int j = 0; j < 4; ++j) {
        const int n = (lane >> 3) + 8 * j; const LAS float* s = scr + (8 * c) * 33 + n;
        u32x4 o; o.x = pk_bf16(s[0 * 33], s[1 * 33]); o.y = pk_bf16(s[2 * 33], s[3 * 33]); o.z = pk_bf16(s[4 * 33], s[5 * 33]); o.w = pk_bf16(s[6 * 33], s[7 * 33]);
        *(u32x4*)(WT + (size_t)(n0 + n) * K + k0 + 8 * c) = o;
    }
    LDS_WAIT();
}
__device__ __forceinline__ void sincos_d(double a, float& s, float& c) {
    const double kd = __builtin_rint(a * 0.63661977236758134308);
    double y = __builtin_fma(-kd, 1.57079632679489655800e+00, a); y = __builtin_fma(-kd, 6.12323399573676603587e-17, y);
    const double y2 = y * y;
    const double sp = y * (1.0 + y2 * (-1.0 / 6 + y2 * (1.0 / 120 + y2 * (-1.0 / 5040 + y2 * (1.0 / 362880 + y2 * (-1.0 / 39916800 + y2 * (1.0 / 6227020800.0)))))));
    const double cp = 1.0 + y2 * (-0.5 + y2 * (1.0 / 24 + y2 * (-1.0 / 720 + y2 * (1.0 / 40320 + y2 * (-1.0 / 3628800 + y2 * (1.0 / 479001600.0))))));
    const int k = ((int)kd) & 3;
    const double sv = (k == 0) ? sp : (k == 1) ? cp : (k == 2) ? -sp : -cp;
    const double cv = (k == 0) ? cp : (k == 1) ? -sp : (k == 2) ? -cp : sp;
    s = (float)sv; c = (float)cv;
}
__device__ __forceinline__ void phase0(const Params& P, LAS unsigned char* lds, int tid, int lane, int wave) {
    unsigned char* ws = P.ws;
    const int gw = blockIdx.x * 8 + wave, NGW = gridDim.x * 8;
    LAS float* scr = (LAS float*)(lds + wave * 8448);
    constexpr int I_IN = (DM / 64) * (DIN / 32), I_MKV = (DM / 64) * (1024 / 32), I_OUT = (DMIX / 64) * (DM / 32);
    for (int it = gw; it < I_IN + I_MKV + I_OUT; it += NGW) {
        int r = it;
        if (r < I_IN) { transpose_item(P.w_in, DM, DIN, (bf16_t*)(ws + WS_WTIN), 2, scr, r, lane); continue; } r -= I_IN;
        if (r < I_MKV) { transpose_item(P.w_mkv, DM, 1024, (bf16_t*)(ws + WS_WTMKV), 1, scr, r, lane); continue; } r -= I_MKV;
        transpose_item(P.w_out, DMIX, DM, (bf16_t*)(ws + WS_WTOUT), 0, scr, r, lane);
    }
    bf16_t* XB = (bf16_t*)(ws + WS_XB);
    for (int m = gw; m < ROWS_ALL; m += NGW) {
        const float* src = (m < M_PROMPT) ? P.x_prompt + (size_t)m * DM : (m < M_PROMPT + M_SAMPLE) ? P.x_sample + (size_t)(m - M_PROMPT) * DM
                         : (m < ROWS_IN) ? nullptr : P.mem_prompt + (size_t)(m - ROWS_IN) * DM;
        u32x2* dst = (u32x2*)(XB + (size_t)m * DM) + lane;
#pragma unroll
        for (int j = 0; j < 4; ++j) {
            f32x4 v = {0.f, 0.f, 0.f, 0.f};
            if (src) v = ((const f32x4*)src)[lane + 64 * j];
            u32x2 o; o.x = pk_bf16(v.x, v.y); o.y = pk_bf16(v.z, v.w); dst[64 * j] = o;
        }
    }
    float* rope = (float*)(ws + WS_ROPE);
    for (int e = blockIdx.x * 512 + tid; e < 2052 * 32; e += gridDim.x * 512) {
        const int idx = e >> 5, i = e & 31;
        const int pos = idx < 2048 ? idx : 8192 + (idx - 2048);
        double inv = 1.0;
        for (int k = 0; k < i; ++k) inv *= 0.7498942093324559;
        float s, c; sincos_d((double)pos * inv, s, c);
        rope[2 * e] = c; rope[2 * e + 1] = s;
    }
}

template <int K>
__device__ __forceinline__ void gemm_mainloop(const bf16_t* __restrict__ A, const bf16_t* __restrict__ Bt, LAS unsigned char* lds,
                                              f32x4 (&acc)[2][2][4][2], int tid, int wr, int wc, int fr, int fq) {
    constexpr int PITCH = 144;
    LAS unsigned char* As = lds; LAS unsigned char* Bs = lds + 256 * PITCH;
    const int lrow = tid >> 3, lch = tid & 7;
    const bf16_t* ga = A + (size_t)lrow * K + lch * 8;
    const bf16_t* gb = Bt + (size_t)lrow * K + lch * 8;
    u32x4 ra[4], rb[4];
#pragma unroll
    for (int i = 0; i < 4; ++i) { ra[i] = *(const u32x4*)(ga + (size_t)i * 64 * K); rb[i] = *(const u32x4*)(gb + (size_t)i * 64 * K); }
#pragma unroll
    for (int a = 0; a < 2; ++a)
#pragma unroll
        for (int b = 0; b < 2; ++b)
#pragma unroll
            for (int m = 0; m < 4; ++m)
#pragma unroll
                for (int n = 0; n < 2; ++n) acc[a][b][m][n] = (f32x4){0.f, 0.f, 0.f, 0.f};
    for (int kt = 0; kt < K / 64; ++kt) {
        __syncthreads();
#pragma unroll
        for (int i = 0; i < 4; ++i) {
            *(LAS u32x4*)(As + (lrow + 64 * i) * PITCH + lch * 16) = ra[i];
            *(LAS u32x4*)(Bs + (lrow + 64 * i) * PITCH + lch * 16) = rb[i];
        }
        __syncthreads();
        if (kt + 1 < K / 64) {
#pragma unroll
            for (int i = 0; i < 4; ++i) { ra[i] = *(const u32x4*)(ga + (size_t)i * 64 * K + (kt + 1) * 64); rb[i] = *(const u32x4*)(gb + (size_t)i * 64 * K + (kt + 1) * 64); }
        }
#pragma unroll
        for (int ai = 0; ai < 2; ++ai) {
#pragma unroll
            for (int k = 0; k < 2; ++k) {
                bf16x8 At[4];
#pragma unroll
                for (int m = 0; m < 4; ++m) At[m] = *(const LAS bf16x8*)(As + (ai * 128 + wr * 64 + m * 16 + fr) * PITCH + (k * 32 + fq * 8) * 2);
#pragma unroll
                for (int bj = 0; bj < 2; ++bj) {
                    bf16x8 Bf[2];
#pragma unroll
                    for (int n = 0; n < 2; ++n) Bf[n] = *(const LAS bf16x8*)(Bs + (bj * 128 + wc * 32 + n * 16 + fr) * PITCH + (k * 32 + fq * 8) * 2);
#pragma unroll
                    for (int m = 0; m < 4; ++m)
#pragma unroll
                        for (int n = 0; n < 2; ++n) acc[ai][bj][m][n] = __builtin_amdgcn_mfma_f32_16x16x32_bf16(Bf[n], At[m], acc[ai][bj][m][n], 0, 0, 0);
                }
            }
        }
    }
}

__device__ __forceinline__ void epi_inproj(const f32x4 (&acc)[2][2][4][2], int pm, int pn, const Params& P, int wr, int wc, int fr, int fq) {
    bf16_t* HB = (bf16_t*)(P.ws + WS_HB);
    const float* rope = (const float*)(P.ws + WS_ROPE);
    int type = 0; float scale = 1.0f; int f32out = 0;
    if (pn == 0) { type = 1; }
    else if (pn == 1) { type = 1; scale = 0.125f; }
    else if (pn == 4 || pn == 5 || pn == 12 || pn == 13 || pn == 16 || pn == 17) { type = 2; }
    else if (pn == 6 || pn == 7) { type = 1; scale = SQ_SCALE; }
    else if (pn == 8 || pn == 9) { type = 1; f32out = 1; }
    else if (pn == 10 || pn == 11) { f32out = 2; }
    else if (pn == 14 || pn == 15) { scale = MQ_SCALE; }
#pragma unroll
    for (int ai = 0; ai < 2; ++ai)
#pragma unroll
        for (int m = 0; m < 4; ++m) {
            const int r = pm * 256 + ai * 128 + wr * 64 + m * 16 + fr;
            const int pi = r < M_PROMPT ? (r & 2047) : 2048 + ((r - M_PROMPT) & 3);
            const bool live = r < M_PROMPT + M_SAMPLE;
#pragma unroll
            for (int bj = 0; bj < 2; ++bj) {
                const int cb = pn * 256 + bj * 128 + wc * 32;
                f32x4 v0 = acc[ai][bj][m][0], v1 = acc[ai][bj][m][1];
                if (type == 1) {
                    const int d1 = 16 * ((cb >> 5) & 1) + 4 * fq;
                    const f32x4* rp = (const f32x4*)(rope + ((size_t)pi * 32 + d1) * 2);
                    const f32x4 cs0 = rp[0], cs1 = rp[1];
                    f32x4 y1, y2;
                    y1[0] = v0[0] * cs0[0] - v1[0] * cs0[1]; y2[0] = v1[0] * cs0[0] + v0[0] * cs0[1];
                    y1[1] = v0[1] * cs0[2] - v1[1] * cs0[3]; y2[1] = v1[1] * cs0[2] + v0[1] * cs0[3];
                    y1[2] = v0[2] * cs1[0] - v1[2] * cs1[1]; y2[2] = v1[2] * cs1[0] + v0[2] * cs1[1];
                    y1[3] = v0[3] * cs1[2] - v1[3] * cs1[3]; y2[3] = v1[3] * cs1[2] + v0[3] * cs1[3];
                    if (f32out == 1 && live) {
                        float* o = (r < M_PROMPT ? P.out + O_KP + (size_t)r * 512 : P.out + O_KS + (size_t)(r - M_PROMPT) * 512) + ((cb - C_SK) >> 6) * 64 + d1;
                        *(f32x4*)o = y1; *(f32x4*)(o + 32) = y2;
                    }
                    v0 = y1 * scale; v1 = y2 * scale;
                } else if (type == 2) {
#pragma unroll
                    for (int e = 0; e < 4; ++e) { v0[e] = silu(v0[e]); v1[e] = silu(v1[e]); }
                } else {
                    if (f32out == 2 && live) {
                        float* o = (r < M_PROMPT ? P.out + O_VP + (size_t)r * 512 : P.out + O_VS + (size_t)(r - M_PROMPT) * 512) + (cb - C_SV) + 8 * fq;
                        *(f32x4*)o = v0; *(f32x4*)(o + 4) = v1;
                    }
                    v0 = v0 * scale; v1 = v1 * scale;
                }
                u32x4 w; w.x = pk_bf16(v0[0], v0[1]); w.y = pk_bf16(v0[2], v0[3]); w.z = pk_bf16(v1[0], v1[1]); w.w = pk_bf16(v1[2], v1[3]);
                *(u32x4*)(HB + (size_t)r * HP + cb + 8 * fq) = w;
            }
        }
}
__device__ __forceinline__ void epi_memkv(const f32x4 (&acc)[2][2][4][2], int pm, int pn, const Params& P, int wr, int wc, int fr, int fq) {
    bf16_t* MKV = (bf16_t*)(P.ws + WS_MKV);
#pragma unroll
    for (int ai = 0; ai < 2; ++ai)
#pragma unroll
        for (int m = 0; m < 4; ++m) {
            const int r = pm * 256 + ai * 128 + wr * 64 + m * 16 + fr;
#pragma unroll
            for (int bj = 0; bj < 2; ++bj) {
                const int c0 = pn * 256 + bj * 128 + wc * 32 + 8 * fq;
                const f32x4 v0 = acc[ai][bj][m][0], v1 = acc[ai][bj][m][1];
                float* o = (c0 < 512) ? P.out + O_MK + (size_t)r * 512 + c0 : P.out + O_MV + (size_t)r * 512 + (c0 - 512);
                *(f32x4*)o = v0; *(f32x4*)(o + 4) = v1;
                u32x4 w; w.x = pk_bf16(v0[0], v0[1]); w.y = pk_bf16(v0[2], v0[3]); w.z = pk_bf16(v1[0], v1[1]); w.w = pk_bf16(v1[2], v1[3]);
                *(u32x4*)(MKV + (size_t)r * 1024 + c0) = w;
            }
        }
}
__device__ __forceinline__ void epi_outproj(const f32x4 (&acc)[2][2][4][2], int pm, int pn, const Params& P, int wr, int wc, int fr, int fq) {
#pragma unroll
    for (int ai = 0; ai < 2; ++ai)
#pragma unroll
        for (int m = 0; m < 4; ++m) {
            const int r = pm * 256 + ai * 128 + wr * 64 + m * 16 + fr;
            if (r >= M_PROMPT + M_SAMPLE) continue;
            const float* xr = r < M_PROMPT ? P.x_prompt + (size_t)r * DM : P.x_sample + (size_t)(r - M_PROMPT) * DM;
            float* zr = r < M_PROMPT ? P.out + O_YP + (size_t)r * DM : P.out + O_YS + (size_t)(r - M_PROMPT) * DM;
#pragma unroll
            for (int bj = 0; bj < 2; ++bj)
#pragma unroll
                for (int n = 0; n < 2; ++n) {
                    const int c = pn * 256 + bj * 128 + wc * 32 + 16 * n + 4 * fq;
                    const f32x4 xv = *(const f32x4*)(xr + c);
                    *(f32x4*)(zr + c) = xv * ALPHA + acc[ai][bj][m][n];
                }
        }
}

__device__ __forceinline__ void ret_scan(const Params& P, LAS unsigned char* lds, int b, int h, int row0, int ntok, const float* init, float* outstate, int tid) {
    const bf16_t* HB = (const bf16_t*)(P.ws + WS_HB);
    bf16_t* MIX = (bf16_t*)(P.ws + WS_MIX);
    LAS float* qs = (LAS float*)lds;
    LAS float* ks = qs + 32 * 64;
    LAS float* vs = ks + 32 * 64;
    LAS float* po = vs + 32 * 128;
    const int vv = tid & 127, kq = tid >> 7;
    const float gamma = 1.0f - __builtin_amdgcn_exp2f((float)(-5 - h));
    float S[16];
#pragma unroll
    for (int j = 0; j < 16; ++j) S[j] = init ? init[((size_t)((b * 4 + h) * 64 + dmap(16 * kq + j))) * 128 + vv] : 0.f;
    for (int t0 = 0; t0 < ntok; t0 += 32) {
        const int nb = (ntok - t0) < 32 ? (ntok - t0) : 32;
        __syncthreads();
        {
            const int tt = (tid & 255) >> 3, ch = tid & 7;
            if (tt < nb) {
                const u32x4 w = *(const u32x4*)(HB + (size_t)(row0 + t0 + tt) * HP + (tid < 256 ? C_RQ : C_RK) + h * 64 + ch * 8);
                LAS float* dst = (tid < 256 ? qs : ks) + tt * 64 + ch * 8;
                dst[0] = bf_lo(w.x); dst[1] = bf_hi(w.x); dst[2] = bf_lo(w.y); dst[3] = bf_hi(w.y);
                dst[4] = bf_lo(w.z); dst[5] = bf_hi(w.z); dst[6] = bf_lo(w.w); dst[7] = bf_hi(w.w);
            }
            const int tv = tid >> 4, cv = tid & 15;
            if (tv < nb) {
                const u32x4 w = *(const u32x4*)(HB + (size_t)(row0 + t0 + tv) * HP + C_RV + h * 128 + cv * 8);
                LAS float* dst = vs + tv * 128 + cv * 8;
                dst[0] = bf_lo(w.x); dst[1] = bf_hi(w.x); dst[2] = bf_lo(w.y); dst[3] = bf_hi(w.y);
                dst[4] = bf_lo(w.z); dst[5] = bf_hi(w.z); dst[6] = bf_lo(w.w); dst[7] = bf_hi(w.w);
            }
        }
        __syncthreads();
        for (int tt = 0; tt < nb; ++tt) {
            const float vval = vs[tt * 128 + vv];
            float o = 0.f;
#pragma unroll
            for (int j4 = 0; j4 < 4; ++j4) {
                const f32x4 k4 = *(const LAS f32x4*)(ks + tt * 64 + 16 * kq + 4 * j4);
                const f32x4 q4 = *(const LAS f32x4*)(qs + tt * 64 + 16 * kq + 4 * j4);
#pragma unroll
                for (int e = 0; e < 4; ++e) { S[4 * j4 + e] = fmaf(gamma, S[4 * j4 + e], k4[e] * vval); o = fmaf(q4[e], S[4 * j4 + e], o); }
            }
            po[(tt * 4 + kq) * 128 + vv] = o;
        }
        __syncthreads();
        {
            const int tf = tid >> 4, c8 = (tid & 15) * 8;
            float o[8]; float s = 0.f;
#pragma unroll
            for (int e = 0; e < 8; ++e) { o[e] = (po[(tf * 4 + 0) * 128 + c8 + e] + po[(tf * 4 + 1) * 128 + c8 + e]) + (po[(tf * 4 + 2) * 128 + c8 + e] + po[(tf * 4 + 3) * 128 + c8 + e]); s += o[e]; }
            s += __shfl_xor(s, 1); s += __shfl_xor(s, 2); s += __shfl_xor(s, 4); s += __shfl_xor(s, 8);
            const float mean = s * (1.0f / 128.0f);
            float q = 0.f;
#pragma unroll
            for (int e = 0; e < 8; ++e) { o[e] -= mean; q += o[e] * o[e]; }
            q += __shfl_xor(q, 1); q += __shfl_xor(q, 2); q += __shfl_xor(q, 4); q += __shfl_xor(q, 8);
            const float rstd = 1.0f / sqrtf(q * (1.0f / 128.0f) + 1e-5f);
            if (tf < nb) {
                const size_t row = (size_t)(row0 + t0 + tf);
                const u32x4 g = *(const u32x4*)(HB + row * HP + C_RG + h * 128 + c8);
                u32x4 w;
                w.x = pk_bf16(o[0] * rstd * bf_lo(g.x), o[1] * rstd * bf_hi(g.x)); w.y = pk_bf16(o[2] * rstd * bf_lo(g.y), o[3] * rstd * bf_hi(g.y));
                w.z = pk_bf16(o[4] * rstd * bf_lo(g.z), o[5] * rstd * bf_hi(g.z)); w.w = pk_bf16(o[6] * rstd * bf_lo(g.w), o[7] * rstd * bf_hi(g.w));
                *(u32x4*)(MIX + row * DMIX + h * 128 + c8) = w;
            }
        }
    }
    __syncthreads();
#pragma unroll
    for (int j = 0; j < 16; ++j) outstate[((size_t)((b * 4 + h) * 64 + dmap(16 * kq + j))) * 128 + vv] = S[j];
}

__device__ __forceinline__ void swa_prompt_naive(const Params& P, int b, int h, int t) {
    const bf16_t* HB = (const bf16_t*)(P.ws + WS_HB);
    bf16_t* MIX = (bf16_t*)(P.ws + WS_MIX);
    const size_t R = (size_t)b * SEQ + t;
    u32x4 q4[8];
    { const u32x4* qp = (const u32x4*)(HB + R * HP + C_SQ + h * 64);
#pragma unroll
      for (int c = 0; c < 8; ++c) q4[c] = qp[c]; }
    float acc[64];
#pragma unroll
    for (int d = 0; d < 64; ++d) acc[d] = 0.f;
    float mrun = -INFINITY, lrun = 0.f;
#pragma unroll 1
    for (int g = 0; g < 3; ++g) {
        const int dil = (g == 0) ? 1 : (g == 1) ? 4 : 16;
#pragma unroll 1
        for (int s = 0; s <= 128; ++s) {
            const int tk = t - s * dil;
            const bool valid = tk >= 0;
            const size_t Rk = (size_t)b * SEQ + (valid ? tk : 0);
            const u32x4* kp = (const u32x4*)(HB + Rk * HP + C_SK + h * 64);
            const u32x4* vp = (const u32x4*)(HB + Rk * HP + C_SV + h * 64);
            u32x4 kk[8], vv[8];
#pragma unroll
            for (int c = 0; c < 8; ++c) { kk[c] = kp[c]; vv[c] = vp[c]; }
            float dot = 0.f;
#pragma unroll
            for (int c = 0; c < 8; ++c) {
                dot += bf_lo(q4[c].x) * bf_lo(kk[c].x) + bf_hi(q4[c].x) * bf_hi(kk[c].x) + bf_lo(q4[c].y) * bf_lo(kk[c].y) + bf_hi(q4[c].y) * bf_hi(kk[c].y)
                     + bf_lo(q4[c].z) * bf_lo(kk[c].z) + bf_hi(q4[c].z) * bf_hi(kk[c].z) + bf_lo(q4[c].w) * bf_lo(kk[c].w) + bf_hi(q4[c].w) * bf_hi(kk[c].w);
            }
            const float sc = valid ? dot : -INFINITY;
            const float mn = fmaxf(mrun, sc);
            const float f = fexp2(mrun - mn), p = fexp2(sc - mn);
            mrun = mn; lrun = lrun * f + p;
#pragma unroll
            for (int c = 0; c < 8; ++c) {
                acc[8 * c + 0] = acc[8 * c + 0] * f + p * bf_lo(vv[c].x); acc[8 * c + 1] = acc[8 * c + 1] * f + p * bf_hi(vv[c].x);
                acc[8 * c + 2] = acc[8 * c + 2] * f + p * bf_lo(vv[c].y); acc[8 * c + 3] = acc[8 * c + 3] * f + p * bf_hi(vv[c].y);
                acc[8 * c + 4] = acc[8 * c + 4] * f + p * bf_lo(vv[c].z); acc[8 * c + 5] = acc[8 * c + 5] * f + p * bf_hi(vv[c].z);
                acc[8 * c + 6] = acc[8 * c + 6] * f + p * bf_lo(vv[c].w); acc[8 * c + 7] = acc[8 * c + 7] * f + p * bf_hi(vv[c].w);
            }
        }
    }
    const float rl = 1.0f / lrun;
    const u32x4* gp = (const u32x4*)(HB + R * HP + C_SG + h * 64);
    u32x4* op = (u32x4*)(MIX + R * DMIX + 512 + h * 64);
#pragma unroll
    for (int c = 0; c < 8; ++c) {
        const u32x4 g = gp[c]; u32x4 w;
        w.x = pk_bf16(acc[8 * c + 0] * rl * bf_lo(g.x), acc[8 * c + 1] * rl * bf_hi(g.x)); w.y = pk_bf16(acc[8 * c + 2] * rl * bf_lo(g.y), acc[8 * c + 3] * rl * bf_hi(g.y));
        w.z = pk_bf16(acc[8 * c + 4] * rl * bf_lo(g.z), acc[8 * c + 5] * rl * bf_hi(g.z)); w.w = pk_bf16(acc[8 * c + 6] * rl * bf_lo(g.w), acc[8 * c + 7] * rl * bf_hi(g.w));
        op[c] = w;
    }
}

__device__ __forceinline__ void mem_prompt_naive(const Params& P, int b, int h, int t, int half) {
    const bf16_t* HB = (const bf16_t*)(P.ws + WS_HB);
    const bf16_t* MKV = (const bf16_t*)(P.ws + WS_MKV);
    bf16_t* MIX = (bf16_t*)(P.ws + WS_MIX);
    const size_t R = (size_t)b * SEQ + t;
    u32x4 q4[8];
    { const u32x4* qp = (const u32x4*)(HB + R * HP + C_MQ + h * 128 + half * 64);
#pragma unroll
      for (int c = 0; c < 8; ++c) q4[c] = qp[c]; }
    float acc[64];
#pragma unroll
    for (int d = 0; d < 64; ++d) acc[d] = 0.f;
    float mrun = -INFINITY, lrun = 0.f;
#pragma unroll 1
    for (int m = 0; m < NMEM; ++m) {
        const size_t Rk = (size_t)b * NMEM + m;
        const u32x4* kp = (const u32x4*)(MKV + Rk * 1024 + h * 128 + half * 64);
        const u32x4* vp = (const u32x4*)(MKV + Rk * 1024 + 512 + h * 128 + half * 64);
        u32x4 kk[8], vv[8];
#pragma unroll
        for (int c = 0; c < 8; ++c) { kk[c] = kp[c]; vv[c] = vp[c]; }
        float dot = 0.f;
#pragma unroll
        for (int c = 0; c < 8; ++c) {
            dot += bf_lo(q4[c].x) * bf_lo(kk[c].x) + bf_hi(q4[c].x) * bf_hi(kk[c].x) + bf_lo(q4[c].y) * bf_lo(kk[c].y) + bf_hi(q4[c].y) * bf_hi(kk[c].y)
                 + bf_lo(q4[c].z) * bf_lo(kk[c].z) + bf_hi(q4[c].z) * bf_hi(kk[c].z) + bf_lo(q4[c].w) * bf_lo(kk[c].w) + bf_hi(q4[c].w) * bf_hi(kk[c].w);
        }
        const float sc = dot + __shfl_xor(dot, 1);
        const float mn = fmaxf(mrun, sc);
        const float f = fexp2(mrun - mn), p = fexp2(sc - mn);
        mrun = mn; lrun = lrun * f + p;
#pragma unroll
        for (int c = 0; c < 8; ++c) {
            acc[8 * c + 0] = acc[8 * c + 0] * f + p * bf_lo(vv[c].x); acc[8 * c + 1] = acc[8 * c + 1] * f + p * bf_hi(vv[c].x);
            acc[8 * c + 2] = acc[8 * c + 2] * f + p * bf_lo(vv[c].y); acc[8 * c + 3] = acc[8 * c + 3] * f + p * bf_hi(vv[c].y);
            acc[8 * c + 4] = acc[8 * c + 4] * f + p * bf_lo(vv[c].z); acc[8 * c + 5] = acc[8 * c + 5] * f + p * bf_hi(vv[c].z);
            acc[8 * c + 6] = acc[8 * c + 6] * f + p * bf_lo(vv[c].w); acc[8 * c + 7] = acc[8 * c + 7] * f + p * bf_hi(vv[c].w);
        }
    }
    const float rl = 1.0f / lrun;
    const u32x4* gp = (const u32x4*)(HB + R * HP + C_MG + h * 128 + half * 64);
    u32x4* op = (u32x4*)(MIX + R * DMIX + 1024 + h * 128 + half * 64);
#pragma unroll
    for (int c = 0; c < 8; ++c) {
        const u32x4 g = gp[c]; u32x4 w;
        w.x = pk_bf16(acc[8 * c + 0] * rl * bf_lo(g.x), acc[8 * c + 1] * rl * bf_hi(g.x)); w.y = pk_bf16(acc[8 * c + 2] * rl * bf_lo(g.y), acc[8 * c + 3] * rl * bf_hi(g.y));
        w.z = pk_bf16(acc[8 * c + 4] * rl * bf_lo(g.z), acc[8 * c + 5] * rl * bf_hi(g.z)); w.w = pk_bf16(acc[8 * c + 6] * rl * bf_lo(g.w), acc[8 * c + 7] * rl * bf_hi(g.w));
        op[c] = w;
    }
}

__device__ __forceinline__ void swa_sample_wave(const Params& P, LAS float* wsc, int b, int h, int i, int lane) {
    const bf16_t* HB = (const bf16_t*)(P.ws + WS_HB);
    bf16_t* MIX = (bf16_t*)(P.ws + WS_MIX);
    const size_t R = (size_t)M_PROMPT + b * 4 + i;
    LAS float* qo = wsc;
    LDS_WAIT();
    qo[dmap(lane)] = bf2f(HB[R * HP + C_SQ + h * 64 + lane]);
    LDS_WAIT();
    float Mrun = -INFINITY, Wsum = 0.f, Nsum = 0.f;
#pragma unroll 1
    for (int g = 0; g < 3; ++g) {
        const int dil = (g == 0) ? 1 : (g == 1) ? 4 : 16;
        float sc[3];
#pragma unroll
        for (int rd = 0; rd < 3; ++rd) {
            const int s = lane + 64 * rd;
            float dot = -INFINITY;
            if (s <= 128) {
                const int idx = 2048 + i - dil * s;
                float a = 0.f;
                if (idx < 2048) {
                    const f32x4* kc = (const f32x4*)(P.cache_k + (((size_t)b * 2048 + idx) * 8 + h) * 64);
#pragma unroll
                    for (int c = 0; c < 16; ++c) { const f32x4 kv = kc[c]; const f32x4 qv = *(const LAS f32x4*)(qo + 4 * c); a += kv[0] * qv[0] + kv[1] * qv[1] + kv[2] * qv[2] + kv[3] * qv[3]; }
                } else {
                    const bf16_t* kn = HB + ((size_t)M_PROMPT + b * 4 + (idx - 2048)) * HP + C_SK + h * 64;
#pragma unroll 1
                    for (int p = 0; p < 64; ++p) a += qo[dmap(p)] * bf2f(kn[p]);
                }
                dot = a;
            }
            sc[rd] = dot;
        }
        const float m = wave_max(fmaxf(fmaxf(sc[0], sc[1]), sc[2]));
        const float p0 = fexp2(sc[0] - m), p1 = fexp2(sc[1] - m), p2 = fexp2(sc[2] - m);
        const float l = wave_sum(p0 + p1 + p2);
        float a = 0.f;
#pragma unroll 1
        for (int s0 = 0; s0 < 136; s0 += 8) {
            const float psel = (s0 < 64) ? p0 : (s0 < 128) ? p1 : p2;
            float vv[8];
#pragma unroll
            for (int e = 0; e < 8; ++e) {
                const int s = (s0 + e) < 128 ? (s0 + e) : 128;
                const int idx = 2048 + i - dil * s;
                vv[e] = (idx < 2048) ? P.cache_v[(((size_t)b * 2048 + idx) * 8 + h) * 64 + lane]
                                     : bf2f(HB[((size_t)M_PROMPT + b * 4 + (idx - 2048)) * HP + C_SV + h * 64 + lane]);
            }
#pragma unroll
            for (int e = 0; e < 8; ++e) a += __shfl(psel, (s0 + e) & 63) * vv[e];
        }
        const float mn = fmaxf(Mrun, m);
        const float f = fexp2(Mrun - mn), fg = fexp2(m - mn);
        Nsum = Nsum * f + a * fg; Wsum = Wsum * f + l * fg; Mrun = mn;
    }
    const float o = Nsum / Wsum;
    const float gate = bf2f(HB[R * HP + C_SG + h * 64 + lane]);
    MIX[R * DMIX + 512 + h * 64 + lane] = (bf16_t)(pk_bf16(o * gate, 0.f) & 0xffffu);
}

__device__ __forceinline__ void mem_sample_wave(const Params& P, LAS float* wsc, int b, int h, int i, int lane) {
    const bf16_t* HB = (const bf16_t*)(P.ws + WS_HB);
    bf16_t* MIX = (bf16_t*)(P.ws + WS_MIX);
    const size_t R = (size_t)M_PROMPT + b * 4 + i;
    LAS float* qm = wsc;
    LDS_WAIT();
    qm[lane] = bf2f(HB[R * HP + C_MQ + h * 128 + lane]); qm[64 + lane] = bf2f(HB[R * HP + C_MQ + h * 128 + 64 + lane]);
    LDS_WAIT();
    float sc[4];
#pragma unroll
    for (int rd = 0; rd < 4; ++rd) {
        const int m = lane + 64 * rd;
        const f32x4* kc = (const f32x4*)(P.cmem_k + (((size_t)b * NMEM + m) * 4 + h) * 128);
        float a = 0.f;
#pragma unroll
        for (int c = 0; c < 32; ++c) { const f32x4 kv = kc[c]; const f32x4 qv = *(const LAS f32x4*)(qm + 4 * c); a += kv[0] * qv[0] + kv[1] * qv[1] + kv[2] * qv[2] + kv[3] * qv[3]; }
        sc[rd] = a;
    }
    const float m = wave_max(fmaxf(fmaxf(sc[0], sc[1]), fmaxf(sc[2], sc[3])));
    const float p0 = fexp2(sc[0] - m), p1 = fexp2(sc[1] - m), p2 = fexp2(sc[2] - m), p3 = fexp2(sc[3] - m);
    const float l = wave_sum((p0 + p1) + (p2 + p3));
    float a0 = 0.f, a1 = 0.f;
#pragma unroll 1
    for (int s0 = 0; s0 < NMEM; s0 += 8) {
        const float psel = (s0 < 64) ? p0 : (s0 < 128) ? p1 : (s0 < 192) ? p2 : p3;
        f32x2 vv[8];
#pragma unroll
        for (int e = 0; e < 8; ++e) vv[e] = *(const f32x2*)(P.cmem_v + (((size_t)b * NMEM + s0 + e) * 4 + h) * 128 + 2 * lane);
#pragma unroll
        for (int e = 0; e < 8; ++e) { const float ps = __shfl(psel, (s0 + e) & 63); a0 += ps * vv[e][0]; a1 += ps * vv[e][1]; }
    }
    const float rl = 1.0f / l;
    const unsigned g = *(const unsigned*)(HB + R * HP + C_MG + h * 128 + 2 * lane);
    *(unsigned*)(MIX + R * DMIX + 1024 + h * 128 + 2 * lane) = pk_bf16(a0 * rl * bf_lo(g), a1 * rl * bf_hi(g));
}

__global__ void __launch_bounds__(512, 2) fwd_kernel(Params P) {
    extern __shared__ __attribute__((aligned(16))) unsigned char lds_raw[];
    LAS unsigned char* lds = (LAS unsigned char*)lds_raw;
    cg::grid_group grid = cg::this_grid();
    const int tid = threadIdx.x, lane = tid & 63, wave = __builtin_amdgcn_readfirstlane(tid >> 6);
    const int wr = wave >> 2, wc = wave & 3, fr = lane & 15, fq = lane >> 4;
    const int G = gridDim.x;
    unsigned* ctl = (unsigned*)(P.ws + WS_CTL);

    phase0(P, lds, tid, lane, wave);
    grid.sync();

    {
        const bf16_t* XB = (const bf16_t*)(P.ws + WS_XB);
        constexpr int U_IN = 65 * 18, U_ALL = U_IN + 32;
        for (int u = blockIdx.x; u < U_ALL; u += G) {
            f32x4 acc[2][2][4][2];
            if (u < U_IN) {
                const int pm = u / 18, pn = u % 18;
                gemm_mainloop<DM>(XB + (size_t)pm * 256 * DM, (const bf16_t*)(P.ws + WS_WTIN) + (size_t)pn * 256 * DM, lds, acc, tid, wr, wc, fr, fq);
                epi_inproj(acc, pm, pn, P, wr, wc, fr, fq);
            } else {
                const int v = u - U_IN, pm = v >> 2, pn = v & 3;
                gemm_mainloop<DM>(XB + (size_t)(ROWS_IN + pm * 256) * DM, (const bf16_t*)(P.ws + WS_WTMKV) + (size_t)pn * 256 * DM, lds, acc, tid, wr, wc, fr, fq);
                epi_memkv(acc, pm, pn, P, wr, wc, fr, fq);
            }
        }
    }
    grid.sync();

    {
        for (int u = blockIdx.x; u < 160; u += G) {
            if (u < 32) ret_scan(P, lds, u >> 2, u & 3, (u >> 2) * SEQ, SEQ, nullptr, P.out + O_RP, tid);
            else { const int v = u - 32; ret_scan(P, lds, v >> 2, v & 3, M_PROMPT + (v >> 2) * 4, 4, P.state_ret, P.out + O_RS, tid); }
        }
        __syncthreads();
        LAS float* wsc = (LAS float*)(lds + wave * 1024);
        for (;;) {
            unsigned u = 0;
            if (lane == 0) u = atomicAdd(ctl + 64, 1u);
            u = (unsigned)__builtin_amdgcn_readfirstlane((int)u);
            if (u >= 2048u + 2048u + 1024u + 512u) break;
            if (u < 2048u) { const int b = u >> 8, h = (u >> 5) & 7, tb = u & 31; swa_prompt_naive(P, b, h, tb * 64 + lane); }
            else if (u < 4096u) { const unsigned v = u - 2048u; const int b = v >> 8, h = (v >> 6) & 3, tb = v & 63; mem_prompt_naive(P, b, h, tb * 32 + (lane >> 1), lane & 1); }
            else if (u < 5120u) { const unsigned v = u - 4096u; swa_sample_wave(P, wsc, v >> 5, (v >> 2) & 7, v & 3, lane); }
            else { const unsigned v = u - 5120u; mem_sample_wave(P, wsc, v >> 4, (v >> 2) & 3, v & 3, lane); }
        }
    }
    grid.sync();

    {
        const bf16_t* MIX = (const bf16_t*)(P.ws + WS_MIX);
        for (int u = blockIdx.x; u < 65 * 4; u += G) {
            const int pm = u >> 2, pn = u & 3;
            f32x4 acc[2][2][4][2];
            gemm_mainloop<DMIX>(MIX + (size_t)pm * 256 * DMIX, (const bf16_t*)(P.ws + WS_WTOUT) + (size_t)pn * 256 * DMIX, lds, acc, tid, wr, wc, fr, fq);
            epi_outproj(acc, pm, pn, P, wr, wc, fr, fq);
        }
    }
    grid.sync();

    {
        const int gw = blockIdx.x * 8 + wave, NGW = G * 8;
        for (int r = gw; r < M_PROMPT + M_SAMPLE; r += NGW) {
            float* zr = r < M_PROMPT ? P.out + O_YP + (size_t)r * DM : P.out + O_YS + (size_t)(r - M_PROMPT) * DM;
            f32x4 v[4]; float s = 0.f;
#pragma unroll
            for (int j = 0; j < 4; ++j) { v[j] = ((const f32x4*)zr)[lane + 64 * j]; s += (v[j][0] + v[j][1]) + (v[j][2] + v[j][3]); }
            const float mean = wave_sum(s) * (1.0f / DM);
            float q = 0.f;
#pragma unroll
            for (int j = 0; j < 4; ++j) { v[j] = v[j] - mean; q += (v[j][0] * v[j][0] + v[j][1] * v[j][1]) + (v[j][2] * v[j][2] + v[j][3] * v[j][3]); }
            const float rstd = 1.0f / sqrtf(wave_sum(q) * (1.0f / DM) + 1e-5f);
#pragma unroll
            for (int j = 0; j < 4; ++j) {
                const f32x4 g = ((const f32x4*)P.ln_g)[lane + 64 * j], bb = ((const f32x4*)P.ln_b)[lane + 64 * j];
                ((f32x4*)zr)[lane + 64 * j] = v[j] * rstd * g + bb;
            }
        }
    }
}

extern "C" void kernel_launch(void* const* d_in, const int* in_sizes, int n_in, void* d_out, int out_size, void* d_ws, size_t ws_size, hipStream_t stream) {
    static int grid_blocks = 0;
    if (!grid_blocks) {
        int dev = 0, cus = 0, per_cu = 0;
        hipGetDevice(&dev);
        hipDeviceGetAttribute(&cus, hipDeviceAttributeMultiprocessorCount, dev);
        hipFuncSetAttribute((const void*)fwd_kernel, hipFuncAttributeMaxDynamicSharedMemorySize, LDS_BYTES);
        hipOccupancyMaxActiveBlocksPerMultiprocessor(&per_cu, (const void*)fwd_kernel, 512, LDS_BYTES);
        if (per_cu < 1) { fprintf(stderr, "kernel_launch: occupancy query says %d blocks per CU\n", per_cu); per_cu = 1; }
        grid_blocks = cus;
        if (ws_size < WS_END) fprintf(stderr, "kernel_launch: workspace too small (%zu < %zu)\n", ws_size, (size_t)WS_END);
    }
    hipMemsetAsync((char*)d_ws + WS_CTL, 0, 4096, stream);
    Params p{};
    p.x_prompt = (const float*)d_in[0]; p.x_sample = (const float*)d_in[1]; p.state_ret = (const float*)d_in[2];
    p.cache_k = (const float*)d_in[3]; p.cache_v = (const float*)d_in[4]; p.cmem_k = (const float*)d_in[5]; p.cmem_v = (const float*)d_in[6];
    p.mem_prompt = (const float*)d_in[7]; p.w_in = (const float*)d_in[8]; p.w_mkv = (const float*)d_in[9]; p.w_out = (const float*)d_in[10];
    p.ln_g = (const float*)d_in[11]; p.ln_b = (const float*)d_in[12];
    p.out = (float*)d_out; p.ws = (unsigned char*)d_ws;
    void* args[] = {&p};
    hipError_t e = hipLaunchCooperativeKernel((const void*)fwd_kernel, dim3(grid_blocks), dim3(512), args, LDS_BYTES, stream);
    if (e != hipSuccess) fprintf(stderr, "cooperative launch failed: %s (grid %d)\n", hipGetErrorString(e), grid_blocks);
}
```

```cpp
#include <hip/hip_runtime.h>
#include <hip/hip_cooperative_groups.h>
#include <cstdio>
#include <cstdint>
namespace cg = cooperative_groups;

#define LAS __attribute__((address_space(3)))
typedef unsigned short bf16_t;
typedef short bf16x8 __attribute__((ext_vector_type(8)));
typedef float f32x4 __attribute__((ext_vector_type(4)));
typedef float f32x2 __attribute__((ext_vector_type(2)));
typedef unsigned u32x4 __attribute__((ext_vector_type(4)));
typedef unsigned u32x2 __attribute__((ext_vector_type(2)));
typedef __bf16 bf16x2_t __attribute__((ext_vector_type(2)));

constexpr int DM = 1024, NB = 8, SEQ = 2048, DECB = 32, DECT = 4;
constexpr int NMEM = 256, DIN = 4608, DMIX = 1536;
constexpr int M_PROMPT = NB * SEQ;
constexpr int M_SAMPLE = DECB * DECT;
constexpr int ROWS_IN = M_PROMPT + 256;
constexpr int ROWS_ALL = ROWS_IN + NB * NMEM;
constexpr int HP = DIN;
constexpr int C_RQ = 0, C_RK = 256, C_RV = 512, C_RG = 1024, C_SQ = 1536, C_SK = 2048, C_SV = 2560, C_SG = 3072, C_MQ = 3584, C_MG = 4096;
constexpr size_t O_YP = 0, O_YS = 16777216, O_RP = 16908288, O_RS = 17170432, O_KP = 18219008, O_VP = 26607616,
                 O_KS = 34996224, O_VS = 35061760, O_MK = 35127296, O_MV = 36175872;
constexpr size_t MiB = 1u << 20;
constexpr size_t WS_CTL = 0, WS_ROPE = 1 * MiB, WS_WTIN = 2 * MiB, WS_WTMKV = 12 * MiB, WS_WTOUT = 14 * MiB,
                 WS_XB = 20 * MiB, WS_HB = 64 * MiB, WS_MKV = 212 * MiB, WS_MIX = 216 * MiB, WS_END = 268 * MiB;
constexpr int LDS_BYTES = 163840;
constexpr float LOG2E = 1.4426950408889634f;
constexpr float SQ_SCALE = 0.18033688011112042f;
constexpr float MQ_SCALE = 0.12751743082459868f;
constexpr float ALPHA = 1.189207115002721f;

struct Params {
    const float *x_prompt, *x_sample, *state_ret, *cache_k, *cache_v, *cmem_k, *cmem_v, *mem_prompt, *w_in, *w_mkv, *w_out, *ln_g, *ln_b;
    float* out;
    unsigned char* ws;
};

__device__ __forceinline__ unsigned pk_bf16(float lo, float hi) { f32x2 v = {lo, hi}; bf16x2_t b = __builtin_convertvector(v, bf16x2_t); return __builtin_bit_cast(unsigned, b); }
__device__ __forceinline__ float bf_lo(unsigned u) { return __uint_as_float(u << 16); }
__device__ __forceinline__ float bf_hi(unsigned u) { return __uint_as_float(u & 0xffff0000u); }
__device__ __forceinline__ float bf2f(bf16_t h) { return __uint_as_float(((unsigned)h) << 16); }
__device__ __forceinline__ float fexp2(float x) { return __builtin_amdgcn_exp2f(x); }
__device__ __forceinline__ float frcp(float x) { return __builtin_amdgcn_rcpf(x); }
__device__ __forceinline__ float silu(float x) { return x * frcp(1.0f + fexp2(-x * LOG2E)); }
__device__ __forceinline__ float wave_max(float v) {
#pragma unroll
    for (int o = 1; o < 64; o <<= 1) v = fmaxf(v, __shfl_xor(v, o));
    return v;
}
__device__ __forceinline__ float wave_sum(float v) {
#pragma unroll
    for (int o = 1; o < 64; o <<= 1) v += __shfl_xor(v, o);
    return v;
}
#define LDS_WAIT() asm volatile("s_waitcnt lgkmcnt(0)" ::: "memory")
__device__ __forceinline__ int perm32(int rho) { const int n = rho >> 4, i = rho & 15; return 8 * (i >> 2) + 4 * n + (i & 3); }
__device__ __forceinline__ int dmap(int p) { return 16 * (p >> 5) + 32 * ((p >> 2) & 1) + 4 * ((p >> 3) & 3) + (p & 3); }
__device__ __forceinline__ int src_col_in(int c) {
    const int rho = c & 31;
    const bool rope = (c < 512) || (c >= 1536 && c < 2560);
    if (rope) return (c & ~63) + 16 * ((c >> 5) & 1) + 32 * (rho >> 4) + (rho & 15);
    return (c & ~31) + perm32(rho);
}

__device__ __forceinline__ void transpose_item(const float* W, int K, int N, bf16_t* WT, int mode, LAS float* scr, int item, int lane) {
    const int nblk = N / 32, kb = item / nblk, nb = item % nblk, k0 = 64 * kb, n0 = 32 * nb;
    const int cl = lane & 31;
    const int sc = (mode == 0) ? (n0 + cl) : (mode == 1) ? (n0 + perm32(cl)) : src_col_in(n0 + cl);
#pragma unroll 8
    for (int i = 0; i < 32; ++i) { const int kk = 2 * i + (lane >> 5); scr[kk * 33 + cl] = W[(size_t)(k0 + kk) * N + sc]; }
    LDS_WAIT();
    const int c = lane & 7;
#pragma unroll
    for (int j = 0; j < 4; ++j) {
        const int n = (lane >> 3) + 8 * j; const LAS float* s = scr + (8 * c) * 33 + n;
        u32x4 o; o.x = pk_bf16(s[0 * 33], s[1 * 33]); o.y = pk_bf16(s[2 * 33], s[3 * 33]); o.z = pk_bf16(s[4 * 33], s[5 * 33]); o.w = pk_bf16(s[6 * 33], s[7 * 33]);
        *(u32x4*)(WT + (size_t)(n0 + n) * K + k0 + 8 * c) = o;
    }
    LDS_WAIT();
}
__device__ __forceinline__ void sincos_d(double a, float& s, float& c) {
    const double kd = __builtin_rint(a * 0.63661977236758134308);
    double y = __builtin_fma(-kd, 1.57079632679489655800e+00, a); y = __builtin_fma(-kd, 6.12323399573676603587e-17, y);
    const double y2 = y * y;
    const double sp = y * (1.0 + y2 * (-1.0 / 6 + y2 * (1.0 / 120 + y2 * (-1.0 / 5040 + y2 * (1.0 / 362880 + y2 * (-1.0 / 39916800 + y2 * (1.0 / 6227020800.0)))))));
    const double cp = 1.0 + y2 * (-0.5 + y2 * (1.0 / 24 + y2 * (-1.0 / 720 + y2 * (1.0 / 40320 + y2 * (-1.0 / 3628800 + y2 * (1.0 / 479001600.0))))));
    const int k = ((int)kd) & 3;
    const double sv = (k == 0) ? sp : (k == 1) ? cp : (k == 2) ? -sp : -cp;
    const double cv = (k == 0) ? cp : (k == 1) ? -sp : (k == 2) ? -cp : sp;
    s = (float)sv; c = (float)cv;
}
__device__ __forceinline__ void phase0(const Params& P, LAS unsigned char* lds, int tid, int lane, int wave) {
    unsigned char* ws = P.ws;
    const int gw = blockIdx.x * 8 + wave, NGW = gridDim.x * 8;
    LAS float* scr = (LAS float*)(lds + wave * 8448);
    constexpr int I_IN = (DM / 64) * (DIN / 32), I_MKV = (DM / 64) * (1024 / 32), I_OUT = (DMIX / 64) * (DM / 32);
    for (int it = gw; it < I_IN + I_MKV + I_OUT; it += NGW) {
        int r = it;
        if (r < I_IN) { transpose_item(P.w_in, DM, DIN, (bf16_t*)(ws + WS_WTIN), 2, scr, r, lane); continue; } r -= I_IN;
        if (r < I_MKV) { transpose_item(P.w_mkv, DM, 1024, (bf16_t*)(ws + WS_WTMKV), 1, scr, r, lane); continue; } r -= I_MKV;
        transpose_item(P.w_out, DMIX, DM, (bf16_t*)(ws + WS_WTOUT), 0, scr, r, lane);
    }
    bf16_t* XB = (bf16_t*)(ws + WS_XB);
    for (int m = gw; m < ROWS_ALL; m += NGW) {
        const float* src = (m < M_PROMPT) ? P.x_prompt + (size_t)m * DM : (m < M_PROMPT + M_SAMPLE) ? P.x_sample + (size_t)(m - M_PROMPT) * DM
                         : (m < ROWS_IN) ? nullptr : P.mem_prompt + (size_t)(m - ROWS_IN) * DM;
        u32x2* dst = (u32x2*)(XB + (size_t)m * DM) + lane;
#pragma unroll
        for (int j = 0; j < 4; ++j) {
            f32x4 v = {0.f, 0.f, 0.f, 0.f};
            if (src) v = ((const f32x4*)src)[lane + 64 * j];
            u32x2 o; o.x = pk_bf16(v.x, v.y); o.y = pk_bf16(v.z, v.w); dst[64 * j] = o;
        }
    }
    float* rope = (float*)(ws + WS_ROPE);
    for (int e = blockIdx.x * 512 + tid; e < 2052 * 32; e += gridDim.x * 512) {
        const int idx = e >> 5, i = e & 31;
        const int pos = idx < 2048 ? idx : 8192 + (idx - 2048);
        double inv = 1.0;
        for (int k = 0; k < i; ++k) inv *= 0.7498942093324559;
        float s, c; sincos_d((double)pos * inv, s, c);
        rope[2 * e] = c; rope[2 * e + 1] = s;
    }
}

template <int K>
__device__ __forceinline__ void gemm_mainloop(const bf16_t* __restrict__ A, const bf16_t* __restrict__ Bt, LAS unsigned char* lds,
                                              f32x4 (&acc)[2][2][4][2], int tid, int wr, int wc, int fr, int fq) {
    constexpr int PITCH = 144;
    LAS unsigned char* As = lds; LAS unsigned char* Bs = lds + 256 * PITCH;
    const int lrow = tid >> 3, lch = tid & 7;
    const bf16_t* ga = A + (size_t)lrow * K + lch * 8;
    const bf16_t* gb = Bt + (size_t)lrow * K + lch * 8;
    u32x4 ra[4], rb[4];
#pragma unroll
    for (int i = 0; i < 4; ++i) { ra[i] = *(const u32x4*)(ga + (size_t)i * 64 * K); rb[i] = *(const u32x4*)(gb + (size_t)i * 64 * K); }
#pragma unroll
    for (int a = 0; a < 2; ++a)
#pragma unroll
        for (int b = 0; b < 2; ++b)
#pragma unroll
            for (int m = 0; m < 4; ++m)
#pragma unroll
                for (int n = 0; n < 2; ++n) acc[a][b][m][n] = (f32x4){0.f, 0.f, 0.f, 0.f};
    for (int kt = 0; kt < K / 64; ++kt) {
        __syncthreads();
#pragma unroll
        for (int i = 0; i < 4; ++i) {
            *(LAS u32x4*)(As + (lrow + 64 * i) * PITCH + lch * 16) = ra[i];
            *(LAS u32x4*)(Bs + (lrow + 64 * i) * PITCH + lch * 16) = rb[i];
        }
        __syncthreads();
        if (kt + 1 < K / 64) {
#pragma unroll
            for (int i = 0; i < 4; ++i) { ra[i] = *(const u32x4*)(ga + (size_t)i * 64 * K + (kt + 1) * 64); rb[i] = *(const u32x4*)(gb + (size_t)i * 64 * K + (kt + 1) * 64); }
        }
#pragma unroll
        for (int ai = 0; ai < 2; ++ai) {
#pragma unroll
            for (int k = 0; k < 2; ++k) {
                bf16x8 At[4];
#pragma unroll
                for (int m = 0; m < 4; ++m) At[m] = *(const LAS bf16x8*)(As + (ai * 128 + wr * 64 + m * 16 + fr) * PITCH + (k * 32 + fq * 8) * 2);
#pragma unroll
                for (int bj = 0; bj < 2; ++bj) {
                    bf16x8 Bf[2];
#pragma unroll
                    for (int n = 0; n < 2; ++n) Bf[n] = *(const LAS bf16x8*)(Bs + (bj * 128 + wc * 32 + n * 16 + fr) * PITCH + (k * 32 + fq * 8) * 2);
#pragma unroll
                    for (int m = 0; m < 4; ++m)
#pragma unroll
                        for (int n = 0; n < 2; ++n) acc[ai][bj][m][n] = __builtin_amdgcn_mfma_f32_16x16x32_bf16(Bf[n], At[m], acc[ai][bj][m][n], 0, 0, 0);
                }
            }
        }
    }
}

__device__ __forceinline__ void epi_inproj(const f32x4 (&acc)[2][2][4][2], int pm, int pn, const Params& P, int wr, int wc, int fr, int fq) {
    bf16_t* HB = (bf16_t*)(P.ws + WS_HB);
    const float* rope = (const float*)(P.ws + WS_ROPE);
    int type = 0; float scale = 1.0f; int f32out = 0;
    if (pn == 0) { type = 1; }
    else if (pn == 1) { type = 1; scale = 0.125f; }
    else if (pn == 4 || pn == 5 || pn == 12 || pn == 13 || pn == 16 || pn == 17) { type = 2; }
    else if (pn == 6 || pn == 7) { type = 1; scale = SQ_SCALE; }
    else if (pn == 8 || pn == 9) { type = 1; f32out = 1; }
    else if (pn == 10 || pn == 11) { f32out = 2; }
    else if (pn == 14 || pn == 15) { scale = MQ_SCALE; }
#pragma unroll
    for (int ai = 0; ai < 2; ++ai)
#pragma unroll
        for (int m = 0; m < 4; ++m) {
            const int r = pm * 256 + ai * 128 + wr * 64 + m * 16 + fr;
            const int pi = r < M_PROMPT ? (r & 2047) : 2048 + ((r - M_PROMPT) & 3);
            const bool live = r < M_PROMPT + M_SAMPLE;
#pragma unroll
            for (int bj = 0; bj < 2; ++bj) {
                const int cb = pn * 256 + bj * 128 + wc * 32;
                f32x4 v0 = acc[ai][bj][m][0], v1 = acc[ai][bj][m][1];
                if (type == 1) {
                    const int d1 = 16 * ((cb >> 5) & 1) + 4 * fq;
                    const f32x4* rp = (const f32x4*)(rope + ((size_t)pi * 32 + d1) * 2);
                    const f32x4 cs0 = rp[0], cs1 = rp[1];
                    f32x4 y1, y2;
                    y1[0] = v0[0] * cs0[0] - v1[0] * cs0[1]; y2[0] = v1[0] * cs0[0] + v0[0] * cs0[1];
                    y1[1] = v0[1] * cs0[2] - v1[1] * cs0[3]; y2[1] = v1[1] * cs0[2] + v0[1] * cs0[3];
                    y1[2] = v0[2] * cs1[0] - v1[2] * cs1[1]; y2[2] = v1[2] * cs1[0] + v0[2] * cs1[1];
                    y1[3] = v0[3] * cs1[2] - v1[3] * cs1[3]; y2[3] = v1[3] * cs1[2] + v0[3] * cs1[3];
                    if (f32out == 1 && live) {
                        float* o = (r < M_PROMPT ? P.out + O_KP + (size_t)r * 512 : P.out + O_KS + (size_t)(r - M_PROMPT) * 512) + ((cb - C_SK) >> 6) * 64 + d1;
                        *(f32x4*)o = y1; *(f32x4*)(o + 32) = y2;
                    }
                    v0 = y1 * scale; v1 = y2 * scale;
                } else if (type == 2) {
#pragma unroll
                    for (int e = 0; e < 4; ++e) { v0[e] = silu(v0[e]); v1[e] = silu(v1[e]); }
                } else {
                    if (f32out == 2 && live) {
                        float* o = (r < M_PROMPT ? P.out + O_VP + (size_t)r * 512 : P.out + O_VS + (size_t)(r - M_PROMPT) * 512) + (cb - C_SV) + 8 * fq;
                        *(f32x4*)o = v0; *(f32x4*)(o + 4) = v1;
                    }
                    v0 = v0 * scale; v1 = v1 * scale;
                }
                u32x4 w; w.x = pk_bf16(v0[0], v0[1]); w.y = pk_bf16(v0[2], v0[3]); w.z = pk_bf16(v1[0], v1[1]); w.w = pk_bf16(v1[2], v1[3]);
                *(u32x4*)(HB + (size_t)r * HP + cb + 8 * fq) = w;
            }
        }
}
__device__ __forceinline__ void epi_memkv(const f32x4 (&acc)[2][2][4][2], int pm, int pn, const Params& P, int wr, int wc, int fr, int fq) {
    bf16_t* MKV = (bf16_t*)(P.ws + WS_MKV);
#pragma unroll
    for (int ai = 0; ai < 2; ++ai)
#pragma unroll
        for (int m = 0; m < 4; ++m) {
            const int r = pm * 256 + ai * 128 + wr * 64 + m * 16 + fr;
#pragma unroll
            for (int bj = 0; bj < 2; ++bj) {
                const int c0 = pn * 256 + bj * 128 + wc * 32 + 8 * fq;
                const f32x4 v0 = acc[ai][bj][m][0], v1 = acc[ai][bj][m][1];
                float* o = (c0 < 512) ? P.out + O_MK + (size_t)r * 512 + c0 : P.out + O_MV + (size_t)r * 512 + (c0 - 512);
                *(f32x4*)o = v0; *(f32x4*)(o + 4) = v1;
                u32x4 w; w.x = pk_bf16(v0[0], v0[1]); w.y = pk_bf16(v0[2], v0[3]); w.z = pk_bf16(v1[0], v1[1]); w.w = pk_bf16(v1[2], v1[3]);
                *(u32x4*)(MKV + (size_t)r * 1024 + c0) = w;
            }
        }
}
__device__ __forceinline__ void epi_outproj(const f32x4 (&acc)[2][2][4][2], int pm, int pn, const Params& P, int wr, int wc, int fr, int fq) {
#pragma unroll
    for (int ai = 0; ai < 2; ++ai)
#pragma unroll
        for (int m = 0; m < 4; ++m) {
            const int r = pm * 256 + ai * 128 + wr * 64 + m * 16 + fr;
            if (r >= M_PROMPT + M_SAMPLE) continue;
            const float* xr = r < M_PROMPT ? P.x_prompt + (size_t)r * DM : P.x_sample + (size_t)(r - M_PROMPT) * DM;
            float* zr = r < M_PROMPT ? P.out + O_YP + (size_t)r * DM : P.out + O_YS + (size_t)(r - M_PROMPT) * DM;
#pragma unroll
            for (int bj = 0; bj < 2; ++bj)
#pragma unroll
                for (int n = 0; n < 2; ++n) {
                    const int c = pn * 256 + bj * 128 + wc * 32 + 16 * n + 4 * fq;
                    const f32x4 xv = *(const f32x4*)(xr + c);
                    *(f32x4*)(zr + c) = xv * ALPHA + acc[ai][bj][m][n];
                }
        }
}

__device__ __forceinline__ void ret_scan(const Params& P, LAS unsigned char* lds, int b, int h, int row0, int ntok, const float* init, float* outstate, int tid) {
    const bf16_t* HB = (const bf16_t*)(P.ws + WS_HB);
    bf16_t* MIX = (bf16_t*)(P.ws + WS_MIX);
    LAS float* qs = (LAS float*)lds;
    LAS float* ks = qs + 32 * 64;
    LAS float* vs = ks + 32 * 64;
    LAS float* po = vs + 32 * 128;
    const int vv = tid & 127, kq = tid >> 7;
    const float gamma = 1.0f - __builtin_amdgcn_exp2f((float)(-5 - h));
    float S[16];
#pragma unroll
    for (int j = 0; j < 16; ++j) S[j] = init ? init[((size_t)((b * 4 + h) * 64 + dmap(16 * kq + j))) * 128 + vv] : 0.f;
    for (int t0 = 0; t0 < ntok; t0 += 32) {
        const int nb = (ntok - t0) < 32 ? (ntok - t0) : 32;
        __syncthreads();
        {
            const int tt = (tid & 255) >> 3, ch = tid & 7;
            if (tt < nb) {
                const u32x4 w = *(const u32x4*)(HB + (size_t)(row0 + t0 + tt) * HP + (tid < 256 ? C_RQ : C_RK) + h * 64 + ch * 8);
                LAS float* dst = (tid < 256 ? qs : ks) + tt * 64 + ch * 8;
                dst[0] = bf_lo(w.x); dst[1] = bf_hi(w.x); dst[2] = bf_lo(w.y); dst[3] = bf_hi(w.y);
                dst[4] = bf_lo(w.z); dst[5] = bf_hi(w.z); dst[6] = bf_lo(w.w); dst[7] = bf_hi(w.w);
            }
            const int tv = tid >> 4, cv = tid & 15;
            if (tv < nb) {
                const u32x4 w = *(const u32x4*)(HB + (size_t)(row0 + t0 + tv) * HP + C_RV + h * 128 + cv * 8);
                LAS float* dst = vs + tv * 128 + cv * 8;
                dst[0] = bf_lo(w.x); dst[1] = bf_hi(w.x); dst[2] = bf_lo(w.y); dst[3] = bf_hi(w.y);
                dst[4] = bf_lo(w.z); dst[5] = bf_hi(w.z); dst[6] = bf_lo(w.w); dst[7] = bf_hi(w.w);
            }
        }
        __syncthreads();
        for (int tt = 0; tt < nb; ++tt) {
            const float vval = vs[tt * 128 + vv];
            float o = 0.f;
#pragma unroll
            for (int j4 = 0; j4 < 4; ++j4) {
                const f32x4 k4 = *(const LAS f32x4*)(ks + tt * 64 + 16 * kq + 4 * j4);
                const f32x4 q4 = *(const LAS f32x4*)(qs + tt * 64 + 16 * kq + 4 * j4);
#pragma unroll
                for (int e = 0; e < 4; ++e) { S[4 * j4 + e] = fmaf(gamma, S[4 * j4 + e], k4[e] * vval); o = fmaf(q4[e], S[4 * j4 + e], o); }
            }
            po[(tt * 4 + kq) * 128 + vv] = o;
        }
        __syncthreads();
        {
            const int tf = tid >> 4, c8 = (tid & 15) * 8;
            float o[8]; float s = 0.f;
#pragma unroll
            for (int e = 0; e < 8; ++e) { o[e] = (po[(tf * 4 + 0) * 128 + c8 + e] + po[(tf * 4 + 1) * 128 + c8 + e]) + (po[(tf * 4 + 2) * 128 + c8 + e] + po[(tf * 4 + 3) * 128 + c8 + e]); s += o[e]; }
            s += __shfl_xor(s, 1); s += __shfl_xor(s, 2); s += __shfl_xor(s, 4); s += __shfl_xor(s, 8);
            const float mean = s * (1.0f / 128.0f);
            float q = 0.f;
#pragma unroll
            for (int e = 0; e < 8; ++e) { o[e] -= mean; q += o[e] * o[e]; }
            q += __shfl_xor(q, 1); q += __shfl_xor(q, 2); q += __shfl_xor(q, 4); q += __shfl_xor(q, 8);
            const float rstd = 1.0f / sqrtf(q * (1.0f / 128.0f) + 1e-5f);
            if (tf < nb) {
                const size_t row = (size_t)(row0 + t0 + tf);
                const u32x4 g = *(const u32x4*)(HB + row * HP + C_RG + h * 128 + c8);
                u32x4 w;
                w.x = pk_bf16(o[0] * rstd * bf_lo(g.x), o[1] * rstd * bf_hi(g.x)); w.y = pk_bf16(o[2] * rstd * bf_lo(g.y), o[3] * rstd * bf_hi(g.y));
                w.z = pk_bf16(o[4] * rstd * bf_lo(g.z), o[5] * rstd * bf_hi(g.z)); w.w = pk_bf16(o[6] * rstd * bf_lo(g.w), o[7] * rstd * bf_hi(g.w));
                *(u32x4*)(MIX + row * DMIX + h * 128 + c8) = w;
            }
        }
    }
    __syncthreads();
#pragma unroll
    for (int j = 0; j < 16; ++j) outstate[((size_t)((b * 4 + h) * 64 + dmap(16 * kq + j))) * 128 + vv] = S[j];
}

__device__ __forceinline__ void swa_prompt_naive(const Params& P, int b, int h, int t) {
    const bf16_t* HB = (const bf16_t*)(P.ws + WS_HB);
    bf16_t* MIX = (bf16_t*)(P.ws + WS_MIX);
    const size_t R = (size_t)b * SEQ + t;
    u32x4 q4[8];
    { const u32x4* qp = (const u32x4*)(HB + R * HP + C_SQ + h * 64);
#pragma unroll
      for (int c = 0; c < 8; ++c) q4[c] = qp[c]; }
    float acc[64];
#pragma unroll
    for (int d = 0; d < 64; ++d) acc[d] = 0.f;
    float mrun = -INFINITY, lrun = 0.f;
#pragma unroll 1
    for (int g = 0; g < 3; ++g) {
        const int dil = (g == 0) ? 1 : (g == 1) ? 4 : 16;
#pragma unroll 1
        for (int s = 0; s <= 128; ++s) {
            const int tk = t - s * dil;
            const bool valid = tk >= 0;
            const size_t Rk = (size_t)b * SEQ + (valid ? tk : 0);
            const u32x4* kp = (const u32x4*)(HB + Rk * HP + C_SK + h * 64);
            const u32x4* vp = (const u32x4*)(HB + Rk * HP + C_SV + h * 64);
            u32x4 kk[8], vv[8];
#pragma unroll
            for (int c = 0; c < 8; ++c) { kk[c] = kp[c]; vv[c] = vp[c]; }
            float dot = 0.f;
#pragma unroll
            for (int c = 0; c < 8; ++c) {
                dot += bf_lo(q4[c].x) * bf_lo(kk[c].x) + bf_hi(q4[c].x) * bf_hi(kk[c].x) + bf_lo(q4[c].y) * bf_lo(kk[c].y) + bf_hi(q4[c].y) * bf_hi(kk[c].y)
                     + bf_lo(q4[c].z) * bf_lo(kk[c].z) + bf_hi(q4[c].z) * bf_hi(kk[c].z) + bf_lo(q4[c].w) * bf_lo(kk[c].w) + bf_hi(q4[c].w) * bf_hi(kk[c].w);
            }
            const float sc = valid ? dot : -INFINITY;
            const float mn = fmaxf(mrun, sc);
            const float f = fexp2(mrun - mn), p = fexp2(sc - mn);
            mrun = mn; lrun = lrun * f + p;
#pragma unroll
            for (int c = 0; c < 8; ++c) {
                acc[8 * c + 0] = acc[8 * c + 0] * f + p * bf_lo(vv[c].x); acc[8 * c + 1] = acc[8 * c + 1] * f + p * bf_hi(vv[c].x);
                acc[8 * c + 2] = acc[8 * c + 2] * f + p * bf_lo(vv[c].y); acc[8 * c + 3] = acc[8 * c + 3] * f + p * bf_hi(vv[c].y);
                acc[8 * c + 4] = acc[8 * c + 4] * f + p * bf_lo(vv[c].z); acc[8 * c + 5] = acc[8 * c + 5] * f + p * bf_hi(vv[c].z);
                acc[8 * c + 6] = acc[8 * c + 6] * f + p * bf_lo(vv[c].w); acc[8 * c + 7] = acc[8 * c + 7] * f + p * bf_hi(vv[c].w);
            }
        }
    }
    const float rl = 1.0f / lrun;
    const u32x4* gp = (const u32x4*)(HB + R * HP + C_SG + h * 64);
    u32x4* op = (u32x4*)(MIX + R * DMIX + 512 + h * 64);
#pragma unroll
    for (int c = 0; c < 8; ++c) {
        const u32x4 g = gp[c]; u32x4 w;
        w.x = pk_bf16(acc[8 * c + 0] * rl * bf_lo(g.x), acc[8 * c + 1] * rl * bf_hi(g.x)); w.y = pk_bf16(acc[8 * c + 2] * rl * bf_lo(g.y), acc[8 * c + 3] * rl * bf_hi(g.y));
        w.z = pk_bf16(acc[8 * c + 4] * rl * bf_lo(g.z), acc[8 * c + 5] * rl * bf_hi(g.z)); w.w = pk_bf16(acc[8 * c + 6] * rl * bf_lo(g.w), acc[8 * c + 7] * rl * bf_hi(g.w));
        op[c] = w;
    }
}

__device__ __forceinline__ void mem_prompt_naive(const Params& P, int b, int h, int t, int half) {
    const bf16_t* HB = (const bf16_t*)(P.ws + WS_HB);
    const bf16_t* MKV = (const bf16_t*)(P.ws + WS_MKV);
    bf16_t* MIX = (bf16_t*)(P.ws + WS_MIX);
    const size_t R = (size_t)b * SEQ + t;
    u32x4 q4[8];
    { const u32x4* qp = (const u32x4*)(HB + R * HP + C_MQ + h * 128 + half * 64);
#pragma unroll
      for (int c = 0; c < 8; ++c) q4[c] = qp[c]; }
    float acc[64];
#pragma unroll
    for (int d = 0; d < 64; ++d) acc[d] = 0.f;
    float mrun = -INFINITY, lrun = 0.f;
#pragma unroll 1
    for (int m = 0; m < NMEM; ++m) {
        const size_t Rk = (size_t)b * NMEM + m;
        const u32x4* kp = (const u32x4*)(MKV + Rk * 1024 + h * 128 + half * 64);
        const u32x4* vp = (const u32x4*)(MKV + Rk * 1024 + 512 + h * 128 + half * 64);
        u32x4 kk[8], vv[8];
#pragma unroll
        for (int c = 0; c < 8; ++c) { kk[c] = kp[c]; vv[c] = vp[c]; }
        float dot = 0.f;
#pragma unroll
        for (int c = 0; c < 8; ++c) {
            dot += bf_lo(q4[c].x) * bf_lo(kk[c].x) + bf_hi(q4[c].x) * bf_hi(kk[c].x) + bf_lo(q4[c].y) * bf_lo(kk[c].y) + bf_hi(q4[c].y) * bf_hi(kk[c].y)
                 + bf_lo(q4[c].z) * bf_lo(kk[c].z) + bf_hi(q4[c].z) * bf_hi(kk[c].z) + bf_lo(q4[c].w) * bf_lo(kk[c].w) + bf_hi(q4[c].w) * bf_hi(kk[c].w);
        }
        const float sc = dot + __shfl_xor(dot, 1);
        const float mn = fmaxf(mrun, sc);
        const float f = fexp2(mrun - mn), p = fexp2(sc - mn);
        mrun = mn; lrun = lrun * f + p;
#pragma unroll
        for (int c = 0; c < 8; ++c) {
            acc[8 * c + 0] = acc[8 * c + 0] * f + p * bf_lo(vv[c].x); acc[8 * c + 1] = acc[8 * c + 1] * f + p * bf_hi(vv[c].x);
            acc[8 * c + 2] = acc[8 * c + 2] * f + p * bf_lo(vv[c].y); acc[8 * c + 3] = acc[8 * c + 3] * f + p * bf_hi(vv[c].y);
            acc[8 * c + 4] = acc[8 * c + 4] * f + p * bf_lo(vv[c].z); acc[8 * c + 5] = acc[8 * c + 5] * f + p * bf_hi(vv[c].z);
            acc[8 * c + 6] = acc[8 * c + 6] * f + p * bf_lo(vv[c].w); acc[8 * c + 7] = acc[8 * c + 7] * f + p * bf_hi(vv[c].w);
        }
    }
    const float rl = 1.0f / lrun;
    const u32x4* gp = (const u32x4*)(HB + R * HP + C_MG + h * 128 + half * 64);
    u32x4* op = (u32x4*)(MIX + R * DMIX + 1024 + h * 128 + half * 64);
#pragma unroll
    for (int c = 0; c < 8; ++c) {
        const u32x4 g = gp[c]; u32x4 w;
        w.x = pk_bf16(acc[8 * c + 0] * rl * bf_lo(g.x), acc[8 * c + 1] * rl * bf_hi(g.x)); w.y = pk_bf16(acc[8 * c + 2] * rl * bf_lo(g.y), acc[8 * c + 3] * rl * bf_hi(g.y));
        w.z = pk_bf16(acc[8 * c + 4] * rl * bf_lo(g.z), acc[8 * c + 5] * rl * bf_hi(g.z)); w.w = pk_bf16(acc[8 * c + 6] * rl * bf_lo(g.w), acc[8 * c + 7] * rl * bf_hi(g.w));
        op[c] = w;
    }
}

__device__ __forceinline__ void swa_sample_wave(const Params& P, LAS float* wsc, int b, int h, int i, int lane) {
    const bf16_t* HB = (const bf16_t*)(P.ws + WS_HB);
    bf16_t* MIX = (bf16_t*)(P.ws + WS_MIX);
    const size_t R = (size_t)M_PROMPT + b * 4 + i;
    LAS float* qo = wsc;
    LDS_WAIT();
    qo[dmap(lane)] = bf2f(HB[R * HP + C_SQ + h * 64 + lane]);
    LDS_WAIT();
    float Mrun = -INFINITY, Wsum = 0.f, Nsum = 0.f;
#pragma unroll 1
    for (int g = 0; g < 3; ++g) {
        const int dil = (g == 0) ? 1 : (g == 1) ? 4 : 16;
        float sc[3];
#pragma unroll
        for (int rd = 0; rd < 3; ++rd) {
            const int s = lane + 64 * rd;
            float dot = -INFINITY;
            if (s <= 128) {
                const int idx = 2048 + i - dil * s;
                float a = 0.f;
                if (idx < 2048) {
                    const f32x4* kc = (const f32x4*)(P.cache_k + (((size_t)b * 2048 + idx) * 8 + h) * 64);
#pragma unroll
                    for (int c = 0; c < 16; ++c) { const f32x4 kv = kc[c]; const f32x4 qv = *(const LAS f32x4*)(qo + 4 * c); a += kv[0] * qv[0] + kv[1] * qv[1] + kv[2] * qv[2] + kv[3] * qv[3]; }
                } else {
                    const bf16_t* kn = HB + ((size_t)M_PROMPT + b * 4 + (idx - 2048)) * HP + C_SK + h * 64;
#pragma unroll 1
                    for (int p = 0; p < 64; ++p) a += qo[dmap(p)] * bf2f(kn[p]);
                }
                dot = a;
            }
            sc[rd] = dot;
        }
        const float m = wave_max(fmaxf(fmaxf(sc[0], sc[1]), sc[2]));
        const float p0 = fexp2(sc[0] - m), p1 = fexp2(sc[1] - m), p2 = fexp2(sc[2] - m);
        const float l = wave_sum(p0 + p1 + p2);
        float a = 0.f;
#pragma unroll 1
        for (int s0 = 0; s0 < 136; s0 += 8) {
            const float psel = (s0 < 64) ? p0 : (s0 < 128) ? p1 : p2;
            float vv[8];
#pragma unroll
            for (int e = 0; e < 8; ++e) {
                const int s = (s0 + e) < 128 ? (s0 + e) : 128;
                const int idx = 2048 + i - dil * s;
                vv[e] = (idx < 2048) ? P.cache_v[(((size_t)b * 2048 + idx) * 8 + h) * 64 + lane]
                                     : bf2f(HB[((size_t)M_PROMPT + b * 4 + (idx - 2048)) * HP + C_SV + h * 64 + lane]);
            }
#pragma unroll
            for (int e = 0; e < 8; ++e) a += __shfl(psel, (s0 + e) & 63) * vv[e];
        }
        const float mn = fmaxf(Mrun, m);
        const float f = fexp2(Mrun - mn), fg = fexp2(m - mn);
        Nsum = Nsum * f + a * fg; Wsum = Wsum * f + l * fg; Mrun = mn;
    }
    const float o = Nsum / Wsum;
    const float gate = bf2f(HB[R * HP + C_SG + h * 64 + lane]);
    MIX[R * DMIX + 512 + h * 64 + lane] = (bf16_t)(pk_bf16(o * gate, 0.f) & 0xffffu);
}

__device__ __forceinline__ void mem_sample_wave(const Params& P, LAS float* wsc, int b, int h, int i, int lane) {
    const bf16_t* HB = (const bf16_t*)(P.ws + WS_HB);
    bf16_t* MIX = (bf16_t*)(P.ws + WS_MIX);
    const size_t R = (size_t)M_PROMPT + b * 4 + i;
    LAS float* qm = wsc;
    LDS_WAIT();
    qm[lane] = bf2f(HB[R * HP + C_MQ + h * 128 + lane]); qm[64 + lane] = bf2f(HB[R * HP + C_MQ + h * 128 + 64 + lane]);
    LDS_WAIT();
    float sc[4];
#pragma unroll
    for (int rd = 0; rd < 4; ++rd) {
        const int m = lane + 64 * rd;
        const f32x4* kc = (const f32x4*)(P.cmem_k + (((size_t)b * NMEM + m) * 4 + h) * 128);
        float a = 0.f;
#pragma unroll
        for (int c = 0; c < 32; ++c) { const f32x4 kv = kc[c]; const f32x4 qv = *(const LAS f32x4*)(qm + 4 * c); a += kv[0] * qv[0] + kv[1] * qv[1] + kv[2] * qv[2] + kv[3] * qv[3]; }
        sc[rd] = a;
    }
    const float m = wave_max(fmaxf(fmaxf(sc[0], sc[1]), fmaxf(sc[2], sc[3])));
    const float p0 = fexp2(sc[0] - m), p1 = fexp2(sc[1] - m), p2 = fexp2(sc[2] - m), p3 = fexp2(sc[3] - m);
    const float l = wave_sum((p0 + p1) + (p2 + p3));
    float a0 = 0.f, a1 = 0.f;
#pragma unroll 1
    for (int s0 = 0; s0 < NMEM; s0 += 8) {
        const float psel = (s0 < 64) ? p0 : (s0 < 128) ? p1 : (s0 < 192) ? p2 : p3;
        f32x2 vv[8];
#pragma unroll
        for (int e = 0; e < 8; ++e) vv[e] = *(const f32x2*)(P.cmem_v + (((size_t)b * NMEM + s0 + e) * 4 + h) * 128 + 2 * lane);
#pragma unroll
        for (int e = 0; e < 8; ++e) { const float ps = __shfl(psel, (s0 + e) & 63); a0 += ps * vv[e][0]; a1 += ps * vv[e][1]; }
    }
    const float rl = 1.0f / l;
    const unsigned g = *(const unsigned*)(HB + R * HP + C_MG + h * 128 + 2 * lane);
    *(unsigned*)(MIX + R * DMIX + 1024 + h * 128 + 2 * lane) = pk_bf16(a0 * rl * bf_lo(g), a1 * rl * bf_hi(g));
}

typedef float f32x16 __attribute__((ext_vector_type(16)));
typedef short s16x4 __attribute__((ext_vector_type(4)));
constexpr int SWA_ST_O = 0, SWA_ST_M = 65536, SWA_ST_L = 65536 + 2048, SWA_WV = 69632, SWA_WV_STRIDE = 10240 + 256;
__device__ __forceinline__ s16x4 tr16(LAS unsigned char* p) { return __builtin_bit_cast(s16x4, __builtin_amdgcn_ds_read_tr16_b64_v4i16((LAS s16x4*)p)); }
__device__ __forceinline__ f32x16 mfma32(bf16x8 a, bf16x8 b, f32x16 c) { return __builtin_amdgcn_mfma_f32_32x32x16_bf16(a, b, c, 0, 0, 0); }
#define VM_WAIT() asm volatile("s_waitcnt vmcnt(0)" ::: "memory")

__device__ __forceinline__ void swa_task(const Params& P, LAS unsigned char* lds, int wave, int lane, int b, int h, int dil, int r, int i0, int pat, int T0) {
    const bf16_t* HB = (const bf16_t*)(P.ws + WS_HB);
    bf16_t* MIX = (bf16_t*)(P.ws + WS_MIX);
    const int a = lane & 31, hi = lane >> 5;
    LAS unsigned char* vreg = lds + SWA_WV + wave * SWA_WV_STRIDE;
    LAS float* msc = (LAS float*)(vreg + 10240);
    LAS float* lsc = msc + 32;
    const size_t rowbase = (size_t)b * SEQ + r;
    const int jmin = i0 >= 128 ? 0 : ((128 - i0) >> 5);
    const int vrow = ((lane >> 5) << 3) + ((lane >> 2) & 7), vch = lane & 3;
    const int trb = (4 * hi + ((lane & 15) >> 2)) * 64 + ((lane >> 4) & 1) * 32 + (lane & 3) * 8;

#define SWA_DMA_V(db) do { _Pragma("unroll") for (int j = 0; j < 5; ++j) if (j >= jmin) { _Pragma("unroll") for (int it2 = 0; it2 < 2; ++it2) { \
        const int ik = i0 - 128 + 32 * j + 16 * it2 + vrow; \
        __builtin_amdgcn_global_load_lds((const unsigned*)(HB + (rowbase + (size_t)dil * ik) * HP + C_SV + h * 64 + 32 * (db) + 8 * vch), \
                                         (LAS unsigned*)(vreg + j * 2048 + it2 * 1024), 16, 0, 0); } } } while (0)

    LDS_WAIT();
    SWA_DMA_V(0);
    bf16x8 qf[4];
    { const bf16_t* qp = HB + (rowbase + (size_t)dil * (i0 + a)) * HP + C_SQ + h * 64 + 8 * hi;
#pragma unroll
      for (int kk = 0; kk < 4; ++kk) qf[kk] = *(const bf16x8*)(qp + 16 * kk); }
    f32x16 S[5];
#pragma unroll
    for (int j = 0; j < 5; ++j) {
        if (j >= jmin) {
            const int ik = i0 - 128 + 32 * j + a;
            const bf16_t* kp = HB + (rowbase + (size_t)dil * ik) * HP + C_SK + h * 64 + 8 * hi;
            bf16x8 kf[4];
#pragma unroll
            for (int kk = 0; kk < 4; ++kk) kf[kk] = *(const bf16x8*)(kp + 16 * kk);
            f32x16 acc;
#pragma unroll
            for (int e = 0; e < 16; ++e) acc[e] = 0.f;
#pragma unroll
            for (int kk = 0; kk < 4; ++kk) acc = mfma32(kf[kk], qf[kk], acc);
            if (j == 0) {
#pragma unroll
                for (int e = 0; e < 16; ++e) { const int c = (e & 3) + 8 * (e >> 2) + 4 * hi; if (c < a) acc[e] = -INFINITY; }
            }
            if (j == 4) {
#pragma unroll
                for (int e = 0; e < 16; ++e) { const int c = (e & 3) + 8 * (e >> 2) + 4 * hi; if (c > a) acc[e] = -INFINITY; }
            }
            S[j] = acc;
        } else {
#pragma unroll
            for (int e = 0; e < 16; ++e) S[j][e] = -INFINITY;
        }
    }
    float mx = -INFINITY;
#pragma unroll
    for (int j = 0; j < 5; ++j)
#pragma unroll
        for (int e = 0; e < 16; ++e) mx = fmaxf(mx, S[j][e]);
    mx = fmaxf(mx, __shfl_xor(mx, 32));
    float lsum = 0.f;
    unsigned pa[5][2][4];
#pragma unroll
    for (int j = 0; j < 5; ++j) {
#pragma unroll
        for (int e = 0; e < 16; ++e) { const float p = fexp2(S[j][e] - mx); S[j][e] = p; lsum += p; }
#pragma unroll
        for (int s = 0; s < 2; ++s)
#pragma unroll
            for (int w = 0; w < 4; ++w) pa[j][s][w] = pk_bf16(S[j][8 * s + 2 * w], S[j][8 * s + 2 * w + 1]);
    }
    lsum += __shfl_xor(lsum, 32);
    if (hi == 0) { msc[a] = mx; lsc[a] = lsum; }
    LDS_WAIT();
    float fo[16], go[16], rl[16];
    LAS float* stM = (LAS float*)(lds + SWA_ST_M);
    LAS float* stL = (LAS float*)(lds + SWA_ST_L);
#pragma unroll
    for (int g4 = 0; g4 < 4; ++g4) {
        const f32x4 m4 = *(const LAS f32x4*)(msc + 8 * g4 + 4 * hi), l4 = *(const LAS f32x4*)(lsc + 8 * g4 + 4 * hi);
#pragma unroll
        for (int e = 0; e < 4; ++e) {
            const int c = 8 * g4 + 4 * hi + e;
            const int tok = r + dil * (i0 + c) - T0;
            if (pat == 0) { fo[4 * g4 + e] = 0.f; go[4 * g4 + e] = 1.f; rl[4 * g4 + e] = 1.f; if (a == 0) { stM[tok] = m4[e]; stL[tok] = l4[e]; } }
            else {
                const float Mo = stM[tok], Lo = stL[tok];
                const float Mn = fmaxf(Mo, m4[e]);
                const float f = fexp2(Mo - Mn), g = fexp2(m4[e] - Mn);
                const float Ln = Lo * f + l4[e] * g;
                fo[4 * g4 + e] = f; go[4 * g4 + e] = g; rl[4 * g4 + e] = 1.0f / Ln;
                if (pat == 1 && a == 0) { stM[tok] = Mn; stL[tok] = Ln; }
            }
        }
    }
#pragma unroll
    for (int db = 0; db < 2; ++db) {
        VM_WAIT();
        f32x16 O;
#pragma unroll
        for (int e = 0; e < 16; ++e) O[e] = 0.f;
#pragma unroll
        for (int j = 0; j < 5; ++j) if (j >= jmin) {
#pragma unroll
            for (int s = 0; s < 2; ++s) {
                const s16x4 lo = tr16(vreg + j * 2048 + (2 * s) * 512 + trb), hh = tr16(vreg + j * 2048 + (2 * s + 1) * 512 + trb);
                const bf16x8 vb = {lo[0], lo[1], lo[2], lo[3], hh[0], hh[1], hh[2], hh[3]};
                const bf16x8 pf = __builtin_bit_cast(bf16x8, (u32x4){pa[j][s][0], pa[j][s][1], pa[j][s][2], pa[j][s][3]});
                O = mfma32(pf, vb, O);
            }
        }
        if (db == 0) { LDS_WAIT(); SWA_DMA_V(1); }
        LAS bf16_t* stO = (LAS bf16_t*)(lds + SWA_ST_O);
        const int d = 32 * db + a;
#pragma unroll
        for (int e = 0; e < 16; ++e) {
            const int c = (e & 3) + 8 * (e >> 2) + 4 * hi;
            const int tok = r + dil * (i0 + c) - T0;
            if (pat == 0) stO[tok * 64 + d] = (bf16_t)(pk_bf16(O[e], 0.f) & 0xffffu);
            else {
                const float on = bf2f(stO[tok * 64 + d]) * fo[e] + O[e] * go[e];
                if (pat == 1) stO[tok * 64 + d] = (bf16_t)(pk_bf16(on, 0.f) & 0xffffu);
                else {
                    const size_t row = (size_t)b * SEQ + T0 + tok;
                    const float gate = bf2f(HB[row * HP + C_SG + h * 64 + d]);
                    MIX[row * DMIX + 512 + h * 64 + d] = (bf16_t)(pk_bf16(on * rl[e] * gate, 0.f) & 0xffffu);
                }
            }
        }
    }
#undef SWA_DMA_V
}
__device__ __forceinline__ void swa_unit(const Params& P, LAS unsigned char* lds, int wave, int lane, int b, int h, int chunk) {
    const int T0 = chunk * 512;
#pragma unroll 1
    for (int pat = 0; pat < 3; ++pat) {
#pragma unroll 1
        for (int tt = 0; tt < 2; ++tt) {
            const int k = wave + 8 * tt;
            int dil, r, i0;
            if (pat == 0) { dil = 1; r = 0; i0 = T0 + 32 * k; }
            else if (pat == 1) { dil = 4; r = k & 3; i0 = (T0 >> 2) + 32 * (k >> 2); }
            else { dil = 16; r = k; i0 = T0 >> 4; }
            swa_task(P, lds, wave, lane, b, h, dil, r, i0, pat, T0);
        }
        __syncthreads();
    }
}

__global__ void __launch_bounds__(512, 2) fwd_kernel(Params P) {
    extern __shared__ __attribute__((aligned(16))) unsigned char lds_raw[];
    LAS unsigned char* lds = (LAS unsigned char*)lds_raw;
    cg::grid_group grid = cg::this_grid();
    const int tid = threadIdx.x, lane = tid & 63, wave = __builtin_amdgcn_readfirstlane(tid >> 6);
    const int wr = wave >> 2, wc = wave & 3, fr = lane & 15, fq = lane >> 4;
    const int G = gridDim.x;
    unsigned* ctl = (unsigned*)(P.ws + WS_CTL);

    phase0(P, lds, tid, lane, wave);
    grid.sync();

    {
        const bf16_t* XB = (const bf16_t*)(P.ws + WS_XB);
        constexpr int U_IN = 65 * 18, U_ALL = U_IN + 32;
        for (int u = blockIdx.x; u < U_ALL; u += G) {
            f32x4 acc[2][2][4][2];
            if (u < U_IN) {
                const int pm = u / 18, pn = u % 18;
                gemm_mainloop<DM>(XB + (size_t)pm * 256 * DM, (const bf16_t*)(P.ws + WS_WTIN) + (size_t)pn * 256 * DM, lds, acc, tid, wr, wc, fr, fq);
                epi_inproj(acc, pm, pn, P, wr, wc, fr, fq);
            } else {
                const int v = u - U_IN, pm = v >> 2, pn = v & 3;
                gemm_mainloop<DM>(XB + (size_t)(ROWS_IN + pm * 256) * DM, (const bf16_t*)(P.ws + WS_WTMKV) + (size_t)pn * 256 * DM, lds, acc, tid, wr, wc, fr, fq);
                epi_memkv(acc, pm, pn, P, wr, wc, fr, fq);
            }
        }
    }
    grid.sync();

    {
        for (int u = blockIdx.x; u < 160; u += G) {
            if (u < 32) ret_scan(P, lds, u >> 2, u & 3, (u >> 2) * SEQ, SEQ, nullptr, P.out + O_RP, tid);
            else { const int v = u - 32; ret_scan(P, lds, v >> 2, v & 3, M_PROMPT + (v >> 2) * 4, 4, P.state_ret, P.out + O_RS, tid); }
        }
        __syncthreads();
        for (int u = blockIdx.x; u < 256; u += G) swa_unit(P, lds, wave, lane, u >> 5, (u >> 2) & 7, u & 3);
        LAS float* wsc = (LAS float*)(lds + wave * 1024);
        for (;;) {
            unsigned u = 0;
            if (lane == 0) u = atomicAdd(ctl + 64, 1u);
            u = (unsigned)__builtin_amdgcn_readfirstlane((int)u);
            if (u >= 2048u + 2048u + 1024u + 512u) break;
            if (u < 2048u) { continue; }
            else if (u < 4096u) { const unsigned v = u - 2048u; const int b = v >> 8, h = (v >> 6) & 3, tb = v & 63; mem_prompt_naive(P, b, h, tb * 32 + (lane >> 1), lane & 1); }
            else if (u < 5120u) { const unsigned v = u - 4096u; swa_sample_wave(P, wsc, v >> 5, (v >> 2) & 7, v & 3, lane); }
            else { const unsigned v = u - 5120u; mem_sample_wave(P, wsc, v >> 4, (v >> 2) & 3, v & 3, lane); }
        }
    }
    grid.sync();

    {
        const bf16_t* MIX = (const bf16_t*)(P.ws + WS_MIX);
        for (int u = blockIdx.x; u < 65 * 4; u += G) {
            const int pm = u >> 2, pn = u & 3;
            f32x4 acc[2][2][4][2];
            gemm_mainloop<DMIX>(MIX + (size_t)pm * 256 * DMIX, (const bf16_t*)(P.ws + WS_WTOUT) + (size_t)pn * 256 * DMIX, lds, acc, tid, wr, wc, fr, fq);
            epi_outproj(acc, pm, pn, P, wr, wc, fr, fq);
        }
    }
    grid.sync();

    {
        const int gw = blockIdx.x * 8 + wave, NGW = G * 8;
        for (int r = gw; r < M_PROMPT + M_SAMPLE; r += NGW) {
            float* zr = r < M_PROMPT ? P.out + O_YP + (size_t)r * DM : P.out + O_YS + (size_t)(r - M_PROMPT) * DM;
            f32x4 v[4]; float s = 0.f;
#pragma unroll
            for (int j = 0; j < 4; ++j) { v[j] = ((const f32x4*)zr)[lane + 64 * j]; s += (v[j][0] + v[j][1]) + (v[j][2] + v[j][3]); }
            const float mean = wave_sum(s) * (1.0f / DM);
            float q = 0.f;
#pragma unroll
            for (int j = 0; j < 4; ++j) { v[j] = v[j] - mean; q += (v[j][0] * v[j][0] + v[j][1] * v[j][1]) + (v[j][2] * v[j][2] + v[j][3] * v[j][3]); }
            const float rstd = 1.0f / sqrtf(wave_sum(q) * (1.0f / DM) + 1e-5f);
#pragma unroll
            for (int j = 0; j < 4; ++j) {
                const f32x4 g = ((const f32x4*)P.ln_g)[lane + 64 * j], bb = ((const f32x4*)P.ln_b)[lane + 64 * j];
                ((f32x4*)zr)[lane + 64 * j] = v[j] * rstd * g + bb;
            }
        }
    }
}

extern "C" void kernel_launch(void* const* d_in, const int* in_sizes, int n_in, void* d_out, int out_size, void* d_ws, size_t ws_size, hipStream_t stream) {
    static int grid_blocks = 0;
    if (!grid_blocks) {
        int dev = 0, cus = 0, per_cu = 0;
        hipGetDevice(&dev);
        hipDeviceGetAttribute(&cus, hipDeviceAttributeMultiprocessorCount, dev);
        hipFuncSetAttribute((const void*)fwd_kernel, hipFuncAttributeMaxDynamicSharedMemorySize, LDS_BYTES);
        hipOccupancyMaxActiveBlocksPerMultiprocessor(&per_cu, (const void*)fwd_kernel, 512, LDS_BYTES);
        if (per_cu < 1) { fprintf(stderr, "kernel_launch: occupancy query says %d blocks per CU\n", per_cu); per_cu = 1; }
        grid_blocks = cus;
        if (ws_size < WS_END) fprintf(stderr, "kernel_launch: workspace too small (%zu < %zu)\n", ws_size, (size_t)WS_END);
    }
    hipMemsetAsync((char*)d_ws + WS_CTL, 0, 4096, stream);
    Params p{};
    p.x_prompt = (const float*)d_in[0]; p.x_sample = (const float*)d_in[1]; p.state_ret = (const float*)d_in[2];
    p.cache_k = (const float*)d_in[3]; p.cache_v = (const float*)d_in[4]; p.cmem_k = (const float*)d_in[5]; p.cmem_v = (const float*)d_in[6];
    p.mem_prompt = (const float*)d_in[7]; p.w_in = (const float*)d_in[8]; p.w_mkv = (const float*)d_in[9]; p.w_out = (const float*)d_in[10];
    p.ln_g = (const float*)d_in[11]; p.ln_b = (const float*)d_in[12];
    p.out = (float*)d_out; p.ws = (unsigned char*)d_ws;
    void* args[] = {&p};
    hipError_t e = hipLaunchCooperativeKernel((const void*)fwd_kernel, dim3(grid_blocks), dim3(512), args, LDS_BYTES, stream);
    if (e != hipSuccess) fprintf(stderr, "cooperative launch failed: %s (grid %d)\n", hipGetErrorString(e), grid_blocks);
}
```

```cpp
#include <hip/hip_runtime.h>
#include <hip/hip_cooperative_groups.h>
#include <cstdio>
#include <cstdint>
namespace cg = cooperative_groups;

#define LAS __attribute__((address_space(3)))
typedef unsigned short bf16_t;
typedef short bf16x8 __attribute__((ext_vector_type(8)));
typedef float f32x4 __attribute__((ext_vector_type(4)));
typedef float f32x2 __attribute__((ext_vector_type(2)));
typedef unsigned u32x4 __attribute__((ext_vector_type(4)));
typedef unsigned u32x2 __attribute__((ext_vector_type(2)));
typedef __bf16 bf16x2_t __attribute__((ext_vector_type(2)));

constexpr int DM = 1024, NB = 8, SEQ = 2048, DECB = 32, DECT = 4;
constexpr int NMEM = 256, DIN = 4608, DMIX = 1536;
constexpr int M_PROMPT = NB * SEQ;
constexpr int M_SAMPLE = DECB * DECT;
constexpr int ROWS_IN = M_PROMPT + 256;
constexpr int ROWS_ALL = ROWS_IN + NB * NMEM;
constexpr int HP = DIN;
constexpr int C_RQ = 0, C_RK = 256, C_RV = 512, C_RG = 1024, C_SQ = 1536, C_SK = 2048, C_SV = 2560, C_SG = 3072, C_MQ = 3584, C_MG = 4096;
constexpr size_t O_YP = 0, O_YS = 16777216, O_RP = 16908288, O_RS = 17170432, O_KP = 18219008, O_VP = 26607616,
                 O_KS = 34996224, O_VS = 35061760, O_MK = 35127296, O_MV = 36175872;
constexpr size_t MiB = 1u << 20;
constexpr size_t WS_CTL = 0, WS_ROPE = 1 * MiB, WS_WTIN = 2 * MiB, WS_WTMKV = 12 * MiB, WS_WTOUT = 14 * MiB,
                 WS_XB = 20 * MiB, WS_HB = 64 * MiB, WS_MKV = 212 * MiB, WS_MIX = 216 * MiB, WS_END = 268 * MiB;
constexpr int LDS_BYTES = 163840;
constexpr float LOG2E = 1.4426950408889634f;
constexpr float SQ_SCALE = 0.18033688011112042f;
constexpr float MQ_SCALE = 0.12751743082459868f;
constexpr float ALPHA = 1.189207115002721f;

struct Params {
    const float *x_prompt, *x_sample, *state_ret, *cache_k, *cache_v, *cmem_k, *cmem_v, *mem_prompt, *w_in, *w_mkv, *w_out, *ln_g, *ln_b;
    float* out;
    unsigned char* ws;
};

__device__ __forceinline__ unsigned pk_bf16(float lo, float hi) { f32x2 v = {lo, hi}; bf16x2_t b = __builtin_convertvector(v, bf16x2_t); return __builtin_bit_cast(unsigned, b); }
__device__ __forceinline__ float bf_lo(unsigned u) { return __uint_as_float(u << 16); }
__device__ __forceinline__ float bf_hi(unsigned u) { return __uint_as_float(u & 0xffff0000u); }
__device__ __forceinline__ float bf2f(bf16_t h) { return __uint_as_float(((unsigned)h) << 16); }
__device__ __forceinline__ float fexp2(float x) { return __builtin_amdgcn_exp2f(x); }
__device__ __forceinline__ float frcp(float x) { return __builtin_amdgcn_rcpf(x); }
__device__ __forceinline__ float silu(float x) { return x * frcp(1.0f + fexp2(-x * LOG2E)); }
__device__ __forceinline__ float wave_max(float v) {
#pragma unroll
    for (int o = 1; o < 64; o <<= 1) v = fmaxf(v, __shfl_xor(v, o));
    return v;
}
__device__ __forceinline__ float wave_sum(float v) {
#pragma unroll
    for (int o = 1; o < 64; o <<= 1) v += __shfl_xor(v, o);
    return v;
}
#define LDS_WAIT() asm volatile("s_waitcnt lgkmcnt(0)" ::: "memory")
__device__ __forceinline__ int perm32(int rho) { const int n = rho >> 4, i = rho & 15; return 8 * (i >> 2) + 4 * n + (i & 3); }
__device__ __forceinline__ int dmap(int p) { return 16 * (p >> 5) + 32 * ((p >> 2) & 1) + 4 * ((p >> 3) & 3) + (p & 3); }
__device__ __forceinline__ int src_col_in(int c) {
    const int rho = c & 31;
    const bool rope = (c < 512) || (c >= 1536 && c < 2560);
    if (rope) return (c & ~63) + 16 * ((c >> 5) & 1) + 32 * (rho >> 4) + (rho & 15);
    return (c & ~31) + perm32(rho);
}

__device__ __forceinline__ void transpose_item(const float* W, int K, int N, bf16_t* WT, int mode, LAS float* scr, int item, int lane) {
    const int nblk = N / 32, kb = item / nblk, nb = item % nblk, k0 = 64 * kb, n0 = 32 * nb;
    const int cl = lane & 31;
    const int sc = (mode == 0) ? (n0 + cl) : (mode == 1) ? (n0 + perm32(cl)) : src_col_in(n0 + cl);
#pragma unroll 8
    for (int i = 0; i < 32; ++i) { const int kk = 2 * i + (lane >> 5); scr[kk * 33 + cl] = W[(size_t)(k0 + kk) * N + sc]; }
    LDS_WAIT();
    const int c = lane & 7;
#pragma unroll
    for (int j = 0; j < 4; ++j) {
        const int n = (lane >> 3) + 8 * j; const LAS float* s = scr + (8 * c) * 33 + n;
        u32x4 o; o.x = pk_bf16(s[0 * 33], s[1 * 33]); o.y = pk_bf16(s[2 * 33], s[3 * 33]); o.z = pk_bf16(s[4 * 33], s[5 * 33]); o.w = pk_bf16(s[6 * 33], s[7 * 33]);
        *(u32x4*)(WT + (size_t)(n0 + n) * K + k0 + 8 * c) = o;
    }
    LDS_WAIT();
}
__device__ __forceinline__ void sincos_d(double a, float& s, float& c) {
    const double kd = __builtin_rint(a * 0.63661977236758134308);
    double y = __builtin_fma(-kd, 1.57079632679489655800e+00, a); y = __builtin_fma(-kd, 6.12323399573676603587e-17, y);
    const double y2 = y * y;
    const double sp = y * (1.0 + y2 * (-1.0 / 6 + y2 * (1.0 / 120 + y2 * (-1.0 / 5040 + y2 * (1.0 / 362880 + y2 * (-1.0 / 39916800 + y2 * (1.0 / 6227020800.0)))))));
    const double cp = 1.0 + y2 * (-0.5 + y2 * (1.0 / 24 + y2 * (-1.0 / 720 + y2 * (1.0 / 40320 + y2 * (-1.0 / 3628800 + y2 * (1.0 / 479001600.0))))));
    const int k = ((int)kd) & 3;
    const double sv = (k == 0) ? sp : (k == 1) ? cp : (k == 2) ? -sp : -cp;
    const double cv = (k == 0) ? cp : (k == 1) ? -sp : (k == 2) ? -cp : sp;
    s = (float)sv; c = (float)cv;
}
__device__ __forceinline__ void phase0(const Params& P, LAS unsigned char* lds, int tid, int lane, int wave) {
    unsigned char* ws = P.ws;
    const int gw = blockIdx.x * 8 + wave, NGW = gridDim.x * 8;
    LAS float* scr = (LAS float*)(lds + wave * 8448);
    constexpr int I_IN = (DM / 64) * (DIN / 32), I_MKV = (DM / 64) * (1024 / 32), I_OUT = (DMIX / 64) * (DM / 32);
    for (int it = gw; it < I_IN + I_MKV + I_OUT; it += NGW) {
        int r = it;
        if (r < I_IN) { transpose_item(P.w_in, DM, DIN, (bf16_t*)(ws + WS_WTIN), 2, scr, r, lane); continue; } r -= I_IN;
        if (r < I_MKV) { transpose_item(P.w_mkv, DM, 1024, (bf16_t*)(ws + WS_WTMKV), 1, scr, r, lane); continue; } r -= I_MKV;
        transpose_item(P.w_out, DMIX, DM, (bf16_t*)(ws + WS_WTOUT), 0, scr, r, lane);
    }
    bf16_t* XB = (bf16_t*)(ws + WS_XB);
    for (int m = gw; m < ROWS_ALL; m += NGW) {
        const float* src = (m < M_PROMPT) ? P.x_prompt + (size_t)m * DM : (m < M_PROMPT + M_SAMPLE) ? P.x_sample + (size_t)(m - M_PROMPT) * DM
                         : (m < ROWS_IN) ? nullptr : P.mem_prompt + (size_t)(m - ROWS_IN) * DM;
        u32x2* dst = (u32x2*)(XB + (size_t)m * DM) + lane;
#pragma unroll
        for (int j = 0; j < 4; ++j) {
            f32x4 v = {0.f, 0.f, 0.f, 0.f};
            if (src) v = ((const f32x4*)src)[lane + 64 * j];
            u32x2 o; o.x = pk_bf16(v.x, v.y); o.y = pk_bf16(v.z, v.w); dst[64 * j] = o;
        }
    }
    float* rope = (float*)(ws + WS_ROPE);
    for (int e = blockIdx.x * 512 + tid; e < 2052 * 32; e += gridDim.x * 512) {
        const int idx = e >> 5, i = e & 31;
        const int pos = idx < 2048 ? idx : 8192 + (idx - 2048);
        double inv = 1.0;
        for (int k = 0; k < i; ++k) inv *= 0.7498942093324559;
        float s, c; sincos_d((double)pos * inv, s, c);
        rope[2 * e] = c; rope[2 * e + 1] = s;
    }
}

template <int K>
__device__ __forceinline__ void gemm_mainloop(const bf16_t* __restrict__ A, const bf16_t* __restrict__ Bt, LAS unsigned char* lds,
                                              f32x4 (&acc)[2][2][4][2], int tid, int wr, int wc, int fr, int fq) {
    constexpr int PITCH = 144;
    LAS unsigned char* As = lds; LAS unsigned char* Bs = lds + 256 * PITCH;
    const int lrow = tid >> 3, lch = tid & 7;
    const bf16_t* ga = A + (size_t)lrow * K + lch * 8;
    const bf16_t* gb = Bt + (size_t)lrow * K + lch * 8;
    u32x4 ra[4], rb[4];
#pragma unroll
    for (int i = 0; i < 4; ++i) { ra[i] = *(const u32x4*)(ga + (size_t)i * 64 * K); rb[i] = *(const u32x4*)(gb + (size_t)i * 64 * K); }
#pragma unroll
    for (int a = 0; a < 2; ++a)
#pragma unroll
        for (int b = 0; b < 2; ++b)
#pragma unroll
            for (int m = 0; m < 4; ++m)
#pragma unroll
                for (int n = 0; n < 2; ++n) acc[a][b][m][n] = (f32x4){0.f, 0.f, 0.f, 0.f};
    for (int kt = 0; kt < K / 64; ++kt) {
        __syncthreads();
#pragma unroll
        for (int i = 0; i < 4; ++i) {
            *(LAS u32x4*)(As + (lrow + 64 * i) * PITCH + lch * 16) = ra[i];
            *(LAS u32x4*)(Bs + (lrow + 64 * i) * PITCH + lch * 16) = rb[i];
        }
        __syncthreads();
        if (kt + 1 < K / 64) {
#pragma unroll
            for (int i = 0; i < 4; ++i) { ra[i] = *(const u32x4*)(ga + (size_t)i * 64 * K + (kt + 1) * 64); rb[i] = *(const u32x4*)(gb + (size_t)i * 64 * K + (kt + 1) * 64); }
        }
#pragma unroll
        for (int ai = 0; ai < 2; ++ai) {
#pragma unroll
            for (int k = 0; k < 2; ++k) {
                bf16x8 At[4];
#pragma unroll
                for (int m = 0; m < 4; ++m) At[m] = *(const LAS bf16x8*)(As + (ai * 128 + wr * 64 + m * 16 + fr) * PITCH + (k * 32 + fq * 8) * 2);
#pragma unroll
                for (int bj = 0; bj < 2; ++bj) {
                    bf16x8 Bf[2];
#pragma unroll
                    for (int n = 0; n < 2; ++n) Bf[n] = *(const LAS bf16x8*)(Bs + (bj * 128 + wc * 32 + n * 16 + fr) * PITCH + (k * 32 + fq * 8) * 2);
#pragma unroll
                    for (int m = 0; m < 4; ++m)
#pragma unroll
                        for (int n = 0; n < 2; ++n) acc[ai][bj][m][n] = __builtin_amdgcn_mfma_f32_16x16x32_bf16(Bf[n], At[m], acc[ai][bj][m][n], 0, 0, 0);
                }
            }
        }
    }
}

__device__ __forceinline__ void epi_inproj(const f32x4 (&acc)[2][2][4][2], int pm, int pn, const Params& P, int wr, int wc, int fr, int fq) {
    bf16_t* HB = (bf16_t*)(P.ws + WS_HB);
    const float* rope = (const float*)(P.ws + WS_ROPE);
    int type = 0; float scale = 1.0f; int f32out = 0;
    if (pn == 0) { type = 1; }
    else if (pn == 1) { type = 1; scale = 0.125f; }
    else if (pn == 4 || pn == 5 || pn == 12 || pn == 13 || pn == 16 || pn == 17) { type = 2; }
    else if (pn == 6 || pn == 7) { type = 1; scale = SQ_SCALE; }
    else if (pn == 8 || pn == 9) { type = 1; f32out = 1; }
    else if (pn == 10 || pn == 11) { f32out = 2; }
    else if (pn == 14 || pn == 15) { scale = MQ_SCALE; }
#pragma unroll
    for (int ai = 0; ai < 2; ++ai)
#pragma unroll
        for (int m = 0; m < 4; ++m) {
            const int r = pm * 256 + ai * 128 + wr * 64 + m * 16 + fr;
            const int pi = r < M_PROMPT ? (r & 2047) : 2048 + ((r - M_PROMPT) & 3);
            const bool live = r < M_PROMPT + M_SAMPLE;
#pragma unroll
            for (int bj = 0; bj < 2; ++bj) {
                const int cb = pn * 256 + bj * 128 + wc * 32;
                f32x4 v0 = acc[ai][bj][m][0], v1 = acc[ai][bj][m][1];
                if (type == 1) {
                    const int d1 = 16 * ((cb >> 5) & 1) + 4 * fq;
                    const f32x4* rp = (const f32x4*)(rope + ((size_t)pi * 32 + d1) * 2);
                    const f32x4 cs0 = rp[0], cs1 = rp[1];
                    f32x4 y1, y2;
                    y1[0] = v0[0] * cs0[0] - v1[0] * cs0[1]; y2[0] = v1[0] * cs0[0] + v0[0] * cs0[1];
                    y1[1] = v0[1] * cs0[2] - v1[1] * cs0[3]; y2[1] = v1[1] * cs0[2] + v0[1] * cs0[3];
                    y1[2] = v0[2] * cs1[0] - v1[2] * cs1[1]; y2[2] = v1[2] * cs1[0] + v0[2] * cs1[1];
                    y1[3] = v0[3] * cs1[2] - v1[3] * cs1[3]; y2[3] = v1[3] * cs1[2] + v0[3] * cs1[3];
                    if (f32out == 1 && live) {
                        float* o = (r < M_PROMPT ? P.out + O_KP + (size_t)r * 512 : P.out + O_KS + (size_t)(r - M_PROMPT) * 512) + ((cb - C_SK) >> 6) * 64 + d1;
                        *(f32x4*)o = y1; *(f32x4*)(o + 32) = y2;
                    }
                    v0 = y1 * scale; v1 = y2 * scale;
                } else if (type == 2) {
#pragma unroll
                    for (int e = 0; e < 4; ++e) { v0[e] = silu(v0[e]); v1[e] = silu(v1[e]); }
                } else {
                    if (f32out == 2 && live) {
                        float* o = (r < M_PROMPT ? P.out + O_VP + (size_t)r * 512 : P.out + O_VS + (size_t)(r - M_PROMPT) * 512) + (cb - C_SV) + 8 * fq;
                        *(f32x4*)o = v0; *(f32x4*)(o + 4) = v1;
                    }
                    v0 = v0 * scale; v1 = v1 * scale;
                }
                u32x4 w; w.x = pk_bf16(v0[0], v0[1]); w.y = pk_bf16(v0[2], v0[3]); w.z = pk_bf16(v1[0], v1[1]); w.w = pk_bf16(v1[2], v1[3]);
                *(u32x4*)(HB + (size_t)r * HP + cb + 8 * fq) = w;
            }
        }
}
__device__ __forceinline__ void epi_memkv(const f32x4 (&acc)[2][2][4][2], int pm, int pn, const Params& P, int wr, int wc, int fr, int fq) {
    bf16_t* MKV = (bf16_t*)(P.ws + WS_MKV);
#pragma unroll
    for (int ai = 0; ai < 2; ++ai)
#pragma unroll
        for (int m = 0; m < 4; ++m) {
            const int r = pm * 256 + ai * 128 + wr * 64 + m * 16 + fr;
#pragma unroll
            for (int bj = 0; bj < 2; ++bj) {
                const int c0 = pn * 256 + bj * 128 + wc * 32 + 8 * fq;
                const f32x4 v0 = acc[ai][bj][m][0], v1 = acc[ai][bj][m][1];
                float* o = (c0 < 512) ? P.out + O_MK + (size_t)r * 512 + c0 : P.out + O_MV + (size_t)r * 512 + (c0 - 512);
                *(f32x4*)o = v0; *(f32x4*)(o + 4) = v1;
                u32x4 w; w.x = pk_bf16(v0[0], v0[1]); w.y = pk_bf16(v0[2], v0[3]); w.z = pk_bf16(v1[0], v1[1]); w.w = pk_bf16(v1[2], v1[3]);
                *(u32x4*)(MKV + (size_t)r * 1024 + c0) = w;
            }
        }
}
__device__ __forceinline__ void epi_outproj(const f32x4 (&acc)[2][2][4][2], int pm, int pn, const Params& P, int wr, int wc, int fr, int fq) {
#pragma unroll
    for (int ai = 0; ai < 2; ++ai)
#pragma unroll
        for (int m = 0; m < 4; ++m) {
            const int r = pm * 256 + ai * 128 + wr * 64 + m * 16 + fr;
            if (r >= M_PROMPT + M_SAMPLE) continue;
            const float* xr = r < M_PROMPT ? P.x_prompt + (size_t)r * DM : P.x_sample + (size_t)(r - M_PROMPT) * DM;
            float* zr = r < M_PROMPT ? P.out + O_YP + (size_t)r * DM : P.out + O_YS + (size_t)(r - M_PROMPT) * DM;
#pragma unroll
            for (int bj = 0; bj < 2; ++bj)
#pragma unroll
                for (int n = 0; n < 2; ++n) {
                    const int c = pn * 256 + bj * 128 + wc * 32 + 16 * n + 4 * fq;
                    const f32x4 xv = *(const f32x4*)(xr + c);
                    *(f32x4*)(zr + c) = xv * ALPHA + acc[ai][bj][m][n];
                }
        }
}

__device__ __forceinline__ void ret_scan(const Params& P, LAS unsigned char* lds, int b, int h, int row0, int ntok, const float* init, float* outstate, int tid) {
    const bf16_t* HB = (const bf16_t*)(P.ws + WS_HB);
    bf16_t* MIX = (bf16_t*)(P.ws + WS_MIX);
    LAS float* qs = (LAS float*)lds;
    LAS float* ks = qs + 32 * 64;
    LAS float* vs = ks + 32 * 64;
    LAS float* po = vs + 32 * 128;
    const int vv = tid & 127, kq = tid >> 7;
    const float gamma = 1.0f - __builtin_amdgcn_exp2f((float)(-5 - h));
    float S[16];
#pragma unroll
    for (int j = 0; j < 16; ++j) S[j] = init ? init[((size_t)((b * 4 + h) * 64 + dmap(16 * kq + j))) * 128 + vv] : 0.f;
    for (int t0 = 0; t0 < ntok; t0 += 32) {
        const int nb = (ntok - t0) < 32 ? (ntok - t0) : 32;
        __syncthreads();
        {
            const int tt = (tid & 255) >> 3, ch = tid & 7;
            if (tt < nb) {
                const u32x4 w = *(const u32x4*)(HB + (size_t)(row0 + t0 + tt) * HP + (tid < 256 ? C_RQ : C_RK) + h * 64 + ch * 8);
                LAS float* dst = (tid < 256 ? qs : ks) + tt * 64 + ch * 8;
                dst[0] = bf_lo(w.x); dst[1] = bf_hi(w.x); dst[2] = bf_lo(w.y); dst[3] = bf_hi(w.y);
                dst[4] = bf_lo(w.z); dst[5] = bf_hi(w.z); dst[6] = bf_lo(w.w); dst[7] = bf_hi(w.w);
            }
            const int tv = tid >> 4, cv = tid & 15;
            if (tv < nb) {
                const u32x4 w = *(const u32x4*)(HB + (size_t)(row0 + t0 + tv) * HP + C_RV + h * 128 + cv * 8);
                LAS float* dst = vs + tv * 128 + cv * 8;
                dst[0] = bf_lo(w.x); dst[1] = bf_hi(w.x); dst[2] = bf_lo(w.y); dst[3] = bf_hi(w.y);
                dst[4] = bf_lo(w.z); dst[5] = bf_hi(w.z); dst[6] = bf_lo(w.w); dst[7] = bf_hi(w.w);
            }
        }
        __syncthreads();
        for (int tt = 0; tt < nb; ++tt) {
            const float vval = vs[tt * 128 + vv];
            float o = 0.f;
#pragma unroll
            for (int j4 = 0; j4 < 4; ++j4) {
                const f32x4 k4 = *(const LAS f32x4*)(ks + tt * 64 + 16 * kq + 4 * j4);
                const f32x4 q4 = *(const LAS f32x4*)(qs + tt * 64 + 16 * kq + 4 * j4);
#pragma unroll
                for (int e = 0; e < 4; ++e) { S[4 * j4 + e] = fmaf(gamma, S[4 * j4 + e], k4[e] * vval); o = fmaf(q4[e], S[4 * j4 + e], o); }
            }
            po[(tt * 4 + kq) * 128 + vv] = o;
        }
        __syncthreads();
        {
            const int tf = tid >> 4, c8 = (tid & 15) * 8;
            float o[8]; float s = 0.f;
#pragma unroll
            for (int e = 0; e < 8; ++e) { o[e] = (po[(tf * 4 + 0) * 128 + c8 + e] + po[(tf * 4 + 1) * 128 + c8 + e]) + (po[(tf * 4 + 2) * 128 + c8 + e] + po[(tf * 4 + 3) * 128 + c8 + e]); s += o[e]; }
            s += __shfl_xor(s, 1); s += __shfl_xor(s, 2); s += __shfl_xor(s, 4); s += __shfl_xor(s, 8);
            const float mean = s * (1.0f / 128.0f);
            float q = 0.f;
#pragma unroll
            for (int e = 0; e < 8; ++e) { o[e] -= mean; q += o[e] * o[e]; }
            q += __shfl_xor(q, 1); q += __shfl_xor(q, 2); q += __shfl_xor(q, 4); q += __shfl_xor(q, 8);
            const float rstd = 1.0f / sqrtf(q * (1.0f / 128.0f) + 1e-5f);
            if (tf < nb) {
                const size_t row = (size_t)(row0 + t0 + tf);
                const u32x4 g = *(const u32x4*)(HB + row * HP + C_RG + h * 128 + c8);
                u32x4 w;
                w.x = pk_bf16(o[0] * rstd * bf_lo(g.x), o[1] * rstd * bf_hi(g.x)); w.y = pk_bf16(o[2] * rstd * bf_lo(g.y), o[3] * rstd * bf_hi(g.y));
                w.z = pk_bf16(o[4] * rstd * bf_lo(g.z), o[5] * rstd * bf_hi(g.z)); w.w = pk_bf16(o[6] * rstd * bf_lo(g.w), o[7] * rstd * bf_hi(g.w));
                *(u32x4*)(MIX + row * DMIX + h * 128 + c8) = w;
            }
        }
    }
    __syncthreads();
#pragma unroll
    for (int j = 0; j < 16; ++j) outstate[((size_t)((b * 4 + h) * 64 + dmap(16 * kq + j))) * 128 + vv] = S[j];
}

__device__ __forceinline__ void swa_prompt_naive(const Params& P, int b, int h, int t) {
    const bf16_t* HB = (const bf16_t*)(P.ws + WS_HB);
    bf16_t* MIX = (bf16_t*)(P.ws + WS_MIX);
    const size_t R = (size_t)b * SEQ + t;
    u32x4 q4[8];
    { const u32x4* qp = (const u32x4*)(HB + R * HP + C_SQ + h * 64);
#pragma unroll
      for (int c = 0; c < 8; ++c) q4[c] = qp[c]; }
    float acc[64];
#pragma unroll
    for (int d = 0; d < 64; ++d) acc[d] = 0.f;
    float mrun = -INFINITY, lrun = 0.f;
#pragma unroll 1
    for (int g = 0; g < 3; ++g) {
        const int dil = (g == 0) ? 1 : (g == 1) ? 4 : 16;
#pragma unroll 1
        for (int s = 0; s <= 128; ++s) {
            const int tk = t - s * dil;
            const bool valid = tk >= 0;
            const size_t Rk = (size_t)b * SEQ + (valid ? tk : 0);
            const u32x4* kp = (const u32x4*)(HB + Rk * HP + C_SK + h * 64);
            const u32x4* vp = (const u32x4*)(HB + Rk * HP + C_SV + h * 64);
            u32x4 kk[8], vv[8];
#pragma unroll
            for (int c = 0; c < 8; ++c) { kk[c] = kp[c]; vv[c] = vp[c]; }
            float dot = 0.f;
#pragma unroll
            for (int c = 0; c < 8; ++c) {
                dot += bf_lo(q4[c].x) * bf_lo(kk[c].x) + bf_hi(q4[c].x) * bf_hi(kk[c].x) + bf_lo(q4[c].y) * bf_lo(kk[c].y) + bf_hi(q4[c].y) * bf_hi(kk[c].y)
                     + bf_lo(q4[c].z) * bf_lo(kk[c].z) + bf_hi(q4[c].z) * bf_hi(kk[c].z) + bf_lo(q4[c].w) * bf_lo(kk[c].w) + bf_hi(q4[c].w) * bf_hi(kk[c].w);
            }
            const float sc = valid ? dot : -INFINITY;
            const float mn = fmaxf(mrun, sc);
            const float f = fexp2(mrun - mn), p = fexp2(sc - mn);
            mrun = mn; lrun = lrun * f + p;
#pragma unroll
            for (int c = 0; c < 8; ++c) {
                acc[8 * c + 0] = acc[8 * c + 0] * f + p * bf_lo(vv[c].x); acc[8 * c + 1] = acc[8 * c + 1] * f + p * bf_hi(vv[c].x);
                acc[8 * c + 2] = acc[8 * c + 2] * f + p * bf_lo(vv[c].y); acc[8 * c + 3] = acc[8 * c + 3] * f + p * bf_hi(vv[c].y);
                acc[8 * c + 4] = acc[8 * c + 4] * f + p * bf_lo(vv[c].z); acc[8 * c + 5] = acc[8 * c + 5] * f + p * bf_hi(vv[c].z);
                acc[8 * c + 6] = acc[8 * c + 6] * f + p * bf_lo(vv[c].w); acc[8 * c + 7] = acc[8 * c + 7] * f + p * bf_hi(vv[c].w);
            }
        }
    }
    const float rl = 1.0f / lrun;
    const u32x4* gp = (const u32x4*)(HB + R * HP + C_SG + h * 64);
    u32x4* op = (u32x4*)(MIX + R * DMIX + 512 + h * 64);
#pragma unroll
    for (int c = 0; c < 8; ++c) {
        const u32x4 g = gp[c]; u32x4 w;
        w.x = pk_bf16(acc[8 * c + 0] * rl * bf_lo(g.x), acc[8 * c + 1] * rl * bf_hi(g.x)); w.y = pk_bf16(acc[8 * c + 2] * rl * bf_lo(g.y), acc[8 * c + 3] * rl * bf_hi(g.y));
        w.z = pk_bf16(acc[8 * c + 4] * rl * bf_lo(g.z), acc[8 * c + 5] * rl * bf_hi(g.z)); w.w = pk_bf16(acc[8 * c + 6] * rl * bf_lo(g.w), acc[8 * c + 7] * rl * bf_hi(g.w));
        op[c] = w;
    }
}

__device__ __forceinline__ void mem_prompt_naive(const Params& P, int b, int h, int t, int half) {
    const bf16_t* HB = (const bf16_t*)(P.ws + WS_HB);
    const bf16_t* MKV = (const bf16_t*)(P.ws + WS_MKV);
    bf16_t* MIX = (bf16_t*)(P.ws + WS_MIX);
    const size_t R = (size_t)b * SEQ + t;
    u32x4 q4[8];
    { const u32x4* qp = (const u32x4*)(HB + R * HP + C_MQ + h * 128 + half * 64);
#pragma unroll
      for (int c = 0; c < 8; ++c) q4[c] = qp[c]; }
    float acc[64];
#pragma unroll
    for (int d = 0; d < 64; ++d) acc[d] = 0.f;
    float mrun = -INFINITY, lrun = 0.f;
#pragma unroll 1
    for (int m = 0; m < NMEM; ++m) {
        const size_t Rk = (size_t)b * NMEM + m;
        const u32x4* kp = (const u32x4*)(MKV + Rk * 1024 + h * 128 + half * 64);
        const u32x4* vp = (const u32x4*)(MKV + Rk * 1024 + 512 + h * 128 + half * 64);
        u32x4 kk[8], vv[8];
#pragma unroll
        for (int c = 0; c < 8; ++c) { kk[c] = kp[c]; vv[c] = vp[c]; }
        float dot = 0.f;
#pragma unroll
        for (int c = 0; c < 8; ++c) {
            dot += bf_lo(q4[c].x) * bf_lo(kk[c].x) + bf_hi(q4[c].x) * bf_hi(kk[c].x) + bf_lo(q4[c].y) * bf_lo(kk[c].y) + bf_hi(q4[c].y) * bf_hi(kk[c].y)
                 + bf_lo(q4[c].z) * bf_lo(kk[c].z) + bf_hi(q4[c].z) * bf_hi(kk[c].z) + bf_lo(q4[c].w) * bf_lo(kk[c].w) + bf_hi(q4[c].w) * bf_hi(kk[c].w);
        }
        const float sc = dot + __shfl_xor(dot, 1);
        const float mn = fmaxf(mrun, sc);
        const float f = fexp2(mrun - mn), p = fexp2(sc - mn);
        mrun = mn; lrun = lrun * f + p;
#pragma unroll
        for (int c = 0; c < 8; ++c) {
            acc[8 * c + 0] = acc[8 * c + 0] * f + p * bf_lo(vv[c].x); acc[8 * c + 1] = acc[8 * c + 1] * f + p * bf_hi(vv[c].x);
            acc[8 * c + 2] = acc[8 * c + 2] * f + p * bf_lo(vv[c].y); acc[8 * c + 3] = acc[8 * c + 3] * f + p * bf_hi(vv[c].y);
            acc[8 * c + 4] = acc[8 * c + 4] * f + p * bf_lo(vv[c].z); acc[8 * c + 5] = acc[8 * c + 5] * f + p * bf_hi(vv[c].z);
            acc[8 * c + 6] = acc[8 * c + 6] * f + p * bf_lo(vv[c].w); acc[8 * c + 7] = acc[8 * c + 7] * f + p * bf_hi(vv[c].w);
        }
    }
    const float rl = 1.0f / lrun;
    const u32x4* gp = (const u32x4*)(HB + R * HP + C_MG + h * 128 + half * 64);
    u32x4* op = (u32x4*)(MIX + R * DMIX + 1024 + h * 128 + half * 64);
#pragma unroll
    for (int c = 0; c < 8; ++c) {
        const u32x4 g = gp[c]; u32x4 w;
        w.x = pk_bf16(acc[8 * c + 0] * rl * bf_lo(g.x), acc[8 * c + 1] * rl * bf_hi(g.x)); w.y = pk_bf16(acc[8 * c + 2] * rl * bf_lo(g.y), acc[8 * c + 3] * rl * bf_hi(g.y));
        w.z = pk_bf16(acc[8 * c + 4] * rl * bf_lo(g.z), acc[8 * c + 5] * rl * bf_hi(g.z)); w.w = pk_bf16(acc[8 * c + 6] * rl * bf_lo(g.w), acc[8 * c + 7] * rl * bf_hi(g.w));
        op[c] = w;
    }
}

__device__ __forceinline__ void swa_sample_wave(const Params& P, LAS float* wsc, int b, int h, int i, int lane) {
    const bf16_t* HB = (const bf16_t*)(P.ws + WS_HB);
    bf16_t* MIX = (bf16_t*)(P.ws + WS_MIX);
    const size_t R = (size_t)M_PROMPT + b * 4 + i;
    LAS float* qo = wsc;
    LDS_WAIT();
    qo[dmap(lane)] = bf2f(HB[R * HP + C_SQ + h * 64 + lane]);
    LDS_WAIT();
    float Mrun = -INFINITY, Wsum = 0.f, Nsum = 0.f;
#pragma unroll 1
    for (int g = 0; g < 3; ++g) {
        const int dil = (g == 0) ? 1 : (g == 1) ? 4 : 16;
        float sc[3];
#pragma unroll
        for (int rd = 0; rd < 3; ++rd) {
            const int s = lane + 64 * rd;
            float dot = -INFINITY;
            if (s <= 128) {
                const int idx = 2048 + i - dil * s;
                float a = 0.f;
                if (idx < 2048) {
                    const f32x4* kc = (const f32x4*)(P.cache_k + (((size_t)b * 2048 + idx) * 8 + h) * 64);
#pragma unroll
                    for (int c = 0; c < 16; ++c) { const f32x4 kv = kc[c]; const f32x4 qv = *(const LAS f32x4*)(qo + 4 * c); a += kv[0] * qv[0] + kv[1] * qv[1] + kv[2] * qv[2] + kv[3] * qv[3]; }
                } else {
                    const bf16_t* kn = HB + ((size_t)M_PROMPT + b * 4 + (idx - 2048)) * HP + C_SK + h * 64;
#pragma unroll 1
                    for (int p = 0; p < 64; ++p) a += qo[dmap(p)] * bf2f(kn[p]);
                }
                dot = a;
            }
            sc[rd] = dot;
        }
        const float m = wave_max(fmaxf(fmaxf(sc[0], sc[1]), sc[2]));
        const float p0 = fexp2(sc[0] - m), p1 = fexp2(sc[1] - m), p2 = fexp2(sc[2] - m);
        const float l = wave_sum(p0 + p1 + p2);
        float a = 0.f;
#pragma unroll 1
        for (int s0 = 0; s0 < 136; s0 += 8) {
            const float psel = (s0 < 64) ? p0 : (s0 < 128) ? p1 : p2;
            float vv[8];
#pragma unroll
            for (int e = 0; e < 8; ++e) {
                const int s = (s0 + e) < 128 ? (s0 + e) : 128;
                const int idx = 2048 + i - dil * s;
                vv[e] = (idx < 2048) ? P.cache_v[(((size_t)b * 2048 + idx) * 8 + h) * 64 + lane]
                                     : bf2f(HB[((size_t)M_PROMPT + b * 4 + (idx - 2048)) * HP + C_SV + h * 64 + lane]);
            }
#pragma unroll
            for (int e = 0; e < 8; ++e) a += __shfl(psel, (s0 + e) & 63) * vv[e];
        }
        const float mn = fmaxf(Mrun, m);
        const float f = fexp2(Mrun - mn), fg = fexp2(m - mn);
        Nsum = Nsum * f + a * fg; Wsum = Wsum * f + l * fg; Mrun = mn;
    }
    const float o = Nsum / Wsum;
    const float gate = bf2f(HB[R * HP + C_SG + h * 64 + lane]);
    MIX[R * DMIX + 512 + h * 64 + lane] = (bf16_t)(pk_bf16(o * gate, 0.f) & 0xffffu);
}

__device__ __forceinline__ void mem_sample_wave(const Params& P, LAS float* wsc, int b, int h, int i, int lane) {
    const bf16_t* HB = (const bf16_t*)(P.ws + WS_HB);
    bf16_t* MIX = (bf16_t*)(P.ws + WS_MIX);
    const size_t R = (size_t)M_PROMPT + b * 4 + i;
    LAS float* qm = wsc;
    LDS_WAIT();
    qm[lane] = bf2f(HB[R * HP + C_MQ + h * 128 + lane]); qm[64 + lane] = bf2f(HB[R * HP + C_MQ + h * 128 + 64 + lane]);
    LDS_WAIT();
    float sc[4];
#pragma unroll
    for (int rd = 0; rd < 4; ++rd) {
        const int m = lane + 64 * rd;
        const f32x4* kc = (const f32x4*)(P.cmem_k + (((size_t)b * NMEM + m) * 4 + h) * 128);
        float a = 0.f;
#pragma unroll
        for (int c = 0; c < 32; ++c) { const f32x4 kv = kc[c]; const f32x4 qv = *(const LAS f32x4*)(qm + 4 * c); a += kv[0] * qv[0] + kv[1] * qv[1] + kv[2] * qv[2] + kv[3] * qv[3]; }
        sc[rd] = a;
    }
    const float m = wave_max(fmaxf(fmaxf(sc[0], sc[1]), fmaxf(sc[2], sc[3])));
    const float p0 = fexp2(sc[0] - m), p1 = fexp2(sc[1] - m), p2 = fexp2(sc[2] - m), p3 = fexp2(sc[3] - m);
    const float l = wave_sum((p0 + p1) + (p2 + p3));
    float a0 = 0.f, a1 = 0.f;
#pragma unroll 1
    for (int s0 = 0; s0 < NMEM; s0 += 8) {
        const float psel = (s0 < 64) ? p0 : (s0 < 128) ? p1 : (s0 < 192) ? p2 : p3;
        f32x2 vv[8];
#pragma unroll
        for (int e = 0; e < 8; ++e) vv[e] = *(const f32x2*)(P.cmem_v + (((size_t)b * NMEM + s0 + e) * 4 + h) * 128 + 2 * lane);
#pragma unroll
        for (int e = 0; e < 8; ++e) { const float ps = __shfl(psel, (s0 + e) & 63); a0 += ps * vv[e][0]; a1 += ps * vv[e][1]; }
    }
    const float rl = 1.0f / l;
    const unsigned g = *(const unsigned*)(HB + R * HP + C_MG + h * 128 + 2 * lane);
    *(unsigned*)(MIX + R * DMIX + 1024 + h * 128 + 2 * lane) = pk_bf16(a0 * rl * bf_lo(g), a1 * rl * bf_hi(g));
}

typedef float f32x16 __attribute__((ext_vector_type(16)));
typedef short s16x4 __attribute__((ext_vector_type(4)));
constexpr int SWA_ST_O = 0, SWA_ST_M = 65536, SWA_ST_L = 65536 + 2048, SWA_WV = 69632, SWA_WV_STRIDE = 10240 + 256;
__device__ __forceinline__ s16x4 tr16(LAS unsigned char* p) { return __builtin_bit_cast(s16x4, __builtin_amdgcn_ds_read_tr16_b64_v4i16((LAS s16x4*)p)); }
__device__ __forceinline__ f32x16 mfma32(bf16x8 a, bf16x8 b, f32x16 c) { return __builtin_amdgcn_mfma_f32_32x32x16_bf16(a, b, c, 0, 0, 0); }
#define VM_WAIT() asm volatile("s_waitcnt vmcnt(0)" ::: "memory")

__device__ __forceinline__ void swa_task(const Params& P, LAS unsigned char* lds, int wave, int lane, int b, int h, int dil, int r, int i0, int pat, int T0) {
    const bf16_t* HB = (const bf16_t*)(P.ws + WS_HB);
    bf16_t* MIX = (bf16_t*)(P.ws + WS_MIX);
    const int a = lane & 31, hi = lane >> 5;
    LAS unsigned char* vreg = lds + SWA_WV + wave * SWA_WV_STRIDE;
    LAS float* msc = (LAS float*)(vreg + 10240);
    LAS float* lsc = msc + 32;
    const size_t rowbase = (size_t)b * SEQ + r;
    const int jmin = i0 >= 128 ? 0 : ((128 - i0) >> 5);
    const int vrow = ((lane >> 5) << 3) + ((lane >> 2) & 7), vch = lane & 3;
    const int trb = (4 * hi + ((lane & 15) >> 2)) * 64 + ((lane >> 4) & 1) * 32 + (lane & 3) * 8;

#define SWA_DMA_V(db) do { _Pragma("unroll") for (int j = 0; j < 5; ++j) if (j >= jmin) { _Pragma("unroll") for (int it2 = 0; it2 < 2; ++it2) { \
        const int ik = i0 - 128 + 32 * j + 16 * it2 + vrow; \
        __builtin_amdgcn_global_load_lds((const unsigned*)(HB + (rowbase + (size_t)dil * ik) * HP + C_SV + h * 64 + 32 * (db) + 8 * vch), \
                                         (LAS unsigned*)(vreg + j * 2048 + it2 * 1024), 16, 0, 0); } } } while (0)

    LDS_WAIT();
    SWA_DMA_V(0);
    bf16x8 qf[4];
    { const bf16_t* qp = HB + (rowbase + (size_t)dil * (i0 + a)) * HP + C_SQ + h * 64 + 8 * hi;
#pragma unroll
      for (int kk = 0; kk < 4; ++kk) qf[kk] = *(const bf16x8*)(qp + 16 * kk); }
    f32x16 S[5];
#pragma unroll
    for (int j = 0; j < 5; ++j) {
        if (j >= jmin) {
            const int ik = i0 - 128 + 32 * j + a;
            const bf16_t* kp = HB + (rowbase + (size_t)dil * ik) * HP + C_SK + h * 64 + 8 * hi;
            bf16x8 kf[4];
#pragma unroll
            for (int kk = 0; kk < 4; ++kk) kf[kk] = *(const bf16x8*)(kp + 16 * kk);
            f32x16 acc;
#pragma unroll
            for (int e = 0; e < 16; ++e) acc[e] = 0.f;
#pragma unroll
            for (int kk = 0; kk < 4; ++kk) acc = mfma32(kf[kk], qf[kk], acc);
            if (j == 0) {
#pragma unroll
                for (int e = 0; e < 16; ++e) { const int c = (e & 3) + 8 * (e >> 2) + 4 * hi; if (c < a) acc[e] = -INFINITY; }
            }
            if (j == 4) {
#pragma unroll
                for (int e = 0; e < 16; ++e) { const int c = (e & 3) + 8 * (e >> 2) + 4 * hi; if (c > a) acc[e] = -INFINITY; }
            }
            S[j] = acc;
        } else {
#pragma unroll
            for (int e = 0; e < 16; ++e) S[j][e] = -INFINITY;
        }
    }
    float mx = -INFINITY;
#pragma unroll
    for (int j = 0; j < 5; ++j)
#pragma unroll
        for (int e = 0; e < 16; ++e) mx = fmaxf(mx, S[j][e]);
    mx = fmaxf(mx, __shfl_xor(mx, 32));
    float lsum = 0.f;
    unsigned pa[5][2][4];
#pragma unroll
    for (int j = 0; j < 5; ++j) {
#pragma unroll
        for (int e = 0; e < 16; ++e) { const float p = fexp2(S[j][e] - mx); S[j][e] = p; lsum += p; }
#pragma unroll
        for (int s = 0; s < 2; ++s)
#pragma unroll
            for (int w = 0; w < 4; ++w) pa[j][s][w] = pk_bf16(S[j][8 * s + 2 * w], S[j][8 * s + 2 * w + 1]);
    }
    lsum += __shfl_xor(lsum, 32);
    if (hi == 0) { msc[a] = mx; lsc[a] = lsum; }
    LDS_WAIT();
    float fo[16], go[16], rl[16];
    LAS float* stM = (LAS float*)(lds + SWA_ST_M);
    LAS float* stL = (LAS float*)(lds + SWA_ST_L);
#pragma unroll
    for (int g4 = 0; g4 < 4; ++g4) {
        const f32x4 m4 = *(const LAS f32x4*)(msc + 8 * g4 + 4 * hi), l4 = *(const LAS f32x4*)(lsc + 8 * g4 + 4 * hi);
#pragma unroll
        for (int e = 0; e < 4; ++e) {
            const int c = 8 * g4 + 4 * hi + e;
            const int tok = r + dil * (i0 + c) - T0;
            if (pat == 0) { fo[4 * g4 + e] = 0.f; go[4 * g4 + e] = 1.f; rl[4 * g4 + e] = 1.f; if (a == 0) { stM[tok] = m4[e]; stL[tok] = l4[e]; } }
            else {
                const float Mo = stM[tok], Lo = stL[tok];
                const float Mn = fmaxf(Mo, m4[e]);
                const float f = fexp2(Mo - Mn), g = fexp2(m4[e] - Mn);
                const float Ln = Lo * f + l4[e] * g;
                fo[4 * g4 + e] = f; go[4 * g4 + e] = g; rl[4 * g4 + e] = 1.0f / Ln;
                if (pat == 1 && a == 0) { stM[tok] = Mn; stL[tok] = Ln; }
            }
        }
    }
#pragma unroll
    for (int db = 0; db < 2; ++db) {
        VM_WAIT();
        f32x16 O;
#pragma unroll
        for (int e = 0; e < 16; ++e) O[e] = 0.f;
#pragma unroll
        for (int j = 0; j < 5; ++j) if (j >= jmin) {
#pragma unroll
            for (int s = 0; s < 2; ++s) {
                const s16x4 lo = tr16(vreg + j * 2048 + (2 * s) * 512 + trb), hh = tr16(vreg + j * 2048 + (2 * s + 1) * 512 + trb);
                const bf16x8 vb = {lo[0], lo[1], lo[2], lo[3], hh[0], hh[1], hh[2], hh[3]};
                const bf16x8 pf = __builtin_bit_cast(bf16x8, (u32x4){pa[j][s][0], pa[j][s][1], pa[j][s][2], pa[j][s][3]});
                O = mfma32(pf, vb, O);
            }
        }
        if (db == 0) { LDS_WAIT(); SWA_DMA_V(1); }
        LAS bf16_t* stO = (LAS bf16_t*)(lds + SWA_ST_O);
        const int d = 32 * db + a;
#pragma unroll
        for (int e = 0; e < 16; ++e) {
            const int c = (e & 3) + 8 * (e >> 2) + 4 * hi;
            const int tok = r + dil * (i0 + c) - T0;
            if (pat == 0) stO[tok * 64 + d] = (bf16_t)(pk_bf16(O[e], 0.f) & 0xffffu);
            else {
                const float on = bf2f(stO[tok * 64 + d]) * fo[e] + O[e] * go[e];
                if (pat == 1) stO[tok * 64 + d] = (bf16_t)(pk_bf16(on, 0.f) & 0xffffu);
                else {
                    const size_t row = (size_t)b * SEQ + T0 + tok;
                    const float gate = bf2f(HB[row * HP + C_SG + h * 64 + d]);
                    MIX[row * DMIX + 512 + h * 64 + d] = (bf16_t)(pk_bf16(on * rl[e] * gate, 0.f) & 0xffffu);
                }
            }
        }
    }
#undef SWA_DMA_V
}
__device__ __forceinline__ void swa_unit(const Params& P, LAS unsigned char* lds, int wave, int lane, int b, int h, int chunk) {
    const int T0 = chunk * 512;
#pragma unroll 1
    for (int pat = 0; pat < 3; ++pat) {
#pragma unroll 1
        for (int tt = 0; tt < 2; ++tt) {
            const int k = wave + 8 * tt;
            int dil, r, i0;
            if (pat == 0) { dil = 1; r = 0; i0 = T0 + 32 * k; }
            else if (pat == 1) { dil = 4; r = k & 3; i0 = (T0 >> 2) + 32 * (k >> 2); }
            else { dil = 16; r = k; i0 = T0 >> 4; }
            swa_task(P, lds, wave, lane, b, h, dil, r, i0, pat, T0);
        }
        __syncthreads();
    }
}

constexpr int MEM_K = 0, MEM_V = 65536, MEM_SC = 131072;
__device__ __forceinline__ void mem_unit(const Params& P, LAS unsigned char* lds, int wave, int lane, int b, int h, int qb) {
    const bf16_t* HB = (const bf16_t*)(P.ws + WS_HB);
    const bf16_t* MKV = (const bf16_t*)(P.ws + WS_MKV);
    bf16_t* MIX = (bf16_t*)(P.ws + WS_MIX);
    const int a = lane & 31, hi = lane >> 5;
    __syncthreads();
#pragma unroll
    for (int i = 0; i < 8; ++i) {
        const int pc = wave * 8 + i;
        { const int key = 4 * pc + (lane >> 4), cp = lane & 15;
          __builtin_amdgcn_global_load_lds((const unsigned*)(MKV + ((size_t)b * NMEM + key) * 1024 + h * 128 + 8 * (cp ^ (key & 15))),
                                           (LAS unsigned*)(lds + MEM_K + pc * 1024), 16, 0, 0); }
        { const int key = 8 * (pc >> 1) + ((lane & 31) >> 2), d = 32 * (2 * (pc & 1) + (lane >> 5)) + 8 * (lane & 3);
          __builtin_amdgcn_global_load_lds((const unsigned*)(MKV + ((size_t)b * NMEM + key) * 1024 + 512 + h * 128 + d),
                                           (LAS unsigned*)(lds + MEM_V + pc * 1024), 16, 0, 0); }
    }
    const size_t Rq = (size_t)b * SEQ + qb * 256 + wave * 32;
    VM_WAIT();
    __syncthreads();
    LAS float* fsc = (LAS float*)(lds + MEM_SC + wave * 256);
    const int trb = (4 * hi + ((lane & 15) >> 2)) * 64 + ((lane >> 4) & 1) * 32 + (lane & 3) * 8;
    f32x16 O[4];
#pragma unroll
    for (int db = 0; db < 4; ++db)
#pragma unroll
        for (int e = 0; e < 16; ++e) O[db][e] = 0.f;
    float M = -INFINITY, L = 0.f;
#pragma unroll 1
    for (int ch = 0; ch < 2; ++ch) {
        bf16x8 qf[8];
        { const bf16_t* qp = HB + (Rq + a) * HP + C_MQ + h * 128 + 8 * hi;
#pragma unroll
          for (int kk = 0; kk < 8; ++kk) qf[kk] = *(const bf16x8*)(qp + 16 * kk); }
        f32x16 S[4];
#pragma unroll
        for (int jt = 0; jt < 4; ++jt) {
            const int key = 32 * (4 * ch + jt) + a;
            f32x16 acc;
#pragma unroll
            for (int e = 0; e < 16; ++e) acc[e] = 0.f;
#pragma unroll
            for (int kk = 0; kk < 8; ++kk) {
                const bf16x8 kf = *(const LAS bf16x8*)(lds + MEM_K + key * 256 + (((2 * kk + hi) ^ (key & 15)) << 4));
                acc = mfma32(kf, qf[kk], acc);
            }
            S[jt] = acc;
        }
        float mc = -INFINITY;
#pragma unroll
        for (int jt = 0; jt < 4; ++jt)
#pragma unroll
            for (int e = 0; e < 16; ++e) mc = fmaxf(mc, S[jt][e]);
        mc = fmaxf(mc, __shfl_xor(mc, 32));
        const float Mn = fmaxf(M, mc);
        const float f = fexp2(M - Mn);
        float ls = 0.f;
        unsigned pa[4][2][4];
#pragma unroll
        for (int jt = 0; jt < 4; ++jt) {
#pragma unroll
            for (int e = 0; e < 16; ++e) { const float p = fexp2(S[jt][e] - Mn); S[jt][e] = p; ls += p; }
#pragma unroll
            for (int s = 0; s < 2; ++s)
#pragma unroll
                for (int w = 0; w < 4; ++w) pa[jt][s][w] = pk_bf16(S[jt][8 * s + 2 * w], S[jt][8 * s + 2 * w + 1]);
        }
        ls += __shfl_xor(ls, 32);
        L = L * f + ls; M = Mn;
        if (ch == 1) {
            LDS_WAIT();
            if (hi == 0) fsc[a] = f;
            LDS_WAIT();
#pragma unroll
            for (int g4 = 0; g4 < 4; ++g4) {
                const f32x4 f4 = *(const LAS f32x4*)(fsc + 8 * g4 + 4 * hi);
#pragma unroll
                for (int db = 0; db < 4; ++db)
#pragma unroll
                    for (int e = 0; e < 4; ++e) O[db][4 * g4 + e] *= f4[e];
            }
        }
#pragma unroll
        for (int jt = 0; jt < 4; ++jt)
#pragma unroll
            for (int s = 0; s < 2; ++s) {
                const bf16x8 pf = __builtin_bit_cast(bf16x8, (u32x4){pa[jt][s][0], pa[jt][s][1], pa[jt][s][2], pa[jt][s][3]});
                const int st0 = (4 * (4 * ch + jt) + 2 * s) * 4;
#pragma unroll
                for (int db = 0; db < 4; ++db) {
                    const s16x4 lo = tr16(lds + MEM_V + (st0 + db) * 512 + trb), hh = tr16(lds + MEM_V + (st0 + 4 + db) * 512 + trb);
                    const bf16x8 vb = {lo[0], lo[1], lo[2], lo[3], hh[0], hh[1], hh[2], hh[3]};
                    O[db] = mfma32(pf, vb, O[db]);
                }
            }
    }
    LDS_WAIT();
    if (hi == 0) fsc[32 + a] = 1.0f / L;
    LDS_WAIT();
    const bf16_t* gp = HB + (Rq + 4 * hi) * HP + C_MG + h * 128 + a;
    bf16_t* mp = MIX + (Rq + 4 * hi) * DMIX + 1024 + h * 128 + a;
#pragma unroll
    for (int g4 = 0; g4 < 4; ++g4) {
        const f32x4 r4 = *(const LAS f32x4*)(fsc + 32 + 8 * g4 + 4 * hi);
#pragma unroll
        for (int e = 0; e < 4; ++e) {
#pragma unroll
            for (int db = 0; db < 4; ++db) {
                const float gate = bf2f(gp[(8 * g4 + e) * HP + 32 * db]);
                mp[(8 * g4 + e) * DMIX + 32 * db] = (bf16_t)(pk_bf16(O[db][4 * g4 + e] * r4[e] * gate, 0.f) & 0xffffu);
            }
        }
        asm volatile("" ::: "memory");
    }
}

constexpr int RT_Q = 0, RT_K = 16384, RT_KD = 32768, RT_V = 49152, RT_R = 81920, RT_O = 98304;
__device__ __forceinline__ void ret_unit(const Params& P, LAS unsigned char* lds, int wave, int lane, int tid, int b, int h) {
    const bf16_t* HB = (const bf16_t*)(P.ws + WS_HB);
    bf16_t* MIX = (bf16_t*)(P.ws + WS_MIX);
    const float gamma = 1.0f - __builtin_amdgcn_exp2f((float)(-5 - h));
    const float lg2c = __builtin_log2f(gamma);
    const int qg = wave & 3, dh = wave >> 2;
    const int dkt = wave & 1, dvt = wave >> 1;
    f32x16 Rt;
#pragma unroll
    for (int e = 0; e < 16; ++e) Rt[e] = 0.f;
    u32x4 pq[2], pk[2], pv[4];
    const size_t rb = (size_t)b * SEQ;
#define RET_ISSUE(n) do { const size_t base_ = rb + 128 * (n); \
        _Pragma("unroll") for (int i = 0; i < 2; ++i) { const int idx = tid + 512 * i, row = idx >> 3, ch = idx & 7; \
            pq[i] = *(const u32x4*)(HB + (base_ + row) * HP + C_RQ + h * 64 + ch * 8); pk[i] = *(const u32x4*)(HB + (base_ + row) * HP + C_RK + h * 64 + ch * 8); } \
        _Pragma("unroll") for (int i = 0; i < 4; ++i) { const int idx = tid + 512 * i, row = idx >> 4, ch = idx & 15; \
            pv[i] = *(const u32x4*)(HB + (base_ + row) * HP + C_RV + h * 128 + ch * 8); } } while (0)
    RET_ISSUE(0);
#pragma unroll 1
    for (int n = 0; n < 16; ++n) {
        float lg2 = lg2c; asm volatile("" : "+v"(lg2));
        int lane_ = lane; asm volatile("" : "+v"(lane_));
        const int a = lane_ & 31, hi = lane_ >> 5, tq = (lane_ & 15) >> 2, tp = lane_ & 3, tg = (lane_ >> 4) & 1;
        __syncthreads();
#pragma unroll
        for (int i = 0; i < 2; ++i) {
            const int idx = tid + 512 * i, row = idx >> 3, ch = idx & 7;
            *(LAS u32x4*)(lds + RT_Q + row * 128 + ((ch ^ (row & 7)) << 4)) = pq[i];
            *(LAS u32x4*)(lds + RT_K + row * 128 + ((ch ^ (row & 7)) << 4)) = pk[i];
            const float fac = fexp2((float)(127 - row) * lg2);
            u32x4 kd;
            kd.x = pk_bf16(bf_lo(pk[i].x) * fac, bf_hi(pk[i].x) * fac); kd.y = pk_bf16(bf_lo(pk[i].y) * fac, bf_hi(pk[i].y) * fac);
            kd.z = pk_bf16(bf_lo(pk[i].z) * fac, bf_hi(pk[i].z) * fac); kd.w = pk_bf16(bf_lo(pk[i].w) * fac, bf_hi(pk[i].w) * fac);
            *(LAS u32x4*)(lds + RT_KD + ((row >> 3) * 2 + (ch >> 2)) * 512 + (row & 7) * 64 + (ch & 3) * 16) = kd;
        }
#pragma unroll
        for (int i = 0; i < 4; ++i) {
            const int idx = tid + 512 * i, row = idx >> 4, ch = idx & 15;
            *(LAS u32x4*)(lds + RT_V + ((row >> 3) * 4 + (ch >> 2)) * 512 + (row & 7) * 64 + (ch & 3) * 16) = pv[i];
        }
        __syncthreads();
        if (n + 1 < 16) RET_ISSUE(n + 1);
        f32x16 O[2];
        bf16x8 qfr[4];
#pragma unroll
        for (int kk = 0; kk < 4; ++kk) { const int row = 32 * qg + a; qfr[kk] = *(const LAS bf16x8*)(lds + RT_Q + row * 128 + (((2 * kk + hi) ^ (row & 7)) << 4)); }
        if (n > 0) {
#pragma unroll
            for (int dt = 0; dt < 2; ++dt) {
                f32x16 X;
#pragma unroll
                for (int e = 0; e < 16; ++e) X[e] = 0.f;
                const int dv = 32 * (2 * dh + dt) + a;
#pragma unroll
                for (int kk = 0; kk < 4; ++kk) {
                    const bf16x8 rf = *(const LAS bf16x8*)(lds + RT_R + dv * 128 + (((2 * kk + hi) ^ (dv & 7)) << 4));
                    X = mfma32(qfr[kk], rf, X);
                }
#pragma unroll
                for (int e = 0; e < 16; ++e) { const int c = (e & 3) + 8 * (e >> 2) + 4 * hi; O[dt][e] = X[e] * fexp2((float)(32 * qg + c + 1) * lg2); }
            }
        } else {
#pragma unroll
            for (int dt = 0; dt < 2; ++dt)
#pragma unroll
                for (int e = 0; e < 16; ++e) O[dt][e] = 0.f;
        }
#pragma unroll
        for (int j = 0; j < 4; ++j) if (j <= qg) {
            f32x16 S;
#pragma unroll
            for (int e = 0; e < 16; ++e) S[e] = 0.f;
#pragma unroll
            for (int kk = 0; kk < 4; ++kk) {
                const int row = 32 * j + a;
                const bf16x8 kf = *(const LAS bf16x8*)(lds + RT_K + row * 128 + (((2 * kk + hi) ^ (row & 7)) << 4));
                S = mfma32(kf, qfr[kk], S);
            }
            unsigned pa[2][4];
#pragma unroll
            for (int e = 0; e < 16; ++e) {
                const int c = (e & 3) + 8 * (e >> 2) + 4 * hi;
                const int diff = 32 * (qg - j) + a - c;
                S[e] = diff >= 0 ? S[e] * fexp2((float)diff * lg2) : 0.f;
            }
#pragma unroll
            for (int s = 0; s < 2; ++s)
#pragma unroll
                for (int w = 0; w < 4; ++w) pa[s][w] = pk_bf16(S[8 * s + 2 * w], S[8 * s + 2 * w + 1]);
#pragma unroll
            for (int s = 0; s < 2; ++s) {
                const bf16x8 pf = __builtin_bit_cast(bf16x8, (u32x4){pa[s][0], pa[s][1], pa[s][2], pa[s][3]});
#pragma unroll
                for (int dt = 0; dt < 2; ++dt) {
                    LAS unsigned char* vb_ = lds + RT_V + ((4 * j + 2 * s) * 4 + (2 * dh + dt)) * 512 + (4 * hi + tq) * 64 + tg * 32 + tp * 8;
                    const s16x4 lo = tr16(vb_), hh = tr16(vb_ + 4 * 512);
                    const bf16x8 vb = {lo[0], lo[1], lo[2], lo[3], hh[0], hh[1], hh[2], hh[3]};
                    O[dt] = mfma32(pf, vb, O[dt]);
                }
            }
        }
        {
            LAS bf16_t* Ob = (LAS bf16_t*)(lds + RT_O);
#pragma unroll
            for (int dt = 0; dt < 2; ++dt)
#pragma unroll
                for (int e = 0; e < 16; ++e) { const int c = (e & 3) + 8 * (e >> 2) + 4 * hi; Ob[(32 * qg + c) * 128 + 32 * (2 * dh + dt) + a] = (bf16_t)(pk_bf16(O[dt][e], 0.f) & 0xffffu); }
        }
        __syncthreads();
        {
            const float g128 = fexp2(128.0f * lg2);
#pragma unroll
            for (int e = 0; e < 16; ++e) Rt[e] *= g128;
#pragma unroll
            for (int s = 0; s < 8; ++s) {
                LAS unsigned char* ka = lds + RT_KD + ((2 * s + hi) * 2 + dkt) * 512 + tq * 64 + tg * 32 + tp * 8;
                LAS unsigned char* va = lds + RT_V + ((2 * s + hi) * 4 + dvt) * 512 + tq * 64 + tg * 32 + tp * 8;
                const s16x4 k0 = tr16(ka), k1 = tr16(ka + 256), v0 = tr16(va), v1 = tr16(va + 256);
                const bf16x8 af = {k0[0], k0[1], k0[2], k0[3], k1[0], k1[1], k1[2], k1[3]};
                const bf16x8 bfv = {v0[0], v0[1], v0[2], v0[3], v1[0], v1[1], v1[2], v1[3]};
                Rt = mfma32(af, bfv, Rt);
            }
            const int dv = 32 * dvt + a;
#pragma unroll
            for (int g4 = 0; g4 < 4; ++g4) {
                const int dk0 = 32 * dkt + 8 * g4 + 4 * hi;
                u32x2 w; w.x = pk_bf16(Rt[4 * g4], Rt[4 * g4 + 1]); w.y = pk_bf16(Rt[4 * g4 + 2], Rt[4 * g4 + 3]);
                *(LAS u32x2*)(lds + RT_R + dv * 128 + (((dk0 >> 3) ^ (dv & 7)) << 4) + (dk0 & 7) * 2) = w;
            }
        }
        {
            const int tok = tid >> 2, part = tid & 3;
            const LAS u32x4* op = (const LAS u32x4*)(lds + RT_O + tok * 256 + part * 64);
            float o[32]; float sm = 0.f;
#pragma unroll
            for (int c4 = 0; c4 < 4; ++c4) {
                const u32x4 w = op[c4];
                o[8 * c4 + 0] = bf_lo(w.x); o[8 * c4 + 1] = bf_hi(w.x); o[8 * c4 + 2] = bf_lo(w.y); o[8 * c4 + 3] = bf_hi(w.y);
                o[8 * c4 + 4] = bf_lo(w.z); o[8 * c4 + 5] = bf_hi(w.z); o[8 * c4 + 6] = bf_lo(w.w); o[8 * c4 + 7] = bf_hi(w.w);
            }
#pragma unroll
            for (int e = 0; e < 32; ++e) sm += o[e];
            sm += __shfl_xor(sm, 1); sm += __shfl_xor(sm, 2);
            const float mean = sm * (1.0f / 128.0f);
            float qq = 0.f;
#pragma unroll
            for (int e = 0; e < 32; ++e) { o[e] -= mean; qq += o[e] * o[e]; }
            qq += __shfl_xor(qq, 1); qq += __shfl_xor(qq, 2);
            const float rstd = 1.0f / sqrtf(qq * (1.0f / 128.0f) + 1e-5f);
            const size_t row = rb + 128 * n + tok;
            const u32x4* gp = (const u32x4*)(HB + row * HP + C_RG + h * 128 + part * 32);
            u32x4* mp = (u32x4*)(MIX + row * DMIX + h * 128 + part * 32);
#pragma unroll
            for (int c4 = 0; c4 < 4; ++c4) {
                const u32x4 g = gp[c4]; u32x4 w;
                w.x = pk_bf16(o[8 * c4 + 0] * rstd * bf_lo(g.x), o[8 * c4 + 1] * rstd * bf_hi(g.x)); w.y = pk_bf16(o[8 * c4 + 2] * rstd * bf_lo(g.y), o[8 * c4 + 3] * rstd * bf_hi(g.y));
                w.z = pk_bf16(o[8 * c4 + 4] * rstd * bf_lo(g.z), o[8 * c4 + 5] * rstd * bf_hi(g.z)); w.w = pk_bf16(o[8 * c4 + 6] * rstd * bf_lo(g.w), o[8 * c4 + 7] * rstd * bf_hi(g.w));
                mp[c4] = w;
            }
        }
    }
#undef RET_ISSUE
    {
        float* outp = P.out + O_RP;
        const int a = lane & 31, hi = lane >> 5;
#pragma unroll
        for (int e = 0; e < 16; ++e) {
            const int pdk = 32 * dkt + (e & 3) + 8 * (e >> 2) + 4 * hi;
            outp[((size_t)((b * 4 + h) * 64 + dmap(pdk))) * 128 + 32 * dvt + a] = Rt[e];
        }
    }
    __syncthreads();
}

__global__ void __launch_bounds__(512, 2) fwd_kernel(Params P) {
    extern __shared__ __attribute__((aligned(16))) unsigned char lds_raw[];
    LAS unsigned char* lds = (LAS unsigned char*)lds_raw;
    cg::grid_group grid = cg::this_grid();
    const int tid = threadIdx.x, lane = tid & 63, wave = __builtin_amdgcn_readfirstlane(tid >> 6);
    const int wr = wave >> 2, wc = wave & 3, fr = lane & 15, fq = lane >> 4;
    const int G = gridDim.x;
    unsigned* ctl = (unsigned*)(P.ws + WS_CTL);

    phase0(P, lds, tid, lane, wave);
    grid.sync();

    {
        const bf16_t* XB = (const bf16_t*)(P.ws + WS_XB);
        constexpr int U_IN = 65 * 18, U_ALL = U_IN + 32;
        for (int u = blockIdx.x; u < U_ALL; u += G) {
            f32x4 acc[2][2][4][2];
            if (u < U_IN) {
                const int pm = u / 18, pn = u % 18;
                gemm_mainloop<DM>(XB + (size_t)pm * 256 * DM, (const bf16_t*)(P.ws + WS_WTIN) + (size_t)pn * 256 * DM, lds, acc, tid, wr, wc, fr, fq);
                epi_inproj(acc, pm, pn, P, wr, wc, fr, fq);
            } else {
                const int v = u - U_IN, pm = v >> 2, pn = v & 3;
                gemm_mainloop<DM>(XB + (size_t)(ROWS_IN + pm * 256) * DM, (const bf16_t*)(P.ws + WS_WTMKV) + (size_t)pn * 256 * DM, lds, acc, tid, wr, wc, fr, fq);
                epi_memkv(acc, pm, pn, P, wr, wc, fr, fq);
            }
        }
    }
    grid.sync();

    {
        for (int u = blockIdx.x; u < 160; u += G) {
            if (u < 32) ret_unit(P, lds, wave, lane, tid, u >> 2, u & 3);
            else { const int v = u - 32; ret_scan(P, lds, v >> 2, v & 3, M_PROMPT + (v >> 2) * 4, 4, P.state_ret, P.out + O_RS, tid); }
        }
        __syncthreads();
        for (int u = blockIdx.x; u < 256; u += G) swa_unit(P, lds, wave, lane, u >> 5, (u >> 2) & 7, u & 3);
        for (int u = blockIdx.x; u < 256; u += G) mem_unit(P, lds, wave, lane, u >> 5, (u >> 3) & 3, u & 7);
        __syncthreads();
        LAS float* wsc = (LAS float*)(lds + wave * 1024);
        for (;;) {
            unsigned u = 0;
            if (lane == 0) u = atomicAdd(ctl + 64, 1u);
            u = (unsigned)__builtin_amdgcn_readfirstlane((int)u);
            if (u >= 2048u + 2048u + 1024u + 512u) break;
            if (u < 2048u) { continue; }
            else if (u < 4096u) { continue; }
            else if (u < 5120u) { const unsigned v = u - 4096u; swa_sample_wave(P, wsc, v >> 5, (v >> 2) & 7, v & 3, lane); }
            else { const unsigned v = u - 5120u; mem_sample_wave(P, wsc, v >> 4, (v >> 2) & 3, v & 3, lane); }
        }
    }
    grid.sync();

    {
        const bf16_t* MIX = (const bf16_t*)(P.ws + WS_MIX);
        for (int u = blockIdx.x; u < 65 * 4; u += G) {
            const int pm = u >> 2, pn = u & 3;
            f32x4 acc[2][2][4][2];
            gemm_mainloop<DMIX>(MIX + (size_t)pm * 256 * DMIX, (const bf16_t*)(P.ws + WS_WTOUT) + (size_t)pn * 256 * DMIX, lds, acc, tid, wr, wc, fr, fq);
            epi_outproj(acc, pm, pn, P, wr, wc, fr, fq);
        }
    }
    grid.sync();

    {
        const int gw = blockIdx.x * 8 + wave, NGW = G * 8;
        for (int r = gw; r < M_PROMPT + M_SAMPLE; r += NGW) {
            float* zr = r < M_PROMPT ? P.out + O_YP + (size_t)r * DM : P.out + O_YS + (size_t)(r - M_PROMPT) * DM;
            f32x4 v[4]; float s = 0.f;
#pragma unroll
            for (int j = 0; j < 4; ++j) { v[j] = ((const f32x4*)zr)[lane + 64 * j]; s += (v[j][0] + v[j][1]) + (v[j][2] + v[j][3]); }
            const float mean = wave_sum(s) * (1.0f / DM);
            float q = 0.f;
#pragma unroll
            for (int j = 0; j < 4; ++j) { v[j] = v[j] - mean; q += (v[j][0] * v[j][0] + v[j][1] * v[j][1]) + (v[j][2] * v[j][2] + v[j][3] * v[j][3]); }
            const float rstd = 1.0f / sqrtf(wave_sum(q) * (1.0f / DM) + 1e-5f);
#pragma unroll
            for (int j = 0; j < 4; ++j) {
                const f32x4 g = ((const f32x4*)P.ln_g)[lane + 64 * j], bb = ((const f32x4*)P.ln_b)[lane + 64 * j];
                ((f32x4*)zr)[lane + 64 * j] = v[j] * rstd * g + bb;
            }
        }
    }
}

extern "C" void kernel_launch(void* const* d_in, const int* in_sizes, int n_in, void* d_out, int out_size, void* d_ws, size_t ws_size, hipStream_t stream) {
    static int grid_blocks = 0;
    if (!grid_blocks) {
        int dev = 0, cus = 0, per_cu = 0;
        hipGetDevice(&dev);
        hipDeviceGetAttribute(&cus, hipDeviceAttributeMultiprocessorCount, dev);
        hipFuncSetAttribute((const void*)fwd_kernel, hipFuncAttributeMaxDynamicSharedMemorySize, LDS_BYTES);
        hipOccupancyMaxActiveBlocksPerMultiprocessor(&per_cu, (const void*)fwd_kernel, 512, LDS_BYTES);
        if (per_cu < 1) { fprintf(stderr, "kernel_launch: occupancy query says %d blocks per CU\n", per_cu); per_cu = 1; }
        grid_blocks = cus;
        if (ws_size < WS_END) fprintf(stderr, "kernel_launch: workspace too small (%zu < %zu)\n", ws_size, (size_t)WS_END);
    }
    hipMemsetAsync((char*)d_ws + WS_CTL, 0, 4096, stream);
    Params p{};
    p.x_prompt = (const float*)d_in[0]; p.x_sample = (const float*)d_in[1]; p.state_ret = (const float*)d_in[2];
    p.cache_k = (const float*)d_in[3]; p.cache_v = (const float*)d_in[4]; p.cmem_k = (const float*)d_in[5]; p.cmem_v = (const float*)d_in[6];
    p.mem_prompt = (const float*)d_in[7]; p.w_in = (const float*)d_in[8]; p.w_mkv = (const float*)d_in[9]; p.w_out = (const float*)d_in[10];
    p.ln_g = (const float*)d_in[11]; p.ln_b = (const float*)d_in[12];
    p.out = (float*)d_out; p.ws = (unsigned char*)d_ws;
    void* args[] = {&p};
    hipError_t e = hipLaunchCooperativeKernel((const void*)fwd_kernel, dim3(grid_blocks), dim3(512), args, LDS_BYTES, stream);
    if (e != hipSuccess) fprintf(stderr, "cooperative launch failed: %s (grid %d)\n", hipGetErrorString(e), grid_blocks);
}
```

```cpp
#include <hip/hip_runtime.h>
#include <hip/hip_cooperative_groups.h>
#include <cstdio>
#include <cstdint>
namespace cg = cooperative_groups;

#define LAS __attribute__((address_space(3)))
typedef unsigned short bf16_t;
typedef short bf16x8 __attribute__((ext_vector_type(8)));
typedef float f32x4 __attribute__((ext_vector_type(4)));
typedef float f32x2 __attribute__((ext_vector_type(2)));
typedef unsigned u32x4 __attribute__((ext_vector_type(4)));
typedef unsigned u32x2 __attribute__((ext_vector_type(2)));
typedef __bf16 bf16x2_t __attribute__((ext_vector_type(2)));

constexpr int DM = 1024, NB = 8, SEQ = 2048, DECB = 32, DECT = 4;
constexpr int NMEM = 256, DIN = 4608, DMIX = 1536;
constexpr int M_PROMPT = NB * SEQ;
constexpr int M_SAMPLE = DECB * DECT;
constexpr int ROWS_IN = M_PROMPT + 256;
constexpr int ROWS_ALL = ROWS_IN + NB * NMEM;
constexpr int HP = DIN;
constexpr int C_RQ = 0, C_RK = 256, C_RV = 512, C_RG = 1024, C_SQ = 1536, C_SK = 2048, C_SV = 2560, C_SG = 3072, C_MQ = 3584, C_MG = 4096;
constexpr size_t O_YP = 0, O_YS = 16777216, O_RP = 16908288, O_RS = 17170432, O_KP = 18219008, O_VP = 26607616,
                 O_KS = 34996224, O_VS = 35061760, O_MK = 35127296, O_MV = 36175872;
constexpr size_t MiB = 1u << 20;
constexpr size_t WS_CTL = 0, WS_ROPE = 1 * MiB, WS_WTIN = 2 * MiB, WS_WTMKV = 11 * MiB, WS_WTOUT = 14 * MiB,
                 WS_XB = 20 * MiB, WS_HB = 64 * MiB, WS_MKV = 212 * MiB, WS_MIX = 216 * MiB, WS_END = 268 * MiB;
constexpr int LDS_BYTES = 163840;
constexpr float LOG2E = 1.4426950408889634f;
constexpr float SQ_SCALE = 0.18033688011112042f;
constexpr float MQ_SCALE = 0.12751743082459868f;
constexpr float ALPHA = 1.189207115002721f;

struct Params {
    const float *x_prompt, *x_sample, *state_ret, *cache_k, *cache_v, *cmem_k, *cmem_v, *mem_prompt, *w_in, *w_mkv, *w_out, *ln_g, *ln_b;
    float* out;
    unsigned char* ws;
};

__device__ __forceinline__ unsigned pk_bf16(float lo, float hi) { f32x2 v = {lo, hi}; bf16x2_t b = __builtin_convertvector(v, bf16x2_t); return __builtin_bit_cast(unsigned, b); }
__device__ __forceinline__ float bf_lo(unsigned u) { return __uint_as_float(u << 16); }
__device__ __forceinline__ float bf_hi(unsigned u) { return __uint_as_float(u & 0xffff0000u); }
__device__ __forceinline__ float bf2f(bf16_t h) { return __uint_as_float(((unsigned)h) << 16); }
__device__ __forceinline__ float fexp2(float x) { return __builtin_amdgcn_exp2f(x); }
__device__ __forceinline__ float frcp(float x) { return __builtin_amdgcn_rcpf(x); }
__device__ __forceinline__ float silu(float x) { return x * frcp(1.0f + fexp2(-x * LOG2E)); }
__device__ __forceinline__ float wave_max(float v) {
#pragma unroll
    for (int o = 1; o < 64; o <<= 1) v = fmaxf(v, __shfl_xor(v, o));
    return v;
}
__device__ __forceinline__ float wave_sum(float v) {
#pragma unroll
    for (int o = 1; o < 64; o <<= 1) v += __shfl_xor(v, o);
    return v;
}
#define LDS_WAIT() asm volatile("s_waitcnt lgkmcnt(0)" ::: "memory")
__device__ __forceinline__ int perm32(int rho) { const int n = rho >> 4, i = rho & 15; return 8 * (i >> 2) + 4 * n + (i & 3); }
__device__ __forceinline__ int dmap(int p) { return 16 * (p >> 5) + 32 * ((p >> 2) & 1) + 4 * ((p >> 3) & 3) + (p & 3); }
__device__ __forceinline__ int src_col_in(int c) {
    const int rho = c & 31;
    const bool rope = (c < 512) || (c >= 1536 && c < 2560);
    if (rope) return (c & ~63) + 16 * ((c >> 5) & 1) + 32 * (rho >> 4) + (rho & 15);
    return (c & ~31) + perm32(rho);
}

__device__ __forceinline__ void transpose_item(const float* W, int K, int N, bf16_t* WT, int mode, LAS float* scr, int item, int lane) {
    const int nblk = N / 32, kb = item / nblk, nb = item % nblk, k0 = 64 * kb, n0 = 32 * nb;
    const int cl = lane & 31;
    const int sc = (mode == 0) ? (n0 + cl) : (mode == 1) ? (n0 + perm32(cl)) : src_col_in(n0 + cl);
#pragma unroll 8
    for (int i = 0; i < 32; ++i) { const int kk = 2 * i + (lane >> 5); scr[kk * 33 + cl] = W[(size_t)(k0 + kk) * N + sc]; }
    LDS_WAIT();
    const int c = lane & 7;
#pragma unroll
    for (int j = 0; j < 4; ++j) {
        const int n = (lane >> 3) + 8 * j; const LAS float* s = scr + (8 * c) * 33 + n;
        u32x4 o; o.x = pk_bf16(s[0 * 33], s[1 * 33]); o.y = pk_bf16(s[2 * 33], s[3 * 33]); o.z = pk_bf16(s[4 * 33], s[5 * 33]); o.w = pk_bf16(s[6 * 33], s[7 * 33]);
        *(u32x4*)(WT + (size_t)(n0 + n) * K + k0 + 8 * c) = o;
    }
    LDS_WAIT();
}
__device__ __forceinline__ void sincos_d(double a, float& s, float& c) {
    const double kd = __builtin_rint(a * 0.63661977236758134308);
    double y = __builtin_fma(-kd, 1.57079632679489655800e+00, a); y = __builtin_fma(-kd, 6.12323399573676603587e-17, y);
    const double y2 = y * y;
    const double sp = y * (1.0 + y2 * (-1.0 / 6 + y2 * (1.0 / 120 + y2 * (-1.0 / 5040 + y2 * (1.0 / 362880 + y2 * (-1.0 / 39916800 + y2 * (1.0 / 6227020800.0)))))));
    const double cp = 1.0 + y2 * (-0.5 + y2 * (1.0 / 24 + y2 * (-1.0 / 720 + y2 * (1.0 / 40320 + y2 * (-1.0 / 3628800 + y2 * (1.0 / 479001600.0))))));
    const int k = ((int)kd) & 3;
    const double sv = (k == 0) ? sp : (k == 1) ? cp : (k == 2) ? -sp : -cp;
    const double cv = (k == 0) ? cp : (k == 1) ? -sp : (k == 2) ? -cp : sp;
    s = (float)sv; c = (float)cv;
}
__device__ __forceinline__ void phase0(const Params& P, LAS unsigned char* lds, int tid, int lane, int wave) {
    unsigned char* ws = P.ws;
    const int gw = blockIdx.x * 8 + wave, NGW = gridDim.x * 8;
    LAS float* scr = (LAS float*)(lds + wave * 8448);
    constexpr int I_IN = (DM / 64) * (DIN / 32), I_MKV = (DM / 64) * (1024 / 32), I_OUT = (DMIX / 64) * (DM / 32);
    for (int it = gw; it < I_IN + I_MKV + I_OUT; it += NGW) {
        int r = it;
        if (r < I_IN) { transpose_item(P.w_in, DM, DIN, (bf16_t*)(ws + WS_WTIN), 2, scr, r, lane); continue; } r -= I_IN;
        if (r < I_MKV) { transpose_item(P.w_mkv, DM, 1024, (bf16_t*)(ws + WS_WTMKV), 1, scr, r, lane); continue; } r -= I_MKV;
        transpose_item(P.w_out, DMIX, DM, (bf16_t*)(ws + WS_WTOUT), 0, scr, r, lane);
    }
    bf16_t* XB = (bf16_t*)(ws + WS_XB);
    for (int m = gw; m < ROWS_ALL; m += NGW) {
        const float* src = (m < M_PROMPT) ? P.x_prompt + (size_t)m * DM : (m < M_PROMPT + M_SAMPLE) ? P.x_sample + (size_t)(m - M_PROMPT) * DM
                         : (m < ROWS_IN) ? nullptr : P.mem_prompt + (size_t)(m - ROWS_IN) * DM;
        u32x2* dst = (u32x2*)(XB + (size_t)m * DM) + lane;
#pragma unroll
        for (int j = 0; j < 4; ++j) {
            f32x4 v = {0.f, 0.f, 0.f, 0.f};
            if (src) v = ((const f32x4*)src)[lane + 64 * j];
            u32x2 o; o.x = pk_bf16(v.x, v.y); o.y = pk_bf16(v.z, v.w); dst[64 * j] = o;
        }
    }
    float* rope = (float*)(ws + WS_ROPE);
    for (int e = blockIdx.x * 512 + tid; e < 2052 * 32; e += gridDim.x * 512) {
        const int idx = e >> 5, i = e & 31;
        const int pos = idx < 2048 ? idx : 8192 + (idx - 2048);
        double inv = 1.0;
        for (int k = 0; k < i; ++k) inv *= 0.7498942093324559;
        float s, c; sincos_d((double)pos * inv, s, c);
        rope[2 * e] = c; rope[2 * e + 1] = s;
    }
}

template <int K>
__device__ __forceinline__ void gemm_mainloop(const bf16_t* __restrict__ A, const bf16_t* __restrict__ Bt, LAS unsigned char* lds,
                                              f32x4 (&acc)[2][2][4][2], int tid, int wr, int wc, int fr, int fq) {
    constexpr int PITCH = 144;
    LAS unsigned char* As = lds; LAS unsigned char* Bs = lds + 256 * PITCH;
    const int lrow = tid >> 3, lch = tid & 7;
    const bf16_t* ga = A + (size_t)lrow * K + lch * 8;
    const bf16_t* gb = Bt + (size_t)lrow * K + lch * 8;
    u32x4 ra[4], rb[4];
#pragma unroll
    for (int i = 0; i < 4; ++i) { ra[i] = *(const u32x4*)(ga + (size_t)i * 64 * K); rb[i] = *(const u32x4*)(gb + (size_t)i * 64 * K); }
#pragma unroll
    for (int a = 0; a < 2; ++a)
#pragma unroll
        for (int b = 0; b < 2; ++b)
#pragma unroll
            for (int m = 0; m < 4; ++m)
#pragma unroll
                for (int n = 0; n < 2; ++n) acc[a][b][m][n] = (f32x4){0.f, 0.f, 0.f, 0.f};
    for (int kt = 0; kt < K / 64; ++kt) {
        __syncthreads();
#pragma unroll
        for (int i = 0; i < 4; ++i) {
            *(LAS u32x4*)(As + (lrow + 64 * i) * PITCH + lch * 16) = ra[i];
            *(LAS u32x4*)(Bs + (lrow + 64 * i) * PITCH + lch * 16) = rb[i];
        }
        __syncthreads();
        if (kt + 1 < K / 64) {
#pragma unroll
            for (int i = 0; i < 4; ++i) { ra[i] = *(const u32x4*)(ga + (size_t)i * 64 * K + (kt + 1) * 64); rb[i] = *(const u32x4*)(gb + (size_t)i * 64 * K + (kt + 1) * 64); }
        }
#pragma unroll
        for (int ai = 0; ai < 2; ++ai) {
#pragma unroll
            for (int k = 0; k < 2; ++k) {
                bf16x8 At[4];
#pragma unroll
                for (int m = 0; m < 4; ++m) At[m] = *(const LAS bf16x8*)(As + (ai * 128 + wr * 64 + m * 16 + fr) * PITCH + (k * 32 + fq * 8) * 2);
#pragma unroll
                for (int bj = 0; bj < 2; ++bj) {
                    bf16x8 Bf[2];
#pragma unroll
                    for (int n = 0; n < 2; ++n) Bf[n] = *(const LAS bf16x8*)(Bs + (bj * 128 + wc * 32 + n * 16 + fr) * PITCH + (k * 32 + fq * 8) * 2);
#pragma unroll
                    for (int m = 0; m < 4; ++m)
#pragma unroll
                        for (int n = 0; n < 2; ++n) acc[ai][bj][m][n] = __builtin_amdgcn_mfma_f32_16x16x32_bf16(Bf[n], At[m], acc[ai][bj][m][n], 0, 0, 0);
                }
            }
        }
    }
}


namespace pg8 {
#define PG8_LAS __attribute__((address_space(3)))
typedef unsigned short bf16_t;
typedef short bf16x8 __attribute__((ext_vector_type(8)));
typedef float f32x4 __attribute__((ext_vector_type(4)));
constexpr int BM = 256, BK = 64, HALF = 128, HTB = HALF * BK * 2, STAGE_BYTES = 8 * HTB;
__host__ __device__ __forceinline__ int lds_byte(int r, int c) { const int st = (r >> 4) * 2 + (c >> 5), rr = r & 15, cc = c & 31, ob = rr * 64 + cc * 2; return st * 1024 + (ob ^ (((ob >> 9) & 1) << 5)); }
__host__ __device__ __forceinline__ void stage_rc(int b, int& R, int& C) { const int st = b / 1024, sb = b % 1024, swz = sb ^ (((sb >> 9) & 1) << 5); R = (st >> 1) * 16 + swz / 64; C = (st & 1) * 32 + (swz % 64) / 2; }
__host__ __device__ __forceinline__ int perm32(int rho) { const int n = rho >> 4, i = rho & 15; return 8 * (i >> 2) + 4 * n + (i & 3); }
struct Unit { int pm, pn; };
struct Gemm { const bf16_t* A; const bf16_t* Bt; int M, N, K; };
template <class Epi, class Sched, bool ALIGN_EPI = false, bool SP2 = false>
__device__ __forceinline__ void gemm_phase(PG8_LAS unsigned char* lds, const Gemm g, const Sched& S, const Epi& E) {
    const int tid = threadIdx.x, wid = __builtin_amdgcn_readfirstlane(tid >> 6), lane = tid & 63, wr = wid >> 2, wc = wid & 3, fr = lane & 15, fq = lane >> 4;
    const int K = g.K, nt = K / BK;
    unsigned voffA[2], voffB[2];
#pragma unroll
    for (int i = 0; i < 2; ++i) { int R, C; stage_rc(tid * 16 + i * 8192, R, C); const int Rb = Epi::PERM ? ((R & ~31) + perm32(R & 31)) : R;
        voffA[i] = (unsigned)(R * K + C) * 2u; voffB[i] = (unsigned)(Rb * K + C) * 2u; }
    const size_t kstep = (size_t)(BK * 2);
    const size_t hstep = (size_t)HALF * K * 2;
    const size_t tstep = 2 * hstep;
    const unsigned ldsw = (unsigned)wid * 1024u;
    const int aoff = lds_byte(wr * 64 + fr, fq * 8), boff = lds_byte(wc * 32 + fr, fq * 8);
#define PG8_SA(b, h) (((b) * 2 + (h)) * HTB)
#define PG8_SB(b, h) ((4 + (b) * 2 + (h)) * HTB)
#define PG8_STAGE(bufoff, gbase, voff) do { _Pragma("unroll") for (int _i = 0; _i < 2; ++_i) \
        __builtin_amdgcn_global_load_lds((const unsigned*)((const char*)(gbase) + (voff)[_i]), (PG8_LAS unsigned*)(lds + (bufoff) + ldsw + _i * 8192), 16, 0, 0); } while (0)
#define PG8_LDA(dst, b, h) do { _Pragma("unroll") for (int m = 0; m < 4; ++m) _Pragma("unroll") for (int k = 0; k < 2; ++k) dst[m][k] = *(const PG8_LAS bf16x8*)(lds + PG8_SA(b, h) + aoff + m * 2048 + k * 1024); } while (0)
#define PG8_LDB(dst, b, h) do { _Pragma("unroll") for (int n = 0; n < 2; ++n) _Pragma("unroll") for (int k = 0; k < 2; ++k) dst[n][k] = *(const PG8_LAS bf16x8*)(lds + PG8_SB(b, h) + boff + n * 2048 + k * 1024); } while (0)
#define PG8_MMA(ai, bj, At, Bt) do { __builtin_amdgcn_s_setprio(1); _Pragma("unroll") for (int m = 0; m < 4; ++m) _Pragma("unroll") for (int n = 0; n < 2; ++n) _Pragma("unroll") for (int k = 0; k < 2; ++k) \
        acc[ai][bj][m][n] = __builtin_amdgcn_mfma_f32_16x16x32_bf16(Bt[n][k], At[m][k], acc[ai][bj][m][n], 0, 0, 0); __builtin_amdgcn_s_setprio(0); } while (0)
#define PG8_WAIT_V(n) asm volatile("s_waitcnt vmcnt(" #n ")" ::: "memory")
#define PG8_WAIT_L(n) asm volatile("s_waitcnt lgkmcnt(" #n ")" ::: "memory")
#define PG8_BAR __builtin_amdgcn_s_barrier()
#define PG8_SCHED __builtin_amdgcn_sched_barrier(0)
    Unit cur, nxt; int ui = 0;
    if (!S.next(0, cur)) return;
    f32x4 acc[2][2][4][2];
#pragma unroll
    for (int a = 0; a < 2; ++a)
#pragma unroll
        for (int b = 0; b < 2; ++b)
#pragma unroll
            for (int m = 0; m < 4; ++m)
#pragma unroll
                for (int n = 0; n < 2; ++n) acc[a][b][m][n] = (f32x4){0.f, 0.f, 0.f, 0.f};
    bf16x8 At[4][2], B0[2][2], B1[2][2];
    const char* cA = (const char*)g.A + (size_t)cur.pm * tstep; const char* cB = (const char*)g.Bt + (size_t)cur.pn * tstep;
    S.a_ready(cur);
    if constexpr (SP2) {
        PG8_STAGE(PG8_SB(0, 0), cB, voffB); PG8_STAGE(PG8_SB(0, 1), cB + hstep, voffB); PG8_STAGE(PG8_SA(0, 0), cA, voffA); PG8_STAGE(PG8_SA(0, 1), cA + hstep, voffA);
        if (wr == 1) PG8_BAR;
        PG8_WAIT_V(2); PG8_BAR;
        PG8_STAGE(PG8_SB(1, 0), cB + kstep, voffB); PG8_STAGE(PG8_SA(1, 0), cA + kstep, voffA); PG8_STAGE(PG8_SB(1, 1), cB + hstep + kstep, voffB);
        PG8_WAIT_V(6); PG8_BAR;
    } else {
        PG8_STAGE(PG8_SB(0, 0), cB, voffB); PG8_STAGE(PG8_SA(0, 0), cA, voffA); PG8_STAGE(PG8_SB(0, 1), cB + hstep, voffB); PG8_STAGE(PG8_SA(0, 1), cA + hstep, voffA);
        if (wr == 1) PG8_BAR;
        PG8_WAIT_V(4); PG8_BAR;
        PG8_STAGE(PG8_SB(1, 0), cB + kstep, voffB); PG8_STAGE(PG8_SA(1, 0), cA + kstep, voffA); PG8_STAGE(PG8_SB(1, 1), cB + hstep + kstep, voffB);
        PG8_WAIT_V(6); PG8_BAR;
    }
    for (;;) {
        const bool has_next = S.next(ui + 1, nxt);
        const char* nA = has_next ? (const char*)g.A + (size_t)nxt.pm * tstep : cA; const char* nB = has_next ? (const char*)g.Bt + (size_t)nxt.pn * tstep : cB;
        for (int t = 0; t < nt; t += 2) {
            const bool last = (t == nt - 2);
            const char* a1 = cA + (size_t)(t + 1) * kstep;
            const char* a2 = last ? nA : cA + (size_t)(t + 2) * kstep; const char* b2 = last ? nB : cB + (size_t)(t + 2) * kstep;
            const char* a3 = a2 + kstep; const char* b3 = b2 + kstep;
            if (last && has_next) S.a_ready(nxt);
            if constexpr (SP2) {
            PG8_LDB(B0, 0, 0); PG8_LDB(B1, 0, 1); PG8_SCHED; PG8_LDA(At, 0, 0); PG8_STAGE(PG8_SA(1, 1), a1 + hstep, voffA);
            PG8_WAIT_V(8); PG8_WAIT_L(0); PG8_BAR; PG8_MMA(0, 0, At, B0); PG8_MMA(0, 1, At, B1); PG8_BAR; PG8_SCHED;
            PG8_LDA(At, 0, 1); PG8_STAGE(PG8_SB(0, 0), b2, voffB); PG8_STAGE(PG8_SB(0, 1), b2 + hstep, voffB); PG8_STAGE(PG8_SA(0, 0), a2, voffA);
            PG8_WAIT_V(8); PG8_WAIT_L(0); PG8_BAR; PG8_MMA(1, 0, At, B0); PG8_MMA(1, 1, At, B1); PG8_BAR; PG8_SCHED;
            PG8_LDB(B0, 1, 0); PG8_LDB(B1, 1, 1); PG8_SCHED; PG8_LDA(At, 1, 0); PG8_STAGE(PG8_SA(0, 1), a2 + hstep, voffA);
            PG8_WAIT_V(8); PG8_WAIT_L(0); PG8_BAR; PG8_MMA(0, 0, At, B0); PG8_MMA(0, 1, At, B1); PG8_BAR; PG8_SCHED;
            PG8_LDA(At, 1, 1); PG8_STAGE(PG8_SB(1, 0), b3, voffB); PG8_STAGE(PG8_SB(1, 1), b3 + hstep, voffB); PG8_STAGE(PG8_SA(1, 0), a3, voffA);
            PG8_WAIT_V(8); PG8_WAIT_L(0); PG8_BAR; PG8_MMA(1, 0, At, B0); PG8_MMA(1, 1, At, B1); PG8_BAR; PG8_SCHED;
            } else {
            PG8_LDB(B0, 0, 0); PG8_SCHED; PG8_LDA(At, 0, 0); PG8_STAGE(PG8_SA(1, 1), a1 + hstep, voffA);
            PG8_WAIT_L(8); PG8_BAR; PG8_WAIT_L(0); PG8_MMA(0, 0, At, B0); PG8_BAR; PG8_SCHED;
            PG8_LDB(B1, 0, 1); PG8_STAGE(PG8_SB(0, 0), b2, voffB);
            PG8_BAR; PG8_WAIT_L(0); PG8_MMA(0, 1, At, B1); PG8_BAR;
            PG8_LDA(At, 0, 1); PG8_STAGE(PG8_SA(0, 0), a2, voffA);
            PG8_BAR; PG8_WAIT_L(0); PG8_MMA(1, 0, At, B0); PG8_BAR; PG8_SCHED;
            PG8_STAGE(PG8_SB(0, 1), b2 + hstep, voffB);
            PG8_WAIT_V(6); PG8_BAR; PG8_MMA(1, 1, At, B1); PG8_BAR;
            PG8_LDB(B0, 1, 0); PG8_SCHED; PG8_LDA(At, 1, 0); PG8_STAGE(PG8_SA(0, 1), a2 + hstep, voffA);
            PG8_WAIT_L(8); PG8_BAR; PG8_WAIT_L(0); PG8_MMA(0, 0, At, B0); PG8_BAR; PG8_SCHED;
            PG8_LDB(B1, 1, 1); PG8_STAGE(PG8_SB(1, 0), b3, voffB);
            PG8_BAR; PG8_WAIT_L(0); PG8_MMA(0, 1, At, B1); PG8_BAR;
            PG8_LDA(At, 1, 1); PG8_STAGE(PG8_SA(1, 0), a3, voffA);
            PG8_BAR; PG8_WAIT_L(0); PG8_MMA(1, 0, At, B0); PG8_BAR; PG8_SCHED;
            PG8_STAGE(PG8_SB(1, 1), b3 + hstep, voffB);
            PG8_WAIT_V(6); PG8_BAR; PG8_MMA(1, 1, At, B1); PG8_BAR;
            }
        }
        if constexpr (ALIGN_EPI) { if (wr == 0) PG8_BAR; }
        if constexpr (!Epi::AFTER_DRAIN) { E(acc, cur, wr, wc, fr, fq); S.done(cur); }
        if (!has_next) break;
#pragma unroll
        for (int a = 0; a < 2; ++a)
#pragma unroll
            for (int b = 0; b < 2; ++b)
#pragma unroll
                for (int m = 0; m < 4; ++m)
#pragma unroll
                    for (int n = 0; n < 2; ++n) acc[a][b][m][n] = (f32x4){0.f, 0.f, 0.f, 0.f};
        cur = nxt; cA = nA; cB = nB; ++ui;
        if constexpr (ALIGN_EPI) { if (wr == 1) PG8_BAR; }
    }
    PG8_WAIT_V(0);
    if constexpr (!ALIGN_EPI) { if (wr == 0) PG8_BAR; }
    PG8_BAR;
    if constexpr (Epi::AFTER_DRAIN) { E.fused(acc, cur, wr, wc, fr, fq, lds, wid, lane); S.done(cur); }
#undef PG8_SA
#undef PG8_SB
#undef PG8_STAGE
#undef PG8_LDA
#undef PG8_LDB
#undef PG8_MMA
#undef PG8_WAIT_V
#undef PG8_WAIT_L
#undef PG8_BAR
#undef PG8_SCHED
}
}

__device__ __forceinline__ void epi_inproj(const f32x4 (&acc)[2][2][4][2], int pm, int pn, const Params& P, int wr, int wc, int fr, int fq) {
    bf16_t* HB = (bf16_t*)(P.ws + WS_HB);
    const float* rope = (const float*)(P.ws + WS_ROPE);
    int type = 0; float scale = 1.0f; int f32out = 0;
    if (pn == 0) { type = 1; }
    else if (pn == 1) { type = 1; scale = 0.125f; }
    else if (pn == 4 || pn == 5 || pn == 12 || pn == 13 || pn == 16 || pn == 17) { type = 2; }
    else if (pn == 6 || pn == 7) { type = 1; scale = SQ_SCALE; }
    else if (pn == 8 || pn == 9) { type = 1; f32out = 1; }
    else if (pn == 10 || pn == 11) { f32out = 2; }
    else if (pn == 14 || pn == 15) { scale = MQ_SCALE; }
#pragma unroll
    for (int ai = 0; ai < 2; ++ai)
#pragma unroll
        for (int m = 0; m < 4; ++m) {
            const int r = pm * 256 + ai * 128 + wr * 64 + m * 16 + fr;
            const int pi = r < M_PROMPT ? (r & 2047) : 2048 + ((r - M_PROMPT) & 3);
            const bool live = r < M_PROMPT + M_SAMPLE;
#pragma unroll
            for (int bj = 0; bj < 2; ++bj) {
                const int cb = pn * 256 + bj * 128 + wc * 32;
                f32x4 v0 = acc[ai][bj][m][0], v1 = acc[ai][bj][m][1];
                if (type == 1) {
                    const int d1 = 16 * ((cb >> 5) & 1) + 4 * fq;
                    const f32x4* rp = (const f32x4*)(rope + ((size_t)pi * 32 + d1) * 2);
                    const f32x4 cs0 = rp[0], cs1 = rp[1];
                    f32x4 y1, y2;
                    y1[0] = v0[0] * cs0[0] - v1[0] * cs0[1]; y2[0] = v1[0] * cs0[0] + v0[0] * cs0[1];
                    y1[1] = v0[1] * cs0[2] - v1[1] * cs0[3]; y2[1] = v1[1] * cs0[2] + v0[1] * cs0[3];
                    y1[2] = v0[2] * cs1[0] - v1[2] * cs1[1]; y2[2] = v1[2] * cs1[0] + v0[2] * cs1[1];
                    y1[3] = v0[3] * cs1[2] - v1[3] * cs1[3]; y2[3] = v1[3] * cs1[2] + v0[3] * cs1[3];
                    if (f32out == 1 && live) {
                        float* o = (r < M_PROMPT ? P.out + O_KP + (size_t)r * 512 : P.out + O_KS + (size_t)(r - M_PROMPT) * 512) + ((cb - C_SK) >> 6) * 64 + d1;
                        *(f32x4*)o = y1; *(f32x4*)(o + 32) = y2;
                    }
                    v0 = y1 * scale; v1 = y2 * scale;
                } else if (type == 2) {
#pragma unroll
                    for (int e = 0; e < 4; ++e) { v0[e] = silu(v0[e]); v1[e] = silu(v1[e]); }
                } else {
                    if (f32out == 2 && live) {
                        float* o = (r < M_PROMPT ? P.out + O_VP + (size_t)r * 512 : P.out + O_VS + (size_t)(r - M_PROMPT) * 512) + (cb - C_SV) + 8 * fq;
                        *(f32x4*)o = v0; *(f32x4*)(o + 4) = v1;
                    }
                    v0 = v0 * scale; v1 = v1 * scale;
                }
                u32x4 w; w.x = pk_bf16(v0[0], v0[1]); w.y = pk_bf16(v0[2], v0[3]); w.z = pk_bf16(v1[0], v1[1]); w.w = pk_bf16(v1[2], v1[3]);
                *(u32x4*)(HB + (size_t)r * HP + cb + 8 * fq) = w;
            }
        }
}
__device__ __forceinline__ void epi_memkv(const f32x4 (&acc)[2][2][4][2], int pm, int pn, const Params& P, int wr, int wc, int fr, int fq) {
    bf16_t* MKV = (bf16_t*)(P.ws + WS_MKV);
#pragma unroll
    for (int ai = 0; ai < 2; ++ai)
#pragma unroll
        for (int m = 0; m < 4; ++m) {
            const int r = pm * 256 + ai * 128 + wr * 64 + m * 16 + fr;
#pragma unroll
            for (int bj = 0; bj < 2; ++bj) {
                const int c0 = pn * 256 + bj * 128 + wc * 32 + 8 * fq;
                const f32x4 v0 = acc[ai][bj][m][0], v1 = acc[ai][bj][m][1];
                float* o = (c0 < 512) ? P.out + O_MK + (size_t)r * 512 + c0 : P.out + O_MV + (size_t)r * 512 + (c0 - 512);
                *(f32x4*)o = v0; *(f32x4*)(o + 4) = v1;
                u32x4 w; w.x = pk_bf16(v0[0], v0[1]); w.y = pk_bf16(v0[2], v0[3]); w.z = pk_bf16(v1[0], v1[1]); w.w = pk_bf16(v1[2], v1[3]);
                *(u32x4*)(MKV + (size_t)r * 1024 + c0) = w;
            }
        }
}
__device__ __forceinline__ void epi_outproj(const f32x4 (&acc)[2][2][4][2], int pm, int pn, const Params& P, int wr, int wc, int fr, int fq) {
#pragma unroll
    for (int ai = 0; ai < 2; ++ai)
#pragma unroll
        for (int m = 0; m < 4; ++m) {
            const int r = pm * 256 + ai * 128 + wr * 64 + m * 16 + fr;
            if (r >= M_PROMPT + M_SAMPLE) continue;
            const float* xr = r < M_PROMPT ? P.x_prompt + (size_t)r * DM : P.x_sample + (size_t)(r - M_PROMPT) * DM;
            float* zr = r < M_PROMPT ? P.out + O_YP + (size_t)r * DM : P.out + O_YS + (size_t)(r - M_PROMPT) * DM;
#pragma unroll
            for (int bj = 0; bj < 2; ++bj)
#pragma unroll
                for (int n = 0; n < 2; ++n) {
                    const int c = pn * 256 + bj * 128 + wc * 32 + 16 * n + 4 * fq;
                    const f32x4 xv = *(const f32x4*)(xr + c);
                    *(f32x4*)(zr + c) = xv * ALPHA + acc[ai][bj][m][n];
                }
        }
}

__device__ __forceinline__ void ret_scan(const Params& P, LAS unsigned char* lds, int b, int h, int row0, int ntok, const float* init, float* outstate, int tid) {
    const bf16_t* HB = (const bf16_t*)(P.ws + WS_HB);
    bf16_t* MIX = (bf16_t*)(P.ws + WS_MIX);
    LAS float* qs = (LAS float*)lds;
    LAS float* ks = qs + 32 * 64;
    LAS float* vs = ks + 32 * 64;
    LAS float* po = vs + 32 * 128;
    const int vv = tid & 127, kq = tid >> 7;
    const float gamma = 1.0f - __builtin_amdgcn_exp2f((float)(-5 - h));
    float S[16];
#pragma unroll
    for (int j = 0; j < 16; ++j) S[j] = init ? init[((size_t)((b * 4 + h) * 64 + dmap(16 * kq + j))) * 128 + vv] : 0.f;
    for (int t0 = 0; t0 < ntok; t0 += 32) {
        const int nb = (ntok - t0) < 32 ? (ntok - t0) : 32;
        __syncthreads();
        {
            const int tt = (tid & 255) >> 3, ch = tid & 7;
            if (tt < nb) {
                const u32x4 w = *(const u32x4*)(HB + (size_t)(row0 + t0 + tt) * HP + (tid < 256 ? C_RQ : C_RK) + h * 64 + ch * 8);
                LAS float* dst = (tid < 256 ? qs : ks) + tt * 64 + ch * 8;
                dst[0] = bf_lo(w.x); dst[1] = bf_hi(w.x); dst[2] = bf_lo(w.y); dst[3] = bf_hi(w.y);
                dst[4] = bf_lo(w.z); dst[5] = bf_hi(w.z); dst[6] = bf_lo(w.w); dst[7] = bf_hi(w.w);
            }
            const int tv = tid >> 4, cv = tid & 15;
            if (tv < nb) {
                const u32x4 w = *(const u32x4*)(HB + (size_t)(row0 + t0 + tv) * HP + C_RV + h * 128 + cv * 8);
                LAS float* dst = vs + tv * 128 + cv * 8;
                dst[0] = bf_lo(w.x); dst[1] = bf_hi(w.x); dst[2] = bf_lo(w.y); dst[3] = bf_hi(w.y);
                dst[4] = bf_lo(w.z); dst[5] = bf_hi(w.z); dst[6] = bf_lo(w.w); dst[7] = bf_hi(w.w);
            }
        }
        __syncthreads();
        for (int tt = 0; tt < nb; ++tt) {
            const float vval = vs[tt * 128 + vv];
            float o = 0.f;
#pragma unroll
            for (int j4 = 0; j4 < 4; ++j4) {
                const f32x4 k4 = *(const LAS f32x4*)(ks + tt * 64 + 16 * kq + 4 * j4);
                const f32x4 q4 = *(const LAS f32x4*)(qs + tt * 64 + 16 * kq + 4 * j4);
#pragma unroll
                for (int e = 0; e < 4; ++e) { S[4 * j4 + e] = fmaf(gamma, S[4 * j4 + e], k4[e] * vval); o = fmaf(q4[e], S[4 * j4 + e], o); }
            }
            po[(tt * 4 + kq) * 128 + vv] = o;
        }
        __syncthreads();
        {
            const int tf = tid >> 4, c8 = (tid & 15) * 8;
            float o[8]; float s = 0.f;
#pragma unroll
            for (int e = 0; e < 8; ++e) { o[e] = (po[(tf * 4 + 0) * 128 + c8 + e] + po[(tf * 4 + 1) * 128 + c8 + e]) + (po[(tf * 4 + 2) * 128 + c8 + e] + po[(tf * 4 + 3) * 128 + c8 + e]); s += o[e]; }
            s += __shfl_xor(s, 1); s += __shfl_xor(s, 2); s += __shfl_xor(s, 4); s += __shfl_xor(s, 8);
            const float mean = s * (1.0f / 128.0f);
            float q = 0.f;
#pragma unroll
            for (int e = 0; e < 8; ++e) { o[e] -= mean; q += o[e] * o[e]; }
            q += __shfl_xor(q, 1); q += __shfl_xor(q, 2); q += __shfl_xor(q, 4); q += __shfl_xor(q, 8);
            const float rstd = 1.0f / sqrtf(q * (1.0f / 128.0f) + 1e-5f);
            if (tf < nb) {
                const size_t row = (size_t)(row0 + t0 + tf);
                const u32x4 g = *(const u32x4*)(HB + row * HP + C_RG + h * 128 + c8);
                u32x4 w;
                w.x = pk_bf16(o[0] * rstd * bf_lo(g.x), o[1] * rstd * bf_hi(g.x)); w.y = pk_bf16(o[2] * rstd * bf_lo(g.y), o[3] * rstd * bf_hi(g.y));
                w.z = pk_bf16(o[4] * rstd * bf_lo(g.z), o[5] * rstd * bf_hi(g.z)); w.w = pk_bf16(o[6] * rstd * bf_lo(g.w), o[7] * rstd * bf_hi(g.w));
                *(u32x4*)(MIX + row * DMIX + h * 128 + c8) = w;
            }
        }
    }
    __syncthreads();
#pragma unroll
    for (int j = 0; j < 16; ++j) outstate[((size_t)((b * 4 + h) * 64 + dmap(16 * kq + j))) * 128 + vv] = S[j];
}

__device__ __forceinline__ void swa_prompt_naive(const Params& P, int b, int h, int t) {
    const bf16_t* HB = (const bf16_t*)(P.ws + WS_HB);
    bf16_t* MIX = (bf16_t*)(P.ws + WS_MIX);
    const size_t R = (size_t)b * SEQ + t;
    u32x4 q4[8];
    { const u32x4* qp = (const u32x4*)(HB + R * HP + C_SQ + h * 64);
#pragma unroll
      for (int c = 0; c < 8; ++c) q4[c] = qp[c]; }
    float acc[64];
#pragma unroll
    for (int d = 0; d < 64; ++d) acc[d] = 0.f;
    float mrun = -INFINITY, lrun = 0.f;
#pragma unroll 1
    for (int g = 0; g < 3; ++g) {
        const int dil = (g == 0) ? 1 : (g == 1) ? 4 : 16;
#pragma unroll 1
        for (int s = 0; s <= 128; ++s) {
            const int tk = t - s * dil;
            const bool valid = tk >= 0;
            const size_t Rk = (size_t)b * SEQ + (valid ? tk : 0);
            const u32x4* kp = (const u32x4*)(HB + Rk * HP + C_SK + h * 64);
            const u32x4* vp = (const u32x4*)(HB + Rk * HP + C_SV + h * 64);
            u32x4 kk[8], vv[8];
#pragma unroll
            for (int c = 0; c < 8; ++c) { kk[c] = kp[c]; vv[c] = vp[c]; }
            float dot = 0.f;
#pragma unroll
            for (int c = 0; c < 8; ++c) {
                dot += bf_lo(q4[c].x) * bf_lo(kk[c].x) + bf_hi(q4[c].x) * bf_hi(kk[c].x) + bf_lo(q4[c].y) * bf_lo(kk[c].y) + bf_hi(q4[c].y) * bf_hi(kk[c].y)
                     + bf_lo(q4[c].z) * bf_lo(kk[c].z) + bf_hi(q4[c].z) * bf_hi(kk[c].z) + bf_lo(q4[c].w) * bf_lo(kk[c].w) + bf_hi(q4[c].w) * bf_hi(kk[c].w);
            }
            const float sc = valid ? dot : -INFINITY;
            const float mn = fmaxf(mrun, sc);
            const float f = fexp2(mrun - mn), p = fexp2(sc - mn);
            mrun = mn; lrun = lrun * f + p;
#pragma unroll
            for (int c = 0; c < 8; ++c) {
                acc[8 * c + 0] = acc[8 * c + 0] * f + p * bf_lo(vv[c].x); acc[8 * c + 1] = acc[8 * c + 1] * f + p * bf_hi(vv[c].x);
                acc[8 * c + 2] = acc[8 * c + 2] * f + p * bf_lo(vv[c].y); acc[8 * c + 3] = acc[8 * c + 3] * f + p * bf_hi(vv[c].y);
                acc[8 * c + 4] = acc[8 * c + 4] * f + p * bf_lo(vv[c].z); acc[8 * c + 5] = acc[8 * c + 5] * f + p * bf_hi(vv[c].z);
                acc[8 * c + 6] = acc[8 * c + 6] * f + p * bf_lo(vv[c].w); acc[8 * c + 7] = acc[8 * c + 7] * f + p * bf_hi(vv[c].w);
            }
        }
    }
    const float rl = 1.0f / lrun;
    const u32x4* gp = (const u32x4*)(HB + R * HP + C_SG + h * 64);
    u32x4* op = (u32x4*)(MIX + R * DMIX + 512 + h * 64);
#pragma unroll
    for (int c = 0; c < 8; ++c) {
        const u32x4 g = gp[c]; u32x4 w;
        w.x = pk_bf16(acc[8 * c + 0] * rl * bf_lo(g.x), acc[8 * c + 1] * rl * bf_hi(g.x)); w.y = pk_bf16(acc[8 * c + 2] * rl * bf_lo(g.y), acc[8 * c + 3] * rl * bf_hi(g.y));
        w.z = pk_bf16(acc[8 * c + 4] * rl * bf_lo(g.z), acc[8 * c + 5] * rl * bf_hi(g.z)); w.w = pk_bf16(acc[8 * c + 6] * rl * bf_lo(g.w), acc[8 * c + 7] * rl * bf_hi(g.w));
        op[c] = w;
    }
}

__device__ __forceinline__ void mem_prompt_naive(const Params& P, int b, int h, int t, int half) {
    const bf16_t* HB = (const bf16_t*)(P.ws + WS_HB);
    const bf16_t* MKV = (const bf16_t*)(P.ws + WS_MKV);
    bf16_t* MIX = (bf16_t*)(P.ws + WS_MIX);
    const size_t R = (size_t)b * SEQ + t;
    u32x4 q4[8];
    { const u32x4* qp = (const u32x4*)(HB + R * HP + C_MQ + h * 128 + half * 64);
#pragma unroll
      for (int c = 0; c < 8; ++c) q4[c] = qp[c]; }
    float acc[64];
#pragma unroll
    for (int d = 0; d < 64; ++d) acc[d] = 0.f;
    float mrun = -INFINITY, lrun = 0.f;
#pragma unroll 1
    for (int m = 0; m < NMEM; ++m) {
        const size_t Rk = (size_t)b * NMEM + m;
        const u32x4* kp = (const u32x4*)(MKV + Rk * 1024 + h * 128 + half * 64);
        const u32x4* vp = (const u32x4*)(MKV + Rk * 1024 + 512 + h * 128 + half * 64);
        u32x4 kk[8], vv[8];
#pragma unroll
        for (int c = 0; c < 8; ++c) { kk[c] = kp[c]; vv[c] = vp[c]; }
        float dot = 0.f;
#pragma unroll
        for (int c = 0; c < 8; ++c) {
            dot += bf_lo(q4[c].x) * bf_lo(kk[c].x) + bf_hi(q4[c].x) * bf_hi(kk[c].x) + bf_lo(q4[c].y) * bf_lo(kk[c].y) + bf_hi(q4[c].y) * bf_hi(kk[c].y)
                 + bf_lo(q4[c].z) * bf_lo(kk[c].z) + bf_hi(q4[c].z) * bf_hi(kk[c].z) + bf_lo(q4[c].w) * bf_lo(kk[c].w) + bf_hi(q4[c].w) * bf_hi(kk[c].w);
        }
        const float sc = dot + __shfl_xor(dot, 1);
        const float mn = fmaxf(mrun, sc);
        const float f = fexp2(mrun - mn), p = fexp2(sc - mn);
        mrun = mn; lrun = lrun * f + p;
#pragma unroll
        for (int c = 0; c < 8; ++c) {
            acc[8 * c + 0] = acc[8 * c + 0] * f + p * bf_lo(vv[c].x); acc[8 * c + 1] = acc[8 * c + 1] * f + p * bf_hi(vv[c].x);
            acc[8 * c + 2] = acc[8 * c + 2] * f + p * bf_lo(vv[c].y); acc[8 * c + 3] = acc[8 * c + 3] * f + p * bf_hi(vv[c].y);
            acc[8 * c + 4] = acc[8 * c + 4] * f + p * bf_lo(vv[c].z); acc[8 * c + 5] = acc[8 * c + 5] * f + p * bf_hi(vv[c].z);
            acc[8 * c + 6] = acc[8 * c + 6] * f + p * bf_lo(vv[c].w); acc[8 * c + 7] = acc[8 * c + 7] * f + p * bf_hi(vv[c].w);
        }
    }
    const float rl = 1.0f / lrun;
    const u32x4* gp = (const u32x4*)(HB + R * HP + C_MG + h * 128 + half * 64);
    u32x4* op = (u32x4*)(MIX + R * DMIX + 1024 + h * 128 + half * 64);
#pragma unroll
    for (int c = 0; c < 8; ++c) {
        const u32x4 g = gp[c]; u32x4 w;
        w.x = pk_bf16(acc[8 * c + 0] * rl * bf_lo(g.x), acc[8 * c + 1] * rl * bf_hi(g.x)); w.y = pk_bf16(acc[8 * c + 2] * rl * bf_lo(g.y), acc[8 * c + 3] * rl * bf_hi(g.y));
        w.z = pk_bf16(acc[8 * c + 4] * rl * bf_lo(g.z), acc[8 * c + 5] * rl * bf_hi(g.z)); w.w = pk_bf16(acc[8 * c + 6] * rl * bf_lo(g.w), acc[8 * c + 7] * rl * bf_hi(g.w));
        op[c] = w;
    }
}

__device__ __forceinline__ void swa_sample_wave(const Params& P, LAS float* wsc, int b, int h, int i, int lane) {
    const bf16_t* HB = (const bf16_t*)(P.ws + WS_HB);
    bf16_t* MIX = (bf16_t*)(P.ws + WS_MIX);
    const size_t R = (size_t)M_PROMPT + b * 4 + i;
    LAS float* qo = wsc;
    LDS_WAIT();
    qo[dmap(lane)] = bf2f(HB[R * HP + C_SQ + h * 64 + lane]);
    LDS_WAIT();
    float Mrun = -INFINITY, Wsum = 0.f, Nsum = 0.f;
#pragma unroll 1
    for (int g = 0; g < 3; ++g) {
        const int dil = (g == 0) ? 1 : (g == 1) ? 4 : 16;
        float sc[3];
#pragma unroll
        for (int rd = 0; rd < 3; ++rd) {
            const int s = lane + 64 * rd;
            float dot = -INFINITY;
            if (s <= 128) {
                const int idx = 2048 + i - dil * s;
                float a = 0.f;
                if (idx < 2048) {
                    const f32x4* kc = (const f32x4*)(P.cache_k + (((size_t)b * 2048 + idx) * 8 + h) * 64);
#pragma unroll
                    for (int c = 0; c < 16; ++c) { const f32x4 kv = kc[c]; const f32x4 qv = *(const LAS f32x4*)(qo + 4 * c); a += kv[0] * qv[0] + kv[1] * qv[1] + kv[2] * qv[2] + kv[3] * qv[3]; }
                } else {
                    const bf16_t* kn = HB + ((size_t)M_PROMPT + b * 4 + (idx - 2048)) * HP + C_SK + h * 64;
#pragma unroll 1
                    for (int p = 0; p < 64; ++p) a += qo[dmap(p)] * bf2f(kn[p]);
                }
                dot = a;
            }
            sc[rd] = dot;
        }
        const float m = wave_max(fmaxf(fmaxf(sc[0], sc[1]), sc[2]));
        const float p0 = fexp2(sc[0] - m), p1 = fexp2(sc[1] - m), p2 = fexp2(sc[2] - m);
        const float l = wave_sum(p0 + p1 + p2);
        float a = 0.f;
#pragma unroll 1
        for (int s0 = 0; s0 < 136; s0 += 8) {
            const float psel = (s0 < 64) ? p0 : (s0 < 128) ? p1 : p2;
            float vv[8];
#pragma unroll
            for (int e = 0; e < 8; ++e) {
                const int s = (s0 + e) < 128 ? (s0 + e) : 128;
                const int idx = 2048 + i - dil * s;
                vv[e] = (idx < 2048) ? P.cache_v[(((size_t)b * 2048 + idx) * 8 + h) * 64 + lane]
                                     : bf2f(HB[((size_t)M_PROMPT + b * 4 + (idx - 2048)) * HP + C_SV + h * 64 + lane]);
            }
#pragma unroll
            for (int e = 0; e < 8; ++e) a += __shfl(psel, (s0 + e) & 63) * vv[e];
        }
        const float mn = fmaxf(Mrun, m);
        const float f = fexp2(Mrun - mn), fg = fexp2(m - mn);
        Nsum = Nsum * f + a * fg; Wsum = Wsum * f + l * fg; Mrun = mn;
    }
    const float o = Nsum / Wsum;
    const float gate = bf2f(HB[R * HP + C_SG + h * 64 + lane]);
    MIX[R * DMIX + 512 + h * 64 + lane] = (bf16_t)(pk_bf16(o * gate, 0.f) & 0xffffu);
}

__device__ __forceinline__ void mem_sample_wave(const Params& P, LAS float* wsc, int b, int h, int i, int lane) {
    const bf16_t* HB = (const bf16_t*)(P.ws + WS_HB);
    bf16_t* MIX = (bf16_t*)(P.ws + WS_MIX);
    const size_t R = (size_t)M_PROMPT + b * 4 + i;
    LAS float* qm = wsc;
    LDS_WAIT();
    qm[lane] = bf2f(HB[R * HP + C_MQ + h * 128 + lane]); qm[64 + lane] = bf2f(HB[R * HP + C_MQ + h * 128 + 64 + lane]);
    LDS_WAIT();
    float sc[4];
#pragma unroll
    for (int rd = 0; rd < 4; ++rd) {
        const int m = lane + 64 * rd;
        const f32x4* kc = (const f32x4*)(P.cmem_k + (((size_t)b * NMEM + m) * 4 + h) * 128);
        float a = 0.f;
#pragma unroll
        for (int c = 0; c < 32; ++c) { const f32x4 kv = kc[c]; const f32x4 qv = *(const LAS f32x4*)(qm + 4 * c); a += kv[0] * qv[0] + kv[1] * qv[1] + kv[2] * qv[2] + kv[3] * qv[3]; }
        sc[rd] = a;
    }
    const float m = wave_max(fmaxf(fmaxf(sc[0], sc[1]), fmaxf(sc[2], sc[3])));
    const float p0 = fexp2(sc[0] - m), p1 = fexp2(sc[1] - m), p2 = fexp2(sc[2] - m), p3 = fexp2(sc[3] - m);
    const float l = wave_sum((p0 + p1) + (p2 + p3));
    float a0 = 0.f, a1 = 0.f;
#pragma unroll 1
    for (int s0 = 0; s0 < NMEM; s0 += 8) {
        const float psel = (s0 < 64) ? p0 : (s0 < 128) ? p1 : (s0 < 192) ? p2 : p3;
        f32x2 vv[8];
#pragma unroll
        for (int e = 0; e < 8; ++e) vv[e] = *(const f32x2*)(P.cmem_v + (((size_t)b * NMEM + s0 + e) * 4 + h) * 128 + 2 * lane);
#pragma unroll
        for (int e = 0; e < 8; ++e) { const float ps = __shfl(psel, (s0 + e) & 63); a0 += ps * vv[e][0]; a1 += ps * vv[e][1]; }
    }
    const float rl = 1.0f / l;
    const unsigned g = *(const unsigned*)(HB + R * HP + C_MG + h * 128 + 2 * lane);
    *(unsigned*)(MIX + R * DMIX + 1024 + h * 128 + 2 * lane) = pk_bf16(a0 * rl * bf_lo(g), a1 * rl * bf_hi(g));
}

typedef float f32x16 __attribute__((ext_vector_type(16)));
typedef short s16x4 __attribute__((ext_vector_type(4)));
constexpr int SWA_ST_O = 0, SWA_ST_M = 65536, SWA_ST_L = 65536 + 2048, SWA_WV = 69632, SWA_WV_STRIDE = 10240 + 256;
__device__ __forceinline__ s16x4 tr16(LAS unsigned char* p) { return __builtin_bit_cast(s16x4, __builtin_amdgcn_ds_read_tr16_b64_v4i16((LAS s16x4*)p)); }
__device__ __forceinline__ f32x16 mfma32(bf16x8 a, bf16x8 b, f32x16 c) { return __builtin_amdgcn_mfma_f32_32x32x16_bf16(a, b, c, 0, 0, 0); }
#define VM_WAIT() asm volatile("s_waitcnt vmcnt(0)" ::: "memory")

__device__ __forceinline__ void swa_task(const Params& P, LAS unsigned char* lds, int wave, int lane, int b, int h, int dil, int r, int i0, int pat, int T0) {
    const bf16_t* HB = (const bf16_t*)(P.ws + WS_HB);
    bf16_t* MIX = (bf16_t*)(P.ws + WS_MIX);
    const int a = lane & 31, hi = lane >> 5;
    LAS unsigned char* vreg = lds + SWA_WV + wave * SWA_WV_STRIDE;
    LAS float* msc = (LAS float*)(vreg + 10240);
    LAS float* lsc = msc + 32;
    const size_t rowbase = (size_t)b * SEQ + r;
    const int jmin = i0 >= 128 ? 0 : ((128 - i0) >> 5);
    const int vrow = ((lane >> 5) << 3) + ((lane >> 2) & 7), vch = lane & 3;
    const int trb = (4 * hi + ((lane & 15) >> 2)) * 64 + ((lane >> 4) & 1) * 32 + (lane & 3) * 8;

#define SWA_DMA_V(db) do { _Pragma("unroll") for (int j = 0; j < 5; ++j) if (j >= jmin) { _Pragma("unroll") for (int it2 = 0; it2 < 2; ++it2) { \
        const int ik = i0 - 128 + 32 * j + 16 * it2 + vrow; \
        __builtin_amdgcn_global_load_lds((const unsigned*)(HB + (rowbase + (size_t)dil * ik) * HP + C_SV + h * 64 + 32 * (db) + 8 * vch), \
                                         (LAS unsigned*)(vreg + j * 2048 + it2 * 1024), 16, 0, 0); } } } while (0)

    LDS_WAIT();
    SWA_DMA_V(0);
    bf16x8 qf[4];
    { const bf16_t* qp = HB + (rowbase + (size_t)dil * (i0 + a)) * HP + C_SQ + h * 64 + 8 * hi;
#pragma unroll
      for (int kk = 0; kk < 4; ++kk) qf[kk] = *(const bf16x8*)(qp + 16 * kk); }
    f32x16 S[5];
#pragma unroll
    for (int j = 0; j < 5; ++j) {
        if (j >= jmin) {
            const int ik = i0 - 128 + 32 * j + a;
            const bf16_t* kp = HB + (rowbase + (size_t)dil * ik) * HP + C_SK + h * 64 + 8 * hi;
            bf16x8 kf[4];
#pragma unroll
            for (int kk = 0; kk < 4; ++kk) kf[kk] = *(const bf16x8*)(kp + 16 * kk);
            f32x16 acc;
#pragma unroll
            for (int e = 0; e < 16; ++e) acc[e] = 0.f;
#pragma unroll
            for (int kk = 0; kk < 4; ++kk) acc = mfma32(kf[kk], qf[kk], acc);
            if (j == 0) {
#pragma unroll
                for (int e = 0; e < 16; ++e) { const int c = (e & 3) + 8 * (e >> 2) + 4 * hi; if (c < a) acc[e] = -INFINITY; }
            }
            if (j == 4) {
#pragma unroll
                for (int e = 0; e < 16; ++e) { const int c = (e & 3) + 8 * (e >> 2) + 4 * hi; if (c > a) acc[e] = -INFINITY; }
            }
            S[j] = acc;
        } else {
#pragma unroll
            for (int e = 0; e < 16; ++e) S[j][e] = -INFINITY;
        }
    }
    float mx = -INFINITY;
#pragma unroll
    for (int j = 0; j < 5; ++j)
#pragma unroll
        for (int e = 0; e < 16; ++e) mx = fmaxf(mx, S[j][e]);
    mx = fmaxf(mx, __shfl_xor(mx, 32));
    float lsum = 0.f;
    unsigned pa[5][2][4];
#pragma unroll
    for (int j = 0; j < 5; ++j) {
#pragma unroll
        for (int e = 0; e < 16; ++e) { const float p = fexp2(S[j][e] - mx); S[j][e] = p; lsum += p; }
#pragma unroll
        for (int s = 0; s < 2; ++s)
#pragma unroll
            for (int w = 0; w < 4; ++w) pa[j][s][w] = pk_bf16(S[j][8 * s + 2 * w], S[j][8 * s + 2 * w + 1]);
    }
    lsum += __shfl_xor(lsum, 32);
    if (hi == 0) { msc[a] = mx; lsc[a] = lsum; }
    LDS_WAIT();
    float fo[16], go[16], rl[16];
    LAS float* stM = (LAS float*)(lds + SWA_ST_M);
    LAS float* stL = (LAS float*)(lds + SWA_ST_L);
#pragma unroll
    for (int g4 = 0; g4 < 4; ++g4) {
        const f32x4 m4 = *(const LAS f32x4*)(msc + 8 * g4 + 4 * hi), l4 = *(const LAS f32x4*)(lsc + 8 * g4 + 4 * hi);
#pragma unroll
        for (int e = 0; e < 4; ++e) {
            const int c = 8 * g4 + 4 * hi + e;
            const int tok = r + dil * (i0 + c) - T0;
            if (pat == 0) { fo[4 * g4 + e] = 0.f; go[4 * g4 + e] = 1.f; rl[4 * g4 + e] = 1.f; if (a == 0) { stM[tok] = m4[e]; stL[tok] = l4[e]; } }
            else {
                const float Mo = stM[tok], Lo = stL[tok];
                const float Mn = fmaxf(Mo, m4[e]);
                const float f = fexp2(Mo - Mn), g = fexp2(m4[e] - Mn);
                const float Ln = Lo * f + l4[e] * g;
                fo[4 * g4 + e] = f; go[4 * g4 + e] = g; rl[4 * g4 + e] = 1.0f / Ln;
                if (pat == 1 && a == 0) { stM[tok] = Mn; stL[tok] = Ln; }
            }
        }
    }
#pragma unroll
    for (int db = 0; db < 2; ++db) {
        VM_WAIT();
        f32x16 O;
#pragma unroll
        for (int e = 0; e < 16; ++e) O[e] = 0.f;
#pragma unroll
        for (int j = 0; j < 5; ++j) if (j >= jmin) {
#pragma unroll
            for (int s = 0; s < 2; ++s) {
                const s16x4 lo = tr16(vreg + j * 2048 + (2 * s) * 512 + trb), hh = tr16(vreg + j * 2048 + (2 * s + 1) * 512 + trb);
                const bf16x8 vb = {lo[0], lo[1], lo[2], lo[3], hh[0], hh[1], hh[2], hh[3]};
                const bf16x8 pf = __builtin_bit_cast(bf16x8, (u32x4){pa[j][s][0], pa[j][s][1], pa[j][s][2], pa[j][s][3]});
                O = mfma32(pf, vb, O);
            }
        }
        if (db == 0) { LDS_WAIT(); SWA_DMA_V(1); }
        LAS bf16_t* stO = (LAS bf16_t*)(lds + SWA_ST_O);
        const int d = 32 * db + a;
#pragma unroll
        for (int e = 0; e < 16; ++e) {
            const int c = (e & 3) + 8 * (e >> 2) + 4 * hi;
            const int tok = r + dil * (i0 + c) - T0;
            if (pat == 0) stO[tok * 64 + d] = (bf16_t)(pk_bf16(O[e], 0.f) & 0xffffu);
            else {
                const float on = bf2f(stO[tok * 64 + d]) * fo[e] + O[e] * go[e];
                if (pat == 1) stO[tok * 64 + d] = (bf16_t)(pk_bf16(on, 0.f) & 0xffffu);
                else {
                    const size_t row = (size_t)b * SEQ + T0 + tok;
                    const float gate = bf2f(HB[row * HP + C_SG + h * 64 + d]);
                    MIX[row * DMIX + 512 + h * 64 + d] = (bf16_t)(pk_bf16(on * rl[e] * gate, 0.f) & 0xffffu);
                }
            }
        }
    }
#undef SWA_DMA_V
}
__device__ __forceinline__ void swa_unit(const Params& P, LAS unsigned char* lds, int wave, int lane, int b, int h, int chunk) {
    const int T0 = chunk * 512;
#pragma unroll 1
    for (int pat = 0; pat < 3; ++pat) {
#pragma unroll 1
        for (int tt = 0; tt < 2; ++tt) {
            const int k = wave + 8 * tt;
            int dil, r, i0;
            if (pat == 0) { dil = 1; r = 0; i0 = T0 + 32 * k; }
            else if (pat == 1) { dil = 4; r = k & 3; i0 = (T0 >> 2) + 32 * (k >> 2); }
            else { dil = 16; r = k; i0 = T0 >> 4; }
            swa_task(P, lds, wave, lane, b, h, dil, r, i0, pat, T0);
        }
        __syncthreads();
    }
}

constexpr int MEM_K = 0, MEM_V = 65536, MEM_SC = 131072;
__device__ __forceinline__ void mem_unit(const Params& P, LAS unsigned char* lds, int wave, int lane, int b, int h, int qb) {
    const bf16_t* HB = (const bf16_t*)(P.ws + WS_HB);
    const bf16_t* MKV = (const bf16_t*)(P.ws + WS_MKV);
    bf16_t* MIX = (bf16_t*)(P.ws + WS_MIX);
    const int a = lane & 31, hi = lane >> 5;
    __syncthreads();
#pragma unroll
    for (int i = 0; i < 8; ++i) {
        const int pc = wave * 8 + i;
        { const int key = 4 * pc + (lane >> 4), cp = lane & 15;
          __builtin_amdgcn_global_load_lds((const unsigned*)(MKV + ((size_t)b * NMEM + key) * 1024 + h * 128 + 8 * (cp ^ (key & 15))),
                                           (LAS unsigned*)(lds + MEM_K + pc * 1024), 16, 0, 0); }
        { const int key = 8 * (pc >> 1) + ((lane & 31) >> 2), d = 32 * (2 * (pc & 1) + (lane >> 5)) + 8 * (lane & 3);
          __builtin_amdgcn_global_load_lds((const unsigned*)(MKV + ((size_t)b * NMEM + key) * 1024 + 512 + h * 128 + d),
                                           (LAS unsigned*)(lds + MEM_V + pc * 1024), 16, 0, 0); }
    }
    const size_t Rq = (size_t)b * SEQ + qb * 256 + wave * 32;
    VM_WAIT();
    __syncthreads();
    LAS float* fsc = (LAS float*)(lds + MEM_SC + wave * 256);
    const int trb = (4 * hi + ((lane & 15) >> 2)) * 64 + ((lane >> 4) & 1) * 32 + (lane & 3) * 8;
    f32x16 O[4];
#pragma unroll
    for (int db = 0; db < 4; ++db)
#pragma unroll
        for (int e = 0; e < 16; ++e) O[db][e] = 0.f;
    float M = -INFINITY, L = 0.f;
#pragma unroll 1
    for (int ch = 0; ch < 2; ++ch) {
        bf16x8 qf[8];
        { const bf16_t* qp = HB + (Rq + a) * HP + C_MQ + h * 128 + 8 * hi;
#pragma unroll
          for (int kk = 0; kk < 8; ++kk) qf[kk] = *(const bf16x8*)(qp + 16 * kk); }
        f32x16 S[4];
#pragma unroll
        for (int jt = 0; jt < 4; ++jt) {
            const int key = 32 * (4 * ch + jt) + a;
            f32x16 acc;
#pragma unroll
            for (int e = 0; e < 16; ++e) acc[e] = 0.f;
#pragma unroll
            for (int kk = 0; kk < 8; ++kk) {
                const bf16x8 kf = *(const LAS bf16x8*)(lds + MEM_K + key * 256 + (((2 * kk + hi) ^ (key & 15)) << 4));
                acc = mfma32(kf, qf[kk], acc);
            }
            S[jt] = acc;
        }
        float mc = -INFINITY;
#pragma unroll
        for (int jt = 0; jt < 4; ++jt)
#pragma unroll
            for (int e = 0; e < 16; ++e) mc = fmaxf(mc, S[jt][e]);
        mc = fmaxf(mc, __shfl_xor(mc, 32));
        const float Mn = fmaxf(M, mc);
        const float f = fexp2(M - Mn);
        float ls = 0.f;
        unsigned pa[4][2][4];
#pragma unroll
        for (int jt = 0; jt < 4; ++jt) {
#pragma unroll
            for (int e = 0; e < 16; ++e) { const float p = fexp2(S[jt][e] - Mn); S[jt][e] = p; ls += p; }
#pragma unroll
            for (int s = 0; s < 2; ++s)
#pragma unroll
                for (int w = 0; w < 4; ++w) pa[jt][s][w] = pk_bf16(S[jt][8 * s + 2 * w], S[jt][8 * s + 2 * w + 1]);
        }
        ls += __shfl_xor(ls, 32);
        L = L * f + ls; M = Mn;
        if (ch == 1) {
            LDS_WAIT();
            if (hi == 0) fsc[a] = f;
            LDS_WAIT();
#pragma unroll
            for (int g4 = 0; g4 < 4; ++g4) {
                const f32x4 f4 = *(const LAS f32x4*)(fsc + 8 * g4 + 4 * hi);
#pragma unroll
                for (int db = 0; db < 4; ++db)
#pragma unroll
                    for (int e = 0; e < 4; ++e) O[db][4 * g4 + e] *= f4[e];
            }
        }
#pragma unroll
        for (int jt = 0; jt < 4; ++jt)
#pragma unroll
            for (int s = 0; s < 2; ++s) {
                const bf16x8 pf = __builtin_bit_cast(bf16x8, (u32x4){pa[jt][s][0], pa[jt][s][1], pa[jt][s][2], pa[jt][s][3]});
                const int st0 = (4 * (4 * ch + jt) + 2 * s) * 4;
#pragma unroll
                for (int db = 0; db < 4; ++db) {
                    const s16x4 lo = tr16(lds + MEM_V + (st0 + db) * 512 + trb), hh = tr16(lds + MEM_V + (st0 + 4 + db) * 512 + trb);
                    const bf16x8 vb = {lo[0], lo[1], lo[2], lo[3], hh[0], hh[1], hh[2], hh[3]};
                    O[db] = mfma32(pf, vb, O[db]);
                }
            }
    }
    LDS_WAIT();
    if (hi == 0) fsc[32 + a] = 1.0f / L;
    LDS_WAIT();
    const bf16_t* gp = HB + (Rq + 4 * hi) * HP + C_MG + h * 128 + a;
    bf16_t* mp = MIX + (Rq + 4 * hi) * DMIX + 1024 + h * 128 + a;
#pragma unroll
    for (int g4 = 0; g4 < 4; ++g4) {
        const f32x4 r4 = *(const LAS f32x4*)(fsc + 32 + 8 * g4 + 4 * hi);
#pragma unroll
        for (int e = 0; e < 4; ++e) {
#pragma unroll
            for (int db = 0; db < 4; ++db) {
                const float gate = bf2f(gp[(8 * g4 + e) * HP + 32 * db]);
                mp[(8 * g4 + e) * DMIX + 32 * db] = (bf16_t)(pk_bf16(O[db][4 * g4 + e] * r4[e] * gate, 0.f) & 0xffffu);
            }
        }
        asm volatile("" ::: "memory");
    }
}

constexpr int RT_Q = 0, RT_K = 16384, RT_KD = 32768, RT_V = 49152, RT_R = 81920, RT_O = 98304;
__device__ __forceinline__ void ret_unit(const Params& P, LAS unsigned char* lds, int wave, int lane, int tid, int b, int h) {
    const bf16_t* HB = (const bf16_t*)(P.ws + WS_HB);
    bf16_t* MIX = (bf16_t*)(P.ws + WS_MIX);
    const float gamma = 1.0f - __builtin_amdgcn_exp2f((float)(-5 - h));
    const float lg2c = __builtin_log2f(gamma);
    const int qg = wave & 3, dh = wave >> 2;
    const int dkt = wave & 1, dvt = wave >> 1;
    f32x16 Rt;
#pragma unroll
    for (int e = 0; e < 16; ++e) Rt[e] = 0.f;
    u32x4 pq[2], pk[2], pv[4];
    const size_t rb = (size_t)b * SEQ;
#define RET_ISSUE(n) do { const size_t base_ = rb + 128 * (n); \
        _Pragma("unroll") for (int i = 0; i < 2; ++i) { const int idx = tid + 512 * i, row = idx >> 3, ch = idx & 7; \
            pq[i] = *(const u32x4*)(HB + (base_ + row) * HP + C_RQ + h * 64 + ch * 8); pk[i] = *(const u32x4*)(HB + (base_ + row) * HP + C_RK + h * 64 + ch * 8); } \
        _Pragma("unroll") for (int i = 0; i < 4; ++i) { const int idx = tid + 512 * i, row = idx >> 4, ch = idx & 15; \
            pv[i] = *(const u32x4*)(HB + (base_ + row) * HP + C_RV + h * 128 + ch * 8); } } while (0)
    RET_ISSUE(0);
#pragma unroll 1
    for (int n = 0; n < 16; ++n) {
        float lg2 = lg2c; asm volatile("" : "+v"(lg2));
        int lane_ = lane; asm volatile("" : "+v"(lane_));
        const int a = lane_ & 31, hi = lane_ >> 5, tq = (lane_ & 15) >> 2, tp = lane_ & 3, tg = (lane_ >> 4) & 1;
        __syncthreads();
#pragma unroll
        for (int i = 0; i < 2; ++i) {
            const int idx = tid + 512 * i, row = idx >> 3, ch = idx & 7;
            *(LAS u32x4*)(lds + RT_Q + row * 128 + ((ch ^ (row & 7)) << 4)) = pq[i];
            *(LAS u32x4*)(lds + RT_K + row * 128 + ((ch ^ (row & 7)) << 4)) = pk[i];
            const float fac = fexp2((float)(127 - row) * lg2);
            u32x4 kd;
            kd.x = pk_bf16(bf_lo(pk[i].x) * fac, bf_hi(pk[i].x) * fac); kd.y = pk_bf16(bf_lo(pk[i].y) * fac, bf_hi(pk[i].y) * fac);
            kd.z = pk_bf16(bf_lo(pk[i].z) * fac, bf_hi(pk[i].z) * fac); kd.w = pk_bf16(bf_lo(pk[i].w) * fac, bf_hi(pk[i].w) * fac);
            *(LAS u32x4*)(lds + RT_KD + ((row >> 3) * 2 + (ch >> 2)) * 512 + (row & 7) * 64 + (ch & 3) * 16) = kd;
        }
#pragma unroll
        for (int i = 0; i < 4; ++i) {
            const int idx = tid + 512 * i, row = idx >> 4, ch = idx & 15;
            *(LAS u32x4*)(lds + RT_V + ((row >> 3) * 4 + (ch >> 2)) * 512 + (row & 7) * 64 + (ch & 3) * 16) = pv[i];
        }
        __syncthreads();
        if (n + 1 < 16) RET_ISSUE(n + 1);
        f32x16 O[2];
        bf16x8 qfr[4];
#pragma unroll
        for (int kk = 0; kk < 4; ++kk) { const int row = 32 * qg + a; qfr[kk] = *(const LAS bf16x8*)(lds + RT_Q + row * 128 + (((2 * kk + hi) ^ (row & 7)) << 4)); }
        if (n > 0) {
#pragma unroll
            for (int dt = 0; dt < 2; ++dt) {
                f32x16 X;
#pragma unroll
                for (int e = 0; e < 16; ++e) X[e] = 0.f;
                const int dv = 32 * (2 * dh + dt) + a;
#pragma unroll
                for (int kk = 0; kk < 4; ++kk) {
                    const bf16x8 rf = *(const LAS bf16x8*)(lds + RT_R + dv * 128 + (((2 * kk + hi) ^ (dv & 7)) << 4));
                    X = mfma32(qfr[kk], rf, X);
                }
#pragma unroll
                for (int e = 0; e < 16; ++e) { const int c = (e & 3) + 8 * (e >> 2) + 4 * hi; O[dt][e] = X[e] * fexp2((float)(32 * qg + c + 1) * lg2); }
            }
        } else {
#pragma unroll
            for (int dt = 0; dt < 2; ++dt)
#pragma unroll
                for (int e = 0; e < 16; ++e) O[dt][e] = 0.f;
        }
#pragma unroll
        for (int j = 0; j < 4; ++j) if (j <= qg) {
            f32x16 S;
#pragma unroll
            for (int e = 0; e < 16; ++e) S[e] = 0.f;
#pragma unroll
            for (int kk = 0; kk < 4; ++kk) {
                const int row = 32 * j + a;
                const bf16x8 kf = *(const LAS bf16x8*)(lds + RT_K + row * 128 + (((2 * kk + hi) ^ (row & 7)) << 4));
                S = mfma32(kf, qfr[kk], S);
            }
            unsigned pa[2][4];
#pragma unroll
            for (int e = 0; e < 16; ++e) {
                const int c = (e & 3) + 8 * (e >> 2) + 4 * hi;
                const int diff = 32 * (qg - j) + a - c;
                S[e] = diff >= 0 ? S[e] * fexp2((float)diff * lg2) : 0.f;
            }
#pragma unroll
            for (int s = 0; s < 2; ++s)
#pragma unroll
                for (int w = 0; w < 4; ++w) pa[s][w] = pk_bf16(S[8 * s + 2 * w], S[8 * s + 2 * w + 1]);
#pragma unroll
            for (int s = 0; s < 2; ++s) {
                const bf16x8 pf = __builtin_bit_cast(bf16x8, (u32x4){pa[s][0], pa[s][1], pa[s][2], pa[s][3]});
#pragma unroll
                for (int dt = 0; dt < 2; ++dt) {
                    LAS unsigned char* vb_ = lds + RT_V + ((4 * j + 2 * s) * 4 + (2 * dh + dt)) * 512 + (4 * hi + tq) * 64 + tg * 32 + tp * 8;
                    const s16x4 lo = tr16(vb_), hh = tr16(vb_ + 4 * 512);
                    const bf16x8 vb = {lo[0], lo[1], lo[2], lo[3], hh[0], hh[1], hh[2], hh[3]};
                    O[dt] = mfma32(pf, vb, O[dt]);
                }
            }
        }
        {
            LAS bf16_t* Ob = (LAS bf16_t*)(lds + RT_O);
#pragma unroll
            for (int dt = 0; dt < 2; ++dt)
#pragma unroll
                for (int e = 0; e < 16; ++e) { const int c = (e & 3) + 8 * (e >> 2) + 4 * hi; Ob[(32 * qg + c) * 128 + 32 * (2 * dh + dt) + a] = (bf16_t)(pk_bf16(O[dt][e], 0.f) & 0xffffu); }
        }
        __syncthreads();
        {
            const float g128 = fexp2(128.0f * lg2);
#pragma unroll
            for (int e = 0; e < 16; ++e) Rt[e] *= g128;
#pragma unroll
            for (int s = 0; s < 8; ++s) {
                LAS unsigned char* ka = lds + RT_KD + ((2 * s + hi) * 2 + dkt) * 512 + tq * 64 + tg * 32 + tp * 8;
                LAS unsigned char* va = lds + RT_V + ((2 * s + hi) * 4 + dvt) * 512 + tq * 64 + tg * 32 + tp * 8;
                const s16x4 k0 = tr16(ka), k1 = tr16(ka + 256), v0 = tr16(va), v1 = tr16(va + 256);
                const bf16x8 af = {k0[0], k0[1], k0[2], k0[3], k1[0], k1[1], k1[2], k1[3]};
                const bf16x8 bfv = {v0[0], v0[1], v0[2], v0[3], v1[0], v1[1], v1[2], v1[3]};
                Rt = mfma32(af, bfv, Rt);
            }
            const int dv = 32 * dvt + a;
#pragma unroll
            for (int g4 = 0; g4 < 4; ++g4) {
                const int dk0 = 32 * dkt + 8 * g4 + 4 * hi;
                u32x2 w; w.x = pk_bf16(Rt[4 * g4], Rt[4 * g4 + 1]); w.y = pk_bf16(Rt[4 * g4 + 2], Rt[4 * g4 + 3]);
                *(LAS u32x2*)(lds + RT_R + dv * 128 + (((dk0 >> 3) ^ (dv & 7)) << 4) + (dk0 & 7) * 2) = w;
            }
        }
        {
            const int tok = tid >> 2, part = tid & 3;
            const LAS u32x4* op = (const LAS u32x4*)(lds + RT_O + tok * 256 + part * 64);
            float o[32]; float sm = 0.f;
#pragma unroll
            for (int c4 = 0; c4 < 4; ++c4) {
                const u32x4 w = op[c4];
                o[8 * c4 + 0] = bf_lo(w.x); o[8 * c4 + 1] = bf_hi(w.x); o[8 * c4 + 2] = bf_lo(w.y); o[8 * c4 + 3] = bf_hi(w.y);
                o[8 * c4 + 4] = bf_lo(w.z); o[8 * c4 + 5] = bf_hi(w.z); o[8 * c4 + 6] = bf_lo(w.w); o[8 * c4 + 7] = bf_hi(w.w);
            }
#pragma unroll
            for (int e = 0; e < 32; ++e) sm += o[e];
            sm += __shfl_xor(sm, 1); sm += __shfl_xor(sm, 2);
            const float mean = sm * (1.0f / 128.0f);
            float qq = 0.f;
#pragma unroll
            for (int e = 0; e < 32; ++e) { o[e] -= mean; qq += o[e] * o[e]; }
            qq += __shfl_xor(qq, 1); qq += __shfl_xor(qq, 2);
            const float rstd = 1.0f / sqrtf(qq * (1.0f / 128.0f) + 1e-5f);
            const size_t row = rb + 128 * n + tok;
            const u32x4* gp = (const u32x4*)(HB + row * HP + C_RG + h * 128 + part * 32);
            u32x4* mp = (u32x4*)(MIX + row * DMIX + h * 128 + part * 32);
#pragma unroll
            for (int c4 = 0; c4 < 4; ++c4) {
                const u32x4 g = gp[c4]; u32x4 w;
                w.x = pk_bf16(o[8 * c4 + 0] * rstd * bf_lo(g.x), o[8 * c4 + 1] * rstd * bf_hi(g.x)); w.y = pk_bf16(o[8 * c4 + 2] * rstd * bf_lo(g.y), o[8 * c4 + 3] * rstd * bf_hi(g.y));
                w.z = pk_bf16(o[8 * c4 + 4] * rstd * bf_lo(g.z), o[8 * c4 + 5] * rstd * bf_hi(g.z)); w.w = pk_bf16(o[8 * c4 + 6] * rstd * bf_lo(g.w), o[8 * c4 + 7] * rstd * bf_hi(g.w));
                mp[c4] = w;
            }
        }
    }
#undef RET_ISSUE
    {
        float* outp = P.out + O_RP;
        const int a = lane & 31, hi = lane >> 5;
#pragma unroll
        for (int e = 0; e < 16; ++e) {
            const int pdk = 32 * dkt + (e & 3) + 8 * (e >> 2) + 4 * hi;
            outp[((size_t)((b * 4 + h) * 64 + dmap(pdk))) * 128 + 32 * dvt + a] = Rt[e];
        }
    }
    __syncthreads();
}

#define XB_TMO      128
#define XB_XCNT(j)  (256  + 64 * (j))
#define XB_XSUB(j)  (1280 + 64 * (j))
#define XB_XGEN(j)  (2304 + 64 * (j))
#define XB_TOP      3328
#define XB_TOPGEN   3392
#define XCD_BAR_WORDS 3456
#define XB_SPIN_CAP (1u << 18)

__device__ __forceinline__ unsigned xb_ld(unsigned* p)              { return __hip_atomic_load(p, __ATOMIC_RELAXED, __HIP_MEMORY_SCOPE_AGENT); }
__device__ __forceinline__ unsigned xb_add(unsigned* p, unsigned v) { return __hip_atomic_fetch_add(p, v, __ATOMIC_RELAXED, __HIP_MEMORY_SCOPE_AGENT); }
__device__ __forceinline__ unsigned xb_xcc_id() { return (unsigned)__builtin_amdgcn_s_getreg((3 << 11) | 20) & 0xFu; }
#define XB_SPIN(cond, bar) do { unsigned _sp = 0; while (cond) { __builtin_amdgcn_s_sleep(1); \
    if ((++_sp & 255u) == 0u) { if (xb_ld(&(bar)[XB_TMO])) break; if (_sp > XB_SPIN_CAP) { atomicAdd(&(bar)[XB_TMO], 1u); break; } } } } while (0)

struct XcdBarrier {
    unsigned* bar; unsigned x;
    volatile LAS unsigned* st;
};

__device__ __forceinline__ XcdBarrier xcd_barrier_post(unsigned* bar, volatile LAS unsigned* st) {
    XcdBarrier b; b.bar = bar; b.x = xb_xcc_id(); b.st = st;
    if (threadIdx.x == 0) (void)xb_add(&bar[XB_XCNT(b.x)], 1u);
    return b;
}
__device__ __forceinline__ void xcd_barrier_complete(unsigned* bar, unsigned x, unsigned& nloc, unsigned& nx) {
    const unsigned G = gridDim.x * gridDim.y * gridDim.z;
    unsigned sum, cnt, mine, sp = 0u;
    for (;;) {
        sum = 0u; cnt = 0u; mine = 0u;
#pragma unroll
        for (unsigned j = 0; j < 16; ++j) { const unsigned c = xb_ld(&bar[XB_XCNT(j)]); sum += c; cnt += (c > 0u) ? 1u : 0u; mine = (j == x) ? c : mine; }
        if (sum == G) break;
        __builtin_amdgcn_s_sleep(1);
        if ((++sp & 255u) == 0u) { if (xb_ld(&bar[XB_TMO])) break; if (sp > XB_SPIN_CAP) { atomicAdd(&bar[XB_TMO], 1u); break; } }
    }
    nloc = mine > 0u ? mine : 1u; nx = cnt > 0u ? cnt : 1u;
}

__device__ __forceinline__ void xcd_barrier(const XcdBarrier& b) {
    asm volatile("s_waitcnt vmcnt(0)" ::: "memory");
    __syncthreads();
    if (threadIdx.x == 0) {
        unsigned* bar = b.bar;
        __builtin_amdgcn_s_waitcnt(0);
        unsigned nloc = b.st[0], nx = b.st[1];
        if (nloc == 0u) { xcd_barrier_complete(bar, b.x, nloc, nx); b.st[0] = nloc; b.st[1] = nx; }
        const unsigned old = xb_add(&bar[XB_XSUB(b.x)], 1u);
        const unsigned gen = old / nloc;
        if (old + 1u == (gen + 1u) * nloc) {
            __builtin_amdgcn_fence(__ATOMIC_RELEASE, "agent");
            asm volatile("s_waitcnt vmcnt(0)" ::: "memory");
            const unsigned og = xb_add(&bar[XB_TOP], 1u);
            const unsigned tg = og / nx;
            if (og + 1u == (tg + 1u) * nx) xb_add(&bar[XB_TOPGEN], 1u);
            else XB_SPIN(xb_ld(&bar[XB_TOPGEN]) == tg, bar);
            __builtin_amdgcn_fence(__ATOMIC_ACQUIRE, "agent");
            xb_add(&bar[XB_XGEN(b.x)], 1u);
            asm volatile("s_waitcnt vmcnt(0)" ::: "memory");
        } else {
            XB_SPIN(xb_ld(&bar[XB_XGEN(b.x)]) == gen, bar);
            __builtin_amdgcn_fence(__ATOMIC_ACQUIRE, "agent");
            asm volatile("s_waitcnt vmcnt(0)" ::: "memory");
        }
    }
    __syncthreads();
}

struct P1Order {
    int G, c;
    __device__ __forceinline__ bool next(int i, pg8::Unit& u) const {
        const int L = i * G + c;
        if (L >= 1202) return false;
        if (L < 1170) {
            constexpr int nM = 65, nN = 18, nwg = 1170, q = nwg / 8, r = nwg % 8, WGM = 8;
            const int xcd = L % 8, off = L / 8;
            const int wgid = (xcd < r ? xcd * (q + 1) : r * (q + 1) + (xcd - r) * q) + off;
            const int nig = WGM * nN, gid = wgid / nig, fm = gid * WGM, gsz = (nM - fm) < WGM ? (nM - fm) : WGM;
            u.pm = fm + ((wgid % nig) % gsz); u.pn = (wgid % nig) / gsz;
        } else { const int v = L - 1170; u.pm = 65 + (v >> 2); u.pn = 18 + (v & 3); }
        return true;
    }
    __device__ __forceinline__ void a_ready(const pg8::Unit&) const {}
    __device__ __forceinline__ void done(const pg8::Unit&) const {}
};
struct P1Epi {
    static constexpr bool PERM = false, AFTER_DRAIN = false;
    Params P;
    __device__ __forceinline__ void operator()(const f32x4 (&acc)[2][2][4][2], const pg8::Unit& u, int wr, int wc, int fr, int fq) const {
        if (u.pm < 65) epi_inproj(acc, u.pm, u.pn, P, wr, wc, fr, fq);
        else epi_memkv(acc, u.pm - 65, u.pn - 18, P, wr, wc, fr, fq);
    }
};
struct P3Order {
    int G, c;
    __device__ __forceinline__ bool next(int i, pg8::Unit& u) const { const int L = i * G + c; if (L >= 260) return false; u.pm = L >> 2; u.pn = L & 3; return true; }
    __device__ __forceinline__ void a_ready(const pg8::Unit&) const {}
    __device__ __forceinline__ void done(const pg8::Unit&) const {}
};
struct P3Epi {
    static constexpr bool PERM = false, AFTER_DRAIN = false;
    Params P;
    __device__ __forceinline__ void operator()(const f32x4 (&acc)[2][2][4][2], const pg8::Unit& u, int wr, int wc, int fr, int fq) const { epi_outproj(acc, u.pm, u.pn, P, wr, wc, fr, fq); }
};

constexpr int PRM_OFF = LDS_BYTES - 16 - 128;
__device__ __forceinline__ const void* ld_ptr(LAS unsigned char* lds, int i) {
    volatile LAS unsigned* w = (volatile LAS unsigned*)(lds + PRM_OFF);
    const unsigned lo = (unsigned)__builtin_amdgcn_readfirstlane((int)w[2 * i]), hi = (unsigned)__builtin_amdgcn_readfirstlane((int)w[2 * i + 1]);
    return (const void*)(((unsigned long long)hi << 32) | lo);
}
__device__ __forceinline__ Params load_params(LAS unsigned char* lds) {
    Params P;
    P.x_prompt = (const float*)ld_ptr(lds, 0); P.x_sample = (const float*)ld_ptr(lds, 1); P.state_ret = (const float*)ld_ptr(lds, 2);
    P.cache_k = (const float*)ld_ptr(lds, 3); P.cache_v = (const float*)ld_ptr(lds, 4); P.cmem_k = (const float*)ld_ptr(lds, 5);
    P.cmem_v = (const float*)ld_ptr(lds, 6); P.mem_prompt = (const float*)ld_ptr(lds, 7); P.w_in = (const float*)ld_ptr(lds, 8);
    P.w_mkv = (const float*)ld_ptr(lds, 9); P.w_out = (const float*)ld_ptr(lds, 10); P.ln_g = (const float*)ld_ptr(lds, 11);
    P.ln_b = (const float*)ld_ptr(lds, 12); P.out = (float*)ld_ptr(lds, 13); P.ws = (unsigned char*)ld_ptr(lds, 14);
    return P;
}

__global__ void __launch_bounds__(512, 2) fwd_kernel(Params Pk) {
    extern __shared__ __attribute__((aligned(16))) unsigned char lds_raw[];
    LAS unsigned char* lds = (LAS unsigned char*)lds_raw;
    const int tid = threadIdx.x, lane = tid & 63, wave = __builtin_amdgcn_readfirstlane(tid >> 6);
    const int wr = wave >> 2, wc = wave & 3, fr = lane & 15, fq = lane >> 4;
    const int G = gridDim.x;
    if (tid < 4) ((LAS unsigned*)(lds + LDS_BYTES - 16))[tid] = 0u;
    if (tid >= 64 && tid < 94) ((LAS unsigned*)(lds + PRM_OFF))[tid - 64] = ((const unsigned*)__builtin_amdgcn_kernarg_segment_ptr())[tid - 64];
    __syncthreads();
    const XcdBarrier bar = xcd_barrier_post((unsigned*)((unsigned char*)ld_ptr(lds, 14) + WS_CTL) + 4096, (volatile LAS unsigned*)(lds + LDS_BYTES - 16));

    { const Params P = load_params(lds); phase0(P, lds, tid, lane, wave); }
    xcd_barrier(bar);

    {
        const Params P = load_params(lds);
        const pg8::Gemm g{(const bf16_t*)(P.ws + WS_XB), (const bf16_t*)(P.ws + WS_WTIN), ROWS_ALL, DIN + 1024, DM};
        const P1Order S{G, (int)blockIdx.x};
        const P1Epi E{P};
        pg8::gemm_phase<P1Epi, P1Order, true, true>(lds, g, S, E);
    }
    xcd_barrier(bar);

    {
        const Params P = load_params(lds);
        unsigned* ctl = (unsigned*)(P.ws + WS_CTL);
        for (int u = blockIdx.x; u < 160; u += G) {
            if (u < 32) ret_unit(P, lds, wave, lane, tid, u >> 2, u & 3);
            else { const int v = u - 32; ret_scan(P, lds, v >> 2, v & 3, M_PROMPT + (v >> 2) * 4, 4, P.state_ret, P.out + O_RS, tid); }
        }
        __syncthreads();
        for (int u = blockIdx.x; u < 256; u += G) swa_unit(P, lds, wave, lane, u >> 5, (u >> 2) & 7, u & 3);
        for (int u = blockIdx.x; u < 256; u += G) mem_unit(P, lds, wave, lane, u >> 5, (u >> 3) & 3, u & 7);
        __syncthreads();
        LAS float* wsc = (LAS float*)(lds + wave * 1024);
        for (;;) {
            unsigned u = 0;
            if (lane == 0) u = atomicAdd(ctl + 64, 1u);
            u = (unsigned)__builtin_amdgcn_readfirstlane((int)u);
            if (u >= 2048u + 2048u + 1024u + 512u) break;
            if (u < 2048u) { continue; }
            else if (u < 4096u) { continue; }
            else if (u < 5120u) { const unsigned v = u - 4096u; swa_sample_wave(P, wsc, v >> 5, (v >> 2) & 7, v & 3, lane); }
            else { const unsigned v = u - 5120u; mem_sample_wave(P, wsc, v >> 4, (v >> 2) & 3, v & 3, lane); }
        }
    }
    xcd_barrier(bar);

    {
        const Params P = load_params(lds);
        const pg8::Gemm g{(const bf16_t*)(P.ws + WS_MIX), (const bf16_t*)(P.ws + WS_WTOUT), ROWS_IN, DM, DMIX};
        const P3Order S{G, (int)blockIdx.x};
        const P3Epi E{P};
        pg8::gemm_phase<P3Epi, P3Order, true, true>(lds, g, S, E);
    }
    xcd_barrier(bar);

    {
        const Params P = load_params(lds);
        const int gw = blockIdx.x * 8 + wave, NGW = G * 8;
        for (int r = gw; r < M_PROMPT + M_SAMPLE; r += NGW) {
            float* zr = r < M_PROMPT ? P.out + O_YP + (size_t)r * DM : P.out + O_YS + (size_t)(r - M_PROMPT) * DM;
            f32x4 v[4]; float s = 0.f;
#pragma unroll
            for (int j = 0; j < 4; ++j) { v[j] = ((const f32x4*)zr)[lane + 64 * j]; s += (v[j][0] + v[j][1]) + (v[j][2] + v[j][3]); }
            const float mean = wave_sum(s) * (1.0f / DM);
            float q = 0.f;
#pragma unroll
            for (int j = 0; j < 4; ++j) { v[j] = v[j] - mean; q += (v[j][0] * v[j][0] + v[j][1] * v[j][1]) + (v[j][2] * v[j][2] + v[j][3] * v[j][3]); }
            const float rstd = 1.0f / sqrtf(wave_sum(q) * (1.0f / DM) + 1e-5f);
#pragma unroll
            for (int j = 0; j < 4; ++j) {
                const f32x4 g = ((const f32x4*)P.ln_g)[lane + 64 * j], bb = ((const f32x4*)P.ln_b)[lane + 64 * j];
                ((f32x4*)zr)[lane + 64 * j] = v[j] * rstd * g + bb;
            }
        }
    }
}

extern "C" void kernel_launch(void* const* d_in, const int* in_sizes, int n_in, void* d_out, int out_size, void* d_ws, size_t ws_size, hipStream_t stream) {
    static int grid_blocks = 0;
    if (!grid_blocks) {
        int dev = 0, cus = 0, per_cu = 0;
        hipGetDevice(&dev);
        hipDeviceGetAttribute(&cus, hipDeviceAttributeMultiprocessorCount, dev);
        hipFuncSetAttribute((const void*)fwd_kernel, hipFuncAttributeMaxDynamicSharedMemorySize, LDS_BYTES);
        hipOccupancyMaxActiveBlocksPerMultiprocessor(&per_cu, (const void*)fwd_kernel, 512, LDS_BYTES);
        if (per_cu < 1) { fprintf(stderr, "kernel_launch: occupancy query says %d blocks per CU\n", per_cu); per_cu = 1; }
        grid_blocks = cus;
        if (ws_size < WS_END) fprintf(stderr, "kernel_launch: workspace too small (%zu < %zu)\n", ws_size, (size_t)WS_END);
    }
    hipMemsetAsync((char*)d_ws + WS_CTL, 0, 65536, stream);
    Params p{};
    p.x_prompt = (const float*)d_in[0]; p.x_sample = (const float*)d_in[1]; p.state_ret = (const float*)d_in[2];
    p.cache_k = (const float*)d_in[3]; p.cache_v = (const float*)d_in[4]; p.cmem_k = (const float*)d_in[5]; p.cmem_v = (const float*)d_in[6];
    p.mem_prompt = (const float*)d_in[7]; p.w_in = (const float*)d_in[8]; p.w_mkv = (const float*)d_in[9]; p.w_out = (const float*)d_in[10];
    p.ln_g = (const float*)d_in[11]; p.ln_b = (const float*)d_in[12];
    p.out = (float*)d_out; p.ws = (unsigned char*)d_ws;
    hipLaunchKernelGGL(fwd_kernel, dim3(grid_blocks), dim3(512), LDS_BYTES, stream, p);
    hipError_t e = hipPeekAtLastError();
    if (e != hipSuccess) fprintf(stderr, "launch failed: %s (grid %d)\n", hipGetErrorString(e), grid_blocks);
}
```

```cpp
#include <hip/hip_runtime.h>
#include <hip/hip_cooperative_groups.h>
#include <cstdio>
#include <cstdint>
namespace cg = cooperative_groups;

#define LAS __attribute__((address_space(3)))
typedef unsigned short bf16_t;
typedef short bf16x8 __attribute__((ext_vector_type(8)));
typedef float f32x4 __attribute__((ext_vector_type(4)));
typedef float f32x2 __attribute__((ext_vector_type(2)));
typedef unsigned u32x4 __attribute__((ext_vector_type(4)));
typedef unsigned u32x2 __attribute__((ext_vector_type(2)));
typedef __bf16 bf16x2_t __attribute__((ext_vector_type(2)));

constexpr int DM = 1024, NB = 8, SEQ = 2048, DECB = 32, DECT = 4;
constexpr int NMEM = 256, DIN = 4608, DMIX = 1536;
constexpr int M_PROMPT = NB * SEQ;
constexpr int M_SAMPLE = DECB * DECT;
constexpr int ROWS_IN = M_PROMPT + 256;
constexpr int ROWS_ALL = ROWS_IN + NB * NMEM;
constexpr int HP = DIN;
constexpr int C_RQ = 0, C_RK = 256, C_RV = 512, C_RG = 1024, C_SQ = 1536, C_SK = 2048, C_SV = 2560, C_SG = 3072, C_MQ = 3584, C_MG = 4096;
constexpr size_t O_YP = 0, O_YS = 16777216, O_RP = 16908288, O_RS = 17170432, O_KP = 18219008, O_VP = 26607616,
                 O_KS = 34996224, O_VS = 35061760, O_MK = 35127296, O_MV = 36175872;
constexpr size_t MiB = 1u << 20;
constexpr size_t WS_CTL = 0, WS_ROPE = 1 * MiB, WS_WTIN = 2 * MiB, WS_WTMKV = 11 * MiB, WS_WTOUT = 14 * MiB,
                 WS_XB = 20 * MiB, WS_HB = 64 * MiB, WS_MKV = 212 * MiB, WS_MIX = 216 * MiB, WS_END = 268 * MiB;
constexpr int LDS_BYTES = 163840;
constexpr float LOG2E = 1.4426950408889634f;
constexpr float SQ_SCALE = 0.18033688011112042f;
constexpr float MQ_SCALE = 0.12751743082459868f;
constexpr float ALPHA = 1.189207115002721f;

struct Params {
    const float *x_prompt, *x_sample, *state_ret, *cache_k, *cache_v, *cmem_k, *cmem_v, *mem_prompt, *w_in, *w_mkv, *w_out, *ln_g, *ln_b;
    float* out;
    unsigned char* ws;
};

__device__ __forceinline__ unsigned pk_bf16(float lo, float hi) { f32x2 v = {lo, hi}; bf16x2_t b = __builtin_convertvector(v, bf16x2_t); return __builtin_bit_cast(unsigned, b); }
__device__ __forceinline__ float bf_lo(unsigned u) { return __uint_as_float(u << 16); }
__device__ __forceinline__ float bf_hi(unsigned u) { return __uint_as_float(u & 0xffff0000u); }
__device__ __forceinline__ float bf2f(bf16_t h) { return __uint_as_float(((unsigned)h) << 16); }
__device__ __forceinline__ float fexp2(float x) { return __builtin_amdgcn_exp2f(x); }
__device__ __forceinline__ float frcp(float x) { return __builtin_amdgcn_rcpf(x); }
__device__ __forceinline__ float silu(float x) { return x * frcp(1.0f + fexp2(-x * LOG2E)); }
__device__ __forceinline__ float wave_max(float v) {
#pragma unroll
    for (int o = 1; o < 64; o <<= 1) v = fmaxf(v, __shfl_xor(v, o));
    return v;
}
__device__ __forceinline__ float wave_sum(float v) {
#pragma unroll
    for (int o = 1; o < 64; o <<= 1) v += __shfl_xor(v, o);
    return v;
}
#define LDS_WAIT() asm volatile("s_waitcnt lgkmcnt(0)" ::: "memory")
__device__ __forceinline__ int perm32(int rho) { const int n = rho >> 4, i = rho & 15; return 8 * (i >> 2) + 4 * n + (i & 3); }
__device__ __forceinline__ int dmap(int p) { return 16 * (p >> 5) + 32 * ((p >> 2) & 1) + 4 * ((p >> 3) & 3) + (p & 3); }
__device__ __forceinline__ int src_col_in(int c) {
    const int rho = c & 31;
    const bool rope = (c < 512) || (c >= 1536 && c < 2560);
    if (rope) return (c & ~63) + 16 * ((c >> 5) & 1) + 32 * (rho >> 4) + (rho & 15);
    return (c & ~31) + perm32(rho);
}

__device__ __forceinline__ void transpose_item(const float* W, int K, int N, bf16_t* WT, int mode, LAS float* scr, int item, int lane) {
    const int nblk = N / 32, kb = item / nblk, nb = item % nblk, k0 = 64 * kb, n0 = 32 * nb;
    const int cl = lane & 31;
    const int sc = (mode == 0) ? (n0 + cl) : (mode == 1) ? (n0 + perm32(cl)) : src_col_in(n0 + cl);
#pragma unroll 8
    for (int i = 0; i < 32; ++i) { const int kk = 2 * i + (lane >> 5); scr[kk * 33 + cl] = W[(size_t)(k0 + kk) * N + sc]; }
    LDS_WAIT();
    const int c = lane & 7;
#pragma unroll
    for (int j = 0; j < 4; ++j) {
        const int n = (lane >> 3) + 8 * j; const LAS float* s = scr + (8 * c) * 33 + n;
        u32x4 o; o.x = pk_bf16(s[0 * 33], s[1 * 33]); o.y = pk_bf16(s[2 * 33], s[3 * 33]); o.z = pk_bf16(s[4 * 33], s[5 * 33]); o.w = pk_bf16(s[6 * 33], s[7 * 33]);
        *(u32x4*)(WT + (size_t)(n0 + n) * K + k0 + 8 * c) = o;
    }
    LDS_WAIT();
}
__device__ __forceinline__ void sincos_d(double a, float& s, float& c) {
    const double kd = __builtin_rint(a * 0.63661977236758134308);
    double y = __builtin_fma(-kd, 1.57079632679489655800e+00, a); y = __builtin_fma(-kd, 6.12323399573676603587e-17, y);
    const double y2 = y * y;
    const double sp = y * (1.0 + y2 * (-1.0 / 6 + y2 * (1.0 / 120 + y2 * (-1.0 / 5040 + y2 * (1.0 / 362880 + y2 * (-1.0 / 39916800 + y2 * (1.0 / 6227020800.0)))))));
    const double cp = 1.0 + y2 * (-0.5 + y2 * (1.0 / 24 + y2 * (-1.0 / 720 + y2 * (1.0 / 40320 + y2 * (-1.0 / 3628800 + y2 * (1.0 / 479001600.0))))));
    const int k = ((int)kd) & 3;
    const double sv = (k == 0) ? sp : (k == 1) ? cp : (k == 2) ? -sp : -cp;
    const double cv = (k == 0) ? cp : (k == 1) ? -sp : (k == 2) ? -cp : sp;
    s = (float)sv; c = (float)cv;
}
__device__ __forceinline__ void phase0(const Params& P, LAS unsigned char* lds, int tid, int lane, int wave) {
    unsigned char* ws = P.ws;
    const int gw = blockIdx.x * 8 + wave, NGW = gridDim.x * 8;
    LAS float* scr = (LAS float*)(lds + wave * 8448);
    constexpr int I_IN = (DM / 64) * (DIN / 32), I_MKV = (DM / 64) * (1024 / 32), I_OUT = (DMIX / 64) * (DM / 32);
    for (int it = gw; it < I_IN + I_MKV + I_OUT; it += NGW) {
        int r = it;
        if (r < I_IN) { transpose_item(P.w_in, DM, DIN, (bf16_t*)(ws + WS_WTIN), 2, scr, r, lane); continue; } r -= I_IN;
        if (r < I_MKV) { transpose_item(P.w_mkv, DM, 1024, (bf16_t*)(ws + WS_WTMKV), 1, scr, r, lane); continue; } r -= I_MKV;
        transpose_item(P.w_out, DMIX, DM, (bf16_t*)(ws + WS_WTOUT), 0, scr, r, lane);
    }
    bf16_t* XB = (bf16_t*)(ws + WS_XB);
    for (int m = gw; m < ROWS_ALL; m += NGW) {
        const float* src = (m < M_PROMPT) ? P.x_prompt + (size_t)m * DM : (m < M_PROMPT + M_SAMPLE) ? P.x_sample + (size_t)(m - M_PROMPT) * DM
                         : (m < ROWS_IN) ? nullptr : P.mem_prompt + (size_t)(m - ROWS_IN) * DM;
        u32x2* dst = (u32x2*)(XB + (size_t)m * DM) + lane;
#pragma unroll
        for (int j = 0; j < 4; ++j) {
            f32x4 v = {0.f, 0.f, 0.f, 0.f};
            if (src) v = ((const f32x4*)src)[lane + 64 * j];
            u32x2 o; o.x = pk_bf16(v.x, v.y); o.y = pk_bf16(v.z, v.w); dst[64 * j] = o;
        }
    }
    float* rope = (float*)(ws + WS_ROPE);
    for (int e = blockIdx.x * 512 + tid; e < 2052 * 32; e += gridDim.x * 512) {
        const int idx = e >> 5, i = e & 31;
        const int pos = idx < 2048 ? idx : 8192 + (idx - 2048);
        double inv = 1.0;
        for (int k = 0; k < i; ++k) inv *= 0.7498942093324559;
        float s, c; sincos_d((double)pos * inv, s, c);
        rope[2 * e] = c; rope[2 * e + 1] = s;
    }
}

template <int K>
__device__ __forceinline__ void gemm_mainloop(const bf16_t* __restrict__ A, const bf16_t* __restrict__ Bt, LAS unsigned char* lds,
                                              f32x4 (&acc)[2][2][4][2], int tid, int wr, int wc, int fr, int fq) {
    constexpr int PITCH = 144;
    LAS unsigned char* As = lds; LAS unsigned char* Bs = lds + 256 * PITCH;
    const int lrow = tid >> 3, lch = tid & 7;
    const bf16_t* ga = A + (size_t)lrow * K + lch * 8;
    const bf16_t* gb = Bt + (size_t)lrow * K + lch * 8;
    u32x4 ra[4], rb[4];
#pragma unroll
    for (int i = 0; i < 4; ++i) { ra[i] = *(const u32x4*)(ga + (size_t)i * 64 * K); rb[i] = *(const u32x4*)(gb + (size_t)i * 64 * K); }
#pragma unroll
    for (int a = 0; a < 2; ++a)
#pragma unroll
        for (int b = 0; b < 2; ++b)
#pragma unroll
            for (int m = 0; m < 4; ++m)
#pragma unroll
                for (int n = 0; n < 2; ++n) acc[a][b][m][n] = (f32x4){0.f, 0.f, 0.f, 0.f};
    for (int kt = 0; kt < K / 64; ++kt) {
        __syncthreads();
#pragma unroll
        for (int i = 0; i < 4; ++i) {
            *(LAS u32x4*)(As + (lrow + 64 * i) * PITCH + lch * 16) = ra[i];
            *(LAS u32x4*)(Bs + (lrow + 64 * i) * PITCH + lch * 16) = rb[i];
        }
        __syncthreads();
        if (kt + 1 < K / 64) {
#pragma unroll
            for (int i = 0; i < 4; ++i) { ra[i] = *(const u32x4*)(ga + (size_t)i * 64 * K + (kt + 1) * 64); rb[i] = *(const u32x4*)(gb + (size_t)i * 64 * K + (kt + 1) * 64); }
        }
#pragma unroll
        for (int ai = 0; ai < 2; ++ai) {
#pragma unroll
            for (int k = 0; k < 2; ++k) {
                bf16x8 At[4];
#pragma unroll
                for (int m = 0; m < 4; ++m) At[m] = *(const LAS bf16x8*)(As + (ai * 128 + wr * 64 + m * 16 + fr) * PITCH + (k * 32 + fq * 8) * 2);
#pragma unroll
                for (int bj = 0; bj < 2; ++bj) {
                    bf16x8 Bf[2];
#pragma unroll
                    for (int n = 0; n < 2; ++n) Bf[n] = *(const LAS bf16x8*)(Bs + (bj * 128 + wc * 32 + n * 16 + fr) * PITCH + (k * 32 + fq * 8) * 2);
#pragma unroll
                    for (int m = 0; m < 4; ++m)
#pragma unroll
                        for (int n = 0; n < 2; ++n) acc[ai][bj][m][n] = __builtin_amdgcn_mfma_f32_16x16x32_bf16(Bf[n], At[m], acc[ai][bj][m][n], 0, 0, 0);
                }
            }
        }
    }
}


namespace pg8 {
#define PG8_LAS __attribute__((address_space(3)))
typedef unsigned short bf16_t;
typedef short bf16x8 __attribute__((ext_vector_type(8)));
typedef float f32x4 __attribute__((ext_vector_type(4)));
constexpr int BM = 256, BK = 64, HALF = 128, HTB = HALF * BK * 2, STAGE_BYTES = 8 * HTB;
__host__ __device__ __forceinline__ int lds_byte(int r, int c) { const int st = (r >> 4) * 2 + (c >> 5), rr = r & 15, cc = c & 31, ob = rr * 64 + cc * 2; return st * 1024 + (ob ^ (((ob >> 9) & 1) << 5)); }
__host__ __device__ __forceinline__ void stage_rc(int b, int& R, int& C) { const int st = b / 1024, sb = b % 1024, swz = sb ^ (((sb >> 9) & 1) << 5); R = (st >> 1) * 16 + swz / 64; C = (st & 1) * 32 + (swz % 64) / 2; }
__host__ __device__ __forceinline__ int perm32(int rho) { const int n = rho >> 4, i = rho & 15; return 8 * (i >> 2) + 4 * n + (i & 3); }
struct Unit { int pm, pn; };
struct Gemm { const bf16_t* A; const bf16_t* Bt; int M, N, K; };
template <class Epi, class Sched, bool ALIGN_EPI = false, bool SP2 = false>
__device__ __forceinline__ void gemm_phase(PG8_LAS unsigned char* lds, const Gemm g, const Sched& S, const Epi& E) {
    const int tid = threadIdx.x, wid = __builtin_amdgcn_readfirstlane(tid >> 6), lane = tid & 63, wr = wid >> 2, wc = wid & 3, fr = lane & 15, fq = lane >> 4;
    const int K = g.K, nt = K / BK;
    unsigned voffA[2], voffB[2];
#pragma unroll
    for (int i = 0; i < 2; ++i) { int R, C; stage_rc(tid * 16 + i * 8192, R, C); const int Rb = Epi::PERM ? ((R & ~31) + perm32(R & 31)) : R;
        voffA[i] = (unsigned)(R * K + C) * 2u; voffB[i] = (unsigned)(Rb * K + C) * 2u; }
    const size_t kstep = (size_t)(BK * 2);
    const size_t hstep = (size_t)HALF * K * 2;
    const size_t tstep = 2 * hstep;
    const unsigned ldsw = (unsigned)wid * 1024u;
    const int aoff = lds_byte(wr * 64 + fr, fq * 8), boff = lds_byte(wc * 32 + fr, fq * 8);
#define PG8_SA(b, h) (((b) * 2 + (h)) * HTB)
#define PG8_SB(b, h) ((4 + (b) * 2 + (h)) * HTB)
#define PG8_STAGE(bufoff, gbase, voff) do { _Pragma("unroll") for (int _i = 0; _i < 2; ++_i) \
        __builtin_amdgcn_global_load_lds((const unsigned*)((const char*)(gbase) + (voff)[_i]), (PG8_LAS unsigned*)(lds + (bufoff) + ldsw + _i * 8192), 16, 0, 0); } while (0)
#define PG8_LDA(dst, b, h) do { _Pragma("unroll") for (int m = 0; m < 4; ++m) _Pragma("unroll") for (int k = 0; k < 2; ++k) dst[m][k] = *(const PG8_LAS bf16x8*)(lds + PG8_SA(b, h) + aoff + m * 2048 + k * 1024); } while (0)
#define PG8_LDB(dst, b, h) do { _Pragma("unroll") for (int n = 0; n < 2; ++n) _Pragma("unroll") for (int k = 0; k < 2; ++k) dst[n][k] = *(const PG8_LAS bf16x8*)(lds + PG8_SB(b, h) + boff + n * 2048 + k * 1024); } while (0)
#define PG8_MMA(ai, bj, At, Bt) do { __builtin_amdgcn_s_setprio(1); _Pragma("unroll") for (int m = 0; m < 4; ++m) _Pragma("unroll") for (int n = 0; n < 2; ++n) _Pragma("unroll") for (int k = 0; k < 2; ++k) \
        acc[ai][bj][m][n] = __builtin_amdgcn_mfma_f32_16x16x32_bf16(Bt[n][k], At[m][k], acc[ai][bj][m][n], 0, 0, 0); __builtin_amdgcn_s_setprio(0); } while (0)
#define PG8_WAIT_V(n) asm volatile("s_waitcnt vmcnt(" #n ")" ::: "memory")
#define PG8_WAIT_L(n) asm volatile("s_waitcnt lgkmcnt(" #n ")" ::: "memory")
#define PG8_BAR __builtin_amdgcn_s_barrier()
#define PG8_SCHED __builtin_amdgcn_sched_barrier(0)
    Unit cur, nxt; int ui = 0;
    if (!S.next(0, cur)) return;
    f32x4 acc[2][2][4][2];
#pragma unroll
    for (int a = 0; a < 2; ++a)
#pragma unroll
        for (int b = 0; b < 2; ++b)
#pragma unroll
            for (int m = 0; m < 4; ++m)
#pragma unroll
                for (int n = 0; n < 2; ++n) acc[a][b][m][n] = (f32x4){0.f, 0.f, 0.f, 0.f};
    bf16x8 At[4][2], B0[2][2], B1[2][2];
    const char* cA = (const char*)g.A + (size_t)cur.pm * tstep; const char* cB = (const char*)g.Bt + (size_t)cur.pn * tstep;
    S.a_ready(cur);
    if constexpr (SP2) {
        PG8_STAGE(PG8_SB(0, 0), cB, voffB); PG8_STAGE(PG8_SB(0, 1), cB + hstep, voffB); PG8_STAGE(PG8_SA(0, 0), cA, voffA); PG8_STAGE(PG8_SA(0, 1), cA + hstep, voffA);
        if (wr == 1) PG8_BAR;
        PG8_WAIT_V(2); PG8_BAR;
        PG8_STAGE(PG8_SB(1, 0), cB + kstep, voffB); PG8_STAGE(PG8_SA(1, 0), cA + kstep, voffA); PG8_STAGE(PG8_SB(1, 1), cB + hstep + kstep, voffB);
        PG8_WAIT_V(6); PG8_BAR;
    } else {
        PG8_STAGE(PG8_SB(0, 0), cB, voffB); PG8_STAGE(PG8_SA(0, 0), cA, voffA); PG8_STAGE(PG8_SB(0, 1), cB + hstep, voffB); PG8_STAGE(PG8_SA(0, 1), cA + hstep, voffA);
        if (wr == 1) PG8_BAR;
        PG8_WAIT_V(4); PG8_BAR;
        PG8_STAGE(PG8_SB(1, 0), cB + kstep, voffB); PG8_STAGE(PG8_SA(1, 0), cA + kstep, voffA); PG8_STAGE(PG8_SB(1, 1), cB + hstep + kstep, voffB);
        PG8_WAIT_V(6); PG8_BAR;
    }
    for (;;) {
        const bool has_next = S.next(ui + 1, nxt);
        const char* nA = has_next ? (const char*)g.A + (size_t)nxt.pm * tstep : cA; const char* nB = has_next ? (const char*)g.Bt + (size_t)nxt.pn * tstep : cB;
        for (int t = 0; t < nt; t += 2) {
            const bool last = (t == nt - 2);
            const char* a1 = cA + (size_t)(t + 1) * kstep;
            const char* a2 = last ? nA : cA + (size_t)(t + 2) * kstep; const char* b2 = last ? nB : cB + (size_t)(t + 2) * kstep;
            const char* a3 = a2 + kstep; const char* b3 = b2 + kstep;
            if (last && has_next) S.a_ready(nxt);
            if constexpr (SP2) {
            PG8_LDB(B0, 0, 0); PG8_LDB(B1, 0, 1); PG8_SCHED; PG8_LDA(At, 0, 0); PG8_STAGE(PG8_SA(1, 1), a1 + hstep, voffA);
            PG8_WAIT_V(8); PG8_WAIT_L(0); PG8_BAR; PG8_MMA(0, 0, At, B0); PG8_MMA(0, 1, At, B1); PG8_BAR; PG8_SCHED;
            PG8_LDA(At, 0, 1); PG8_STAGE(PG8_SB(0, 0), b2, voffB); PG8_STAGE(PG8_SB(0, 1), b2 + hstep, voffB); PG8_STAGE(PG8_SA(0, 0), a2, voffA);
            PG8_WAIT_V(8); PG8_WAIT_L(0); PG8_BAR; PG8_MMA(1, 0, At, B0); PG8_MMA(1, 1, At, B1); PG8_BAR; PG8_SCHED;
            PG8_LDB(B0, 1, 0); PG8_LDB(B1, 1, 1); PG8_SCHED; PG8_LDA(At, 1, 0); PG8_STAGE(PG8_SA(0, 1), a2 + hstep, voffA);
            PG8_WAIT_V(8); PG8_WAIT_L(0); PG8_BAR; PG8_MMA(0, 0, At, B0); PG8_MMA(0, 1, At, B1); PG8_BAR; PG8_SCHED;
            PG8_LDA(At, 1, 1); PG8_STAGE(PG8_SB(1, 0), b3, voffB); PG8_STAGE(PG8_SB(1, 1), b3 + hstep, voffB); PG8_STAGE(PG8_SA(1, 0), a3, voffA);
            PG8_WAIT_V(8); PG8_WAIT_L(0); PG8_BAR; PG8_MMA(1, 0, At, B0); PG8_MMA(1, 1, At, B1); PG8_BAR; PG8_SCHED;
            } else {
            PG8_LDB(B0, 0, 0); PG8_SCHED; PG8_LDA(At, 0, 0); PG8_STAGE(PG8_SA(1, 1), a1 + hstep, voffA);
            PG8_WAIT_L(8); PG8_BAR; PG8_WAIT_L(0); PG8_MMA(0, 0, At, B0); PG8_BAR; PG8_SCHED;
            PG8_LDB(B1, 0, 1); PG8_STAGE(PG8_SB(0, 0), b2, voffB);
            PG8_BAR; PG8_WAIT_L(0); PG8_MMA(0, 1, At, B1); PG8_BAR;
            PG8_LDA(At, 0, 1); PG8_STAGE(PG8_SA(0, 0), a2, voffA);
            PG8_BAR; PG8_WAIT_L(0); PG8_MMA(1, 0, At, B0); PG8_BAR; PG8_SCHED;
            PG8_STAGE(PG8_SB(0, 1), b2 + hstep, voffB);
            PG8_WAIT_V(6); PG8_BAR; PG8_MMA(1, 1, At, B1); PG8_BAR;
            PG8_LDB(B0, 1, 0); PG8_SCHED; PG8_LDA(At, 1, 0); PG8_STAGE(PG8_SA(0, 1), a2 + hstep, voffA);
            PG8_WAIT_L(8); PG8_BAR; PG8_WAIT_L(0); PG8_MMA(0, 0, At, B0); PG8_BAR; PG8_SCHED;
            PG8_LDB(B1, 1, 1); PG8_STAGE(PG8_SB(1, 0), b3, voffB);
            PG8_BAR; PG8_WAIT_L(0); PG8_MMA(0, 1, At, B1); PG8_BAR;
            PG8_LDA(At, 1, 1); PG8_STAGE(PG8_SA(1, 0), a3, voffA);
            PG8_BAR; PG8_WAIT_L(0); PG8_MMA(1, 0, At, B0); PG8_BAR; PG8_SCHED;
            PG8_STAGE(PG8_SB(1, 1), b3 + hstep, voffB);
            PG8_WAIT_V(6); PG8_BAR; PG8_MMA(1, 1, At, B1); PG8_BAR;
            }
        }
        if constexpr (ALIGN_EPI) { if (wr == 0) PG8_BAR; }
        if constexpr (!Epi::AFTER_DRAIN) { E(acc, cur, wr, wc, fr, fq); S.done(cur); }
        if (!has_next) break;
#pragma unroll
        for (int a = 0; a < 2; ++a)
#pragma unroll
            for (int b = 0; b < 2; ++b)
#pragma unroll
                for (int m = 0; m < 4; ++m)
#pragma unroll
                    for (int n = 0; n < 2; ++n) acc[a][b][m][n] = (f32x4){0.f, 0.f, 0.f, 0.f};
        cur = nxt; cA = nA; cB = nB; ++ui;
        if constexpr (ALIGN_EPI) { if (wr == 1) PG8_BAR; }
    }
    PG8_WAIT_V(0);
    if constexpr (!ALIGN_EPI) { if (wr == 0) PG8_BAR; }
    PG8_BAR;
    if constexpr (Epi::AFTER_DRAIN) { E.fused(acc, cur, wr, wc, fr, fq, lds, wid, lane); S.done(cur); }
#undef PG8_SA
#undef PG8_SB
#undef PG8_STAGE
#undef PG8_LDA
#undef PG8_LDB
#undef PG8_MMA
#undef PG8_WAIT_V
#undef PG8_WAIT_L
#undef PG8_BAR
#undef PG8_SCHED
}
}

__device__ __forceinline__ void epi_inproj(const f32x4 (&acc)[2][2][4][2], int pm, int pn, const Params& P, int wr, int wc, int fr, int fq) {
    bf16_t* HB = (bf16_t*)(P.ws + WS_HB);
    const float* rope = (const float*)(P.ws + WS_ROPE);
    int type = 0; float scale = 1.0f; int f32out = 0;
    if (pn == 0) { type = 1; }
    else if (pn == 1) { type = 1; scale = 0.125f; }
    else if (pn == 4 || pn == 5 || pn == 12 || pn == 13 || pn == 16 || pn == 17) { type = 2; }
    else if (pn == 6 || pn == 7) { type = 1; scale = SQ_SCALE; }
    else if (pn == 8 || pn == 9) { type = 1; f32out = 1; }
    else if (pn == 10 || pn == 11) { f32out = 2; }
    else if (pn == 14 || pn == 15) { scale = MQ_SCALE; }
#pragma unroll
    for (int ai = 0; ai < 2; ++ai)
#pragma unroll
        for (int m = 0; m < 4; ++m) {
            const int r = pm * 256 + ai * 128 + wr * 64 + m * 16 + fr;
            const int pi = r < M_PROMPT ? (r & 2047) : 2048 + ((r - M_PROMPT) & 3);
            const bool live = r < M_PROMPT + M_SAMPLE;
#pragma unroll
            for (int bj = 0; bj < 2; ++bj) {
                const int cb = pn * 256 + bj * 128 + wc * 32;
                f32x4 v0 = acc[ai][bj][m][0], v1 = acc[ai][bj][m][1];
                if (type == 1) {
                    const int d1 = 16 * ((cb >> 5) & 1) + 4 * fq;
                    const f32x4* rp = (const f32x4*)(rope + ((size_t)pi * 32 + d1) * 2);
                    const f32x4 cs0 = rp[0], cs1 = rp[1];
                    f32x4 y1, y2;
                    y1[0] = v0[0] * cs0[0] - v1[0] * cs0[1]; y2[0] = v1[0] * cs0[0] + v0[0] * cs0[1];
                    y1[1] = v0[1] * cs0[2] - v1[1] * cs0[3]; y2[1] = v1[1] * cs0[2] + v0[1] * cs0[3];
                    y1[2] = v0[2] * cs1[0] - v1[2] * cs1[1]; y2[2] = v1[2] * cs1[0] + v0[2] * cs1[1];
                    y1[3] = v0[3] * cs1[2] - v1[3] * cs1[3]; y2[3] = v1[3] * cs1[2] + v0[3] * cs1[3];
                    if (f32out == 1 && live) {
                        float* o = (r < M_PROMPT ? P.out + O_KP + (size_t)r * 512 : P.out + O_KS + (size_t)(r - M_PROMPT) * 512) + ((cb - C_SK) >> 6) * 64 + d1;
                        *(f32x4*)o = y1; *(f32x4*)(o + 32) = y2;
                    }
                    v0 = y1 * scale; v1 = y2 * scale;
                } else if (type == 2) {
#pragma unroll
                    for (int e = 0; e < 4; ++e) { v0[e] = silu(v0[e]); v1[e] = silu(v1[e]); }
                } else {
                    if (f32out == 2 && live) {
                        float* o = (r < M_PROMPT ? P.out + O_VP + (size_t)r * 512 : P.out + O_VS + (size_t)(r - M_PROMPT) * 512) + (cb - C_SV) + 8 * fq;
                        *(f32x4*)o = v0; *(f32x4*)(o + 4) = v1;
                    }
                    v0 = v0 * scale; v1 = v1 * scale;
                }
                u32x4 w; w.x = pk_bf16(v0[0], v0[1]); w.y = pk_bf16(v0[2], v0[3]); w.z = pk_bf16(v1[0], v1[1]); w.w = pk_bf16(v1[2], v1[3]);
                *(u32x4*)(HB + (size_t)r * HP + cb + 8 * fq) = w;
            }
        }
}
__device__ __forceinline__ void epi_memkv(const f32x4 (&acc)[2][2][4][2], int pm, int pn, const Params& P, int wr, int wc, int fr, int fq) {
    bf16_t* MKV = (bf16_t*)(P.ws + WS_MKV);
#pragma unroll
    for (int ai = 0; ai < 2; ++ai)
#pragma unroll
        for (int m = 0; m < 4; ++m) {
            const int r = pm * 256 + ai * 128 + wr * 64 + m * 16 + fr;
#pragma unroll
            for (int bj = 0; bj < 2; ++bj) {
                const int c0 = pn * 256 + bj * 128 + wc * 32 + 8 * fq;
                const f32x4 v0 = acc[ai][bj][m][0], v1 = acc[ai][bj][m][1];
                float* o = (c0 < 512) ? P.out + O_MK + (size_t)r * 512 + c0 : P.out + O_MV + (size_t)r * 512 + (c0 - 512);
                *(f32x4*)o = v0; *(f32x4*)(o + 4) = v1;
                u32x4 w; w.x = pk_bf16(v0[0], v0[1]); w.y = pk_bf16(v0[2], v0[3]); w.z = pk_bf16(v1[0], v1[1]); w.w = pk_bf16(v1[2], v1[3]);
                *(u32x4*)(MKV + (size_t)r * 1024 + c0) = w;
            }
        }
}
__device__ __forceinline__ void epi_outproj(const f32x4 (&acc)[2][2][4][2], int pm, int pn, const Params& P, int wr, int wc, int fr, int fq) {
#pragma unroll
    for (int ai = 0; ai < 2; ++ai)
#pragma unroll
        for (int m = 0; m < 4; ++m) {
            const int r = pm * 256 + ai * 128 + wr * 64 + m * 16 + fr;
            if (r >= M_PROMPT + M_SAMPLE) continue;
            const float* xr = r < M_PROMPT ? P.x_prompt + (size_t)r * DM : P.x_sample + (size_t)(r - M_PROMPT) * DM;
            float* zr = r < M_PROMPT ? P.out + O_YP + (size_t)r * DM : P.out + O_YS + (size_t)(r - M_PROMPT) * DM;
#pragma unroll
            for (int bj = 0; bj < 2; ++bj)
#pragma unroll
                for (int n = 0; n < 2; ++n) {
                    const int c = pn * 256 + bj * 128 + wc * 32 + 16 * n + 4 * fq;
                    const f32x4 xv = *(const f32x4*)(xr + c);
                    *(f32x4*)(zr + c) = xv * ALPHA + acc[ai][bj][m][n];
                }
        }
}

__device__ __forceinline__ void ret_scan(const Params& P, LAS unsigned char* lds, int b, int h, int row0, int ntok, const float* init, float* outstate, int tid) {
    const bf16_t* HB = (const bf16_t*)(P.ws + WS_HB);
    bf16_t* MIX = (bf16_t*)(P.ws + WS_MIX);
    LAS float* qs = (LAS float*)lds;
    LAS float* ks = qs + 32 * 64;
    LAS float* vs = ks + 32 * 64;
    LAS float* po = vs + 32 * 128;
    const int vv = tid & 127, kq = tid >> 7;
    const float gamma = 1.0f - __builtin_amdgcn_exp2f((float)(-5 - h));
    float S[16];
#pragma unroll
    for (int j = 0; j < 16; ++j) S[j] = init ? init[((size_t)((b * 4 + h) * 64 + dmap(16 * kq + j))) * 128 + vv] : 0.f;
    for (int t0 = 0; t0 < ntok; t0 += 32) {
        const int nb = (ntok - t0) < 32 ? (ntok - t0) : 32;
        __syncthreads();
        {
            const int tt = (tid & 255) >> 3, ch = tid & 7;
            if (tt < nb) {
                const u32x4 w = *(const u32x4*)(HB + (size_t)(row0 + t0 + tt) * HP + (tid < 256 ? C_RQ : C_RK) + h * 64 + ch * 8);
                LAS float* dst = (tid < 256 ? qs : ks) + tt * 64 + ch * 8;
                dst[0] = bf_lo(w.x); dst[1] = bf_hi(w.x); dst[2] = bf_lo(w.y); dst[3] = bf_hi(w.y);
                dst[4] = bf_lo(w.z); dst[5] = bf_hi(w.z); dst[6] = bf_lo(w.w); dst[7] = bf_hi(w.w);
            }
            const int tv = tid >> 4, cv = tid & 15;
            if (tv < nb) {
                const u32x4 w = *(const u32x4*)(HB + (size_t)(row0 + t0 + tv) * HP + C_RV + h * 128 + cv * 8);
                LAS float* dst = vs + tv * 128 + cv * 8;
                dst[0] = bf_lo(w.x); dst[1] = bf_hi(w.x); dst[2] = bf_lo(w.y); dst[3] = bf_hi(w.y);
                dst[4] = bf_lo(w.z); dst[5] = bf_hi(w.z); dst[6] = bf_lo(w.w); dst[7] = bf_hi(w.w);
            }
        }
        __syncthreads();
        for (int tt = 0; tt < nb; ++tt) {
            const float vval = vs[tt * 128 + vv];
            float o = 0.f;
#pragma unroll
            for (int j4 = 0; j4 < 4; ++j4) {
                const f32x4 k4 = *(const LAS f32x4*)(ks + tt * 64 + 16 * kq + 4 * j4);
                const f32x4 q4 = *(const LAS f32x4*)(qs + tt * 64 + 16 * kq + 4 * j4);
#pragma unroll
                for (int e = 0; e < 4; ++e) { S[4 * j4 + e] = fmaf(gamma, S[4 * j4 + e], k4[e] * vval); o = fmaf(q4[e], S[4 * j4 + e], o); }
            }
            po[(tt * 4 + kq) * 128 + vv] = o;
        }
        __syncthreads();
        {
            const int tf = tid >> 4, c8 = (tid & 15) * 8;
            float o[8]; float s = 0.f;
#pragma unroll
            for (int e = 0; e < 8; ++e) { o[e] = (po[(tf * 4 + 0) * 128 + c8 + e] + po[(tf * 4 + 1) * 128 + c8 + e]) + (po[(tf * 4 + 2) * 128 + c8 + e] + po[(tf * 4 + 3) * 128 + c8 + e]); s += o[e]; }
            s += __shfl_xor(s, 1); s += __shfl_xor(s, 2); s += __shfl_xor(s, 4); s += __shfl_xor(s, 8);
            const float mean = s * (1.0f / 128.0f);
            float q = 0.f;
#pragma unroll
            for (int e = 0; e < 8; ++e) { o[e] -= mean; q += o[e] * o[e]; }
            q += __shfl_xor(q, 1); q += __shfl_xor(q, 2); q += __shfl_xor(q, 4); q += __shfl_xor(q, 8);
            const float rstd = 1.0f / sqrtf(q * (1.0f / 128.0f) + 1e-5f);
            if (tf < nb) {
                const size_t row = (size_t)(row0 + t0 + tf);
                const u32x4 g = *(const u32x4*)(HB + row * HP + C_RG + h * 128 + c8);
                u32x4 w;
                w.x = pk_bf16(o[0] * rstd * bf_lo(g.x), o[1] * rstd * bf_hi(g.x)); w.y = pk_bf16(o[2] * rstd * bf_lo(g.y), o[3] * rstd * bf_hi(g.y));
                w.z = pk_bf16(o[4] * rstd * bf_lo(g.z), o[5] * rstd * bf_hi(g.z)); w.w = pk_bf16(o[6] * rstd * bf_lo(g.w), o[7] * rstd * bf_hi(g.w));
                *(u32x4*)(MIX + row * DMIX + h * 128 + c8) = w;
            }
        }
    }
    __syncthreads();
#pragma unroll
    for (int j = 0; j < 16; ++j) outstate[((size_t)((b * 4 + h) * 64 + dmap(16 * kq + j))) * 128 + vv] = S[j];
}

__device__ __forceinline__ float dot4(f32x4 a, f32x4 b) { return (a[0] * b[0] + a[1] * b[1]) + (a[2] * b[2] + a[3] * b[3]); }
__device__ __forceinline__ void swa_sample_unit(const Params& P, LAS unsigned char* lds, int tid, int wave, int b, int h) {
    const bf16_t* HB = (const bf16_t*)(P.ws + WS_HB);
    bf16_t* MIX = (bf16_t*)(P.ws + WS_MIX);
    LAS float* qo = (LAS float*)lds; LAS float* kn = qo + 256; LAS float* vn = kn + 256;
    LAS float* sc = (LAS float*)(lds + 4096); LAS float* ls = (LAS float*)(lds + 10496); LAS float* red = (LAS float*)(lds + 12288);
    const int lane = tid & 63;
    __syncthreads();
    if (tid < 256) {
        const int i = tid >> 6, p = tid & 63; const size_t R = (size_t)M_PROMPT + b * 4 + i;
        qo[i * 64 + dmap(p)] = bf2f(HB[R * HP + C_SQ + h * 64 + p]);
        kn[i * 64 + dmap(p)] = bf2f(HB[R * HP + C_SK + h * 64 + p]);
        vn[i * 64 + p] = bf2f(HB[R * HP + C_SV + h * 64 + p]);
    }
    __syncthreads();
#pragma unroll 1
    for (int rnd = 0; rnd < 4; ++rnd) {
        const int tr = tid + 512 * rnd;
        if (tr < 1548) {
            const int i = tr / 387, rem = tr - i * 387, g = rem / 129, s = rem - g * 129;
            const int dil = (g == 0) ? 1 : (g == 1) ? 4 : 16;
            const int idx = 2048 + i - dil * s;
            float a = 0.f;
            if (idx < 2048) {
                const f32x4* kc = (const f32x4*)(P.cache_k + (((size_t)b * 2048 + idx) * 8 + h) * 64);
                f32x4 kv[16];
#pragma unroll
                for (int c = 0; c < 16; ++c) kv[c] = kc[c];
#pragma unroll
                for (int c = 0; c < 16; ++c) a += dot4(kv[c], *(const LAS f32x4*)(qo + i * 64 + 4 * c));
            } else {
                const LAS f32x4* kc = (const LAS f32x4*)(kn + (idx - 2048) * 64);
#pragma unroll
                for (int c = 0; c < 16; ++c) a += dot4(kc[c], *(const LAS f32x4*)(qo + i * 64 + 4 * c));
            }
            sc[tr] = a;
        }
    }
    __syncthreads();
    if (wave < 4) {
        const int i = wave;
        float m = -INFINITY;
#pragma unroll
        for (int k = 0; k < 7; ++k) { const int e = lane + 64 * k; if (e < 387) m = fmaxf(m, sc[i * 387 + e]); }
        m = wave_max(m);
        float l = 0.f;
#pragma unroll
        for (int k = 0; k < 7; ++k) { const int e = lane + 64 * k; if (e < 387) { const float p = fexp2(sc[i * 387 + e] - m); sc[i * 387 + e] = p; l += p; } }
        l = wave_sum(l);
        if (lane == 0) ls[i] = l;
    }
    __syncthreads();
    {
        const int d4 = tid & 15, slot = tid >> 4;
#pragma unroll 1
        for (int i = 0; i < 4; ++i) {
            f32x4 acc = {0.f, 0.f, 0.f, 0.f};
            f32x4 vv[13]; float pp[13];
#pragma unroll
            for (int k = 0; k < 13; ++k) {
                const int e0 = slot + 32 * k; const bool ok = e0 < 387; const int e = ok ? e0 : 0;
                const int g = e / 129, s = e - g * 129;
                const int dil = (g == 0) ? 1 : (g == 1) ? 4 : 16;
                const int idx = 2048 + i - dil * s;
                pp[k] = ok ? sc[i * 387 + e] : 0.f;
                vv[k] = (idx < 2048) ? *(const f32x4*)(P.cache_v + (((size_t)b * 2048 + idx) * 8 + h) * 64 + d4 * 4)
                                     : *(const LAS f32x4*)(vn + (idx - 2048) * 64 + d4 * 4);
            }
#pragma unroll
            for (int k = 0; k < 13; ++k) acc = acc + vv[k] * pp[k];
            *(LAS f32x4*)(red + (slot * 4 + i) * 64 + d4 * 4) = acc;
        }
    }
    __syncthreads();
    if (tid < 256) {
        const int i = tid >> 6, d = tid & 63;
        float s = 0.f;
#pragma unroll
        for (int sl = 0; sl < 32; ++sl) s += red[(sl * 4 + i) * 64 + d];
        const size_t R = (size_t)M_PROMPT + b * 4 + i;
        const float gate = bf2f(HB[R * HP + C_SG + h * 64 + d]);
        MIX[R * DMIX + 512 + h * 64 + d] = (bf16_t)(pk_bf16(s / ls[i] * gate, 0.f) & 0xffffu);
    }
}
__device__ __forceinline__ void mem_sample_unit(const Params& P, LAS unsigned char* lds, int tid, int wave, int b, int h) {
    const bf16_t* HB = (const bf16_t*)(P.ws + WS_HB);
    bf16_t* MIX = (bf16_t*)(P.ws + WS_MIX);
    LAS float* qm = (LAS float*)lds; LAS float* part = (LAS float*)(lds + 2048); LAS float* pr = (LAS float*)(lds + 10240);
    LAS float* ls = (LAS float*)(lds + 14336); LAS float* red = (LAS float*)(lds + 16384);
    const int lane = tid & 63;
    __syncthreads();
    { const int i = tid >> 7, d = tid & 127; qm[i * 128 + d] = bf2f(HB[((size_t)M_PROMPT + b * 4 + i) * HP + C_MQ + h * 128 + d]); }
    __syncthreads();
    {
        const int m = tid & 255, half = tid >> 8;
        const f32x4* kc = (const f32x4*)(P.cmem_k + (((size_t)b * NMEM + m) * 4 + h) * 128 + half * 64);
        f32x4 kv[16];
#pragma unroll
        for (int c = 0; c < 16; ++c) kv[c] = kc[c];
#pragma unroll
        for (int i = 0; i < 4; ++i) {
            float a = 0.f;
#pragma unroll
            for (int c = 0; c < 16; ++c) a += dot4(kv[c], *(const LAS f32x4*)(qm + i * 128 + half * 64 + 4 * c));
            part[(half * 4 + i) * 256 + m] = a;
        }
    }
    __syncthreads();
    if (wave < 4) {
        const int i = wave;
        float s[4]; float m = -INFINITY;
#pragma unroll
        for (int k = 0; k < 4; ++k) { s[k] = part[i * 256 + lane + 64 * k] + part[(4 + i) * 256 + lane + 64 * k]; m = fmaxf(m, s[k]); }
        m = wave_max(m);
        float l = 0.f;
#pragma unroll
        for (int k = 0; k < 4; ++k) { const float p = fexp2(s[k] - m); pr[i * 256 + lane + 64 * k] = p; l += p; }
        l = wave_sum(l);
        if (lane == 0) ls[i] = l;
    }
    __syncthreads();
    {
        const int d4 = tid & 31, slot = tid >> 5;
        f32x4 acc[4];
#pragma unroll
        for (int i = 0; i < 4; ++i) acc[i] = (f32x4){0.f, 0.f, 0.f, 0.f};
        f32x4 vv[16];
#pragma unroll
        for (int k = 0; k < 16; ++k) vv[k] = *(const f32x4*)(P.cmem_v + (((size_t)b * NMEM + slot + 16 * k) * 4 + h) * 128 + d4 * 4);
#pragma unroll
        for (int k = 0; k < 16; ++k)
#pragma unroll
            for (int i = 0; i < 4; ++i) acc[i] = acc[i] + vv[k] * pr[i * 256 + slot + 16 * k];
#pragma unroll
        for (int i = 0; i < 4; ++i) *(LAS f32x4*)(red + (slot * 4 + i) * 128 + d4 * 4) = acc[i];
    }
    __syncthreads();
    {
        const int i = tid >> 7, d = tid & 127;
        float s = 0.f;
#pragma unroll
        for (int sl = 0; sl < 16; ++sl) s += red[(sl * 4 + i) * 128 + d];
        const size_t R = (size_t)M_PROMPT + b * 4 + i;
        const float gate = bf2f(HB[R * HP + C_MG + h * 128 + d]);
        MIX[R * DMIX + 1024 + h * 128 + d] = (bf16_t)(pk_bf16(s / ls[i] * gate, 0.f) & 0xffffu);
    }
}

typedef float f32x16 __attribute__((ext_vector_type(16)));
typedef short s16x4 __attribute__((ext_vector_type(4)));
constexpr int SWA_ST_O = 0, SWA_ST_M = 65536, SWA_ST_L = 65536 + 2048, SWA_WV = 69632, SWA_WV_STRIDE = 10240 + 256;
__device__ __forceinline__ s16x4 tr16(LAS unsigned char* p) { return __builtin_bit_cast(s16x4, __builtin_amdgcn_ds_read_tr16_b64_v4i16((LAS s16x4*)p)); }
__device__ __forceinline__ f32x16 mfma32(bf16x8 a, bf16x8 b, f32x16 c) { return __builtin_amdgcn_mfma_f32_32x32x16_bf16(a, b, c, 0, 0, 0); }
#define VM_WAIT() asm volatile("s_waitcnt vmcnt(0)" ::: "memory")

__device__ __forceinline__ void swa_task(const Params& P, LAS unsigned char* lds, int wave, int lane, int b, int h, int dil, int r, int i0, int pat, int T0) {
    const bf16_t* HB = (const bf16_t*)(P.ws + WS_HB);
    const int a = lane & 31, hi = lane >> 5;
    LAS unsigned char* vreg = lds + SWA_WV + wave * SWA_WV_STRIDE;
    LAS float* msc = (LAS float*)(vreg + 10240);
    LAS float* lsc = msc + 32;
    const size_t rowbase = (size_t)b * SEQ + r;
    const int jmin = i0 >= 128 ? 0 : ((128 - i0) >> 5);
    const int vrow = ((lane >> 5) << 3) + ((lane >> 2) & 7), vch = lane & 3;
    const int trb = (4 * hi + ((lane & 15) >> 2)) * 64 + ((lane >> 4) & 1) * 32 + (lane & 3) * 8;

#define SWA_DMA_V(db) do { _Pragma("unroll") for (int j = 0; j < 5; ++j) if (j >= jmin) { _Pragma("unroll") for (int it2 = 0; it2 < 2; ++it2) { \
        const int ik = i0 - 128 + 32 * j + 16 * it2 + vrow; \
        __builtin_amdgcn_global_load_lds((const unsigned*)(HB + (rowbase + (size_t)dil * ik) * HP + C_SV + h * 64 + 32 * (db) + 8 * vch), \
                                         (LAS unsigned*)(vreg + j * 2048 + it2 * 1024), 16, 0, 0); } } } while (0)

    LDS_WAIT();
    SWA_DMA_V(0);
    bf16x8 qf[4];
    { const bf16_t* qp = HB + (rowbase + (size_t)dil * (i0 + a)) * HP + C_SQ + h * 64 + 8 * hi;
#pragma unroll
      for (int kk = 0; kk < 4; ++kk) qf[kk] = *(const bf16x8*)(qp + 16 * kk); }
    f32x16 S[5];
#pragma unroll
    for (int j = 0; j < 5; ++j) {
        {
            const int ik0 = i0 - 128 + 32 * j + a, ik = ik0 < 0 ? 0 : ik0;
            const bf16_t* kp = HB + (rowbase + (size_t)dil * ik) * HP + C_SK + h * 64 + 8 * hi;
            bf16x8 kf[4];
#pragma unroll
            for (int kk = 0; kk < 4; ++kk) kf[kk] = *(const bf16x8*)(kp + 16 * kk);
            f32x16 acc;
#pragma unroll
            for (int e = 0; e < 16; ++e) acc[e] = 0.f;
#pragma unroll
            for (int kk = 0; kk < 4; ++kk) acc = mfma32(kf[kk], qf[kk], acc);
            if (j == 0) {
#pragma unroll
                for (int e = 0; e < 16; ++e) { const int c = (e & 3) + 8 * (e >> 2) + 4 * hi; if (c < a) acc[e] = -INFINITY; }
            }
            if (j == 4) {
#pragma unroll
                for (int e = 0; e < 16; ++e) { const int c = (e & 3) + 8 * (e >> 2) + 4 * hi; if (c > a) acc[e] = -INFINITY; }
            }
            if (j < jmin) {
#pragma unroll
                for (int e = 0; e < 16; ++e) acc[e] = -INFINITY;
            }
            S[j] = acc;
        }
    }
    float mx = -INFINITY;
#pragma unroll
    for (int j = 0; j < 5; ++j)
#pragma unroll
        for (int e = 0; e < 16; ++e) mx = fmaxf(mx, S[j][e]);
    mx = fmaxf(mx, __shfl_xor(mx, 32));
    float lsum = 0.f;
    unsigned pa[5][2][4];
#pragma unroll
    for (int j = 0; j < 5; ++j) {
#pragma unroll
        for (int e = 0; e < 16; ++e) { const float p = fexp2(S[j][e] - mx); S[j][e] = p; lsum += p; }
#pragma unroll
        for (int s = 0; s < 2; ++s)
#pragma unroll
            for (int w = 0; w < 4; ++w) pa[j][s][w] = pk_bf16(S[j][8 * s + 2 * w], S[j][8 * s + 2 * w + 1]);
    }
    lsum += __shfl_xor(lsum, 32);
    if (hi == 0) { msc[a] = mx; lsc[a] = lsum; }
    LDS_WAIT();
    float fo[16], go[16], rl[16];
    LAS float* stM = (LAS float*)(lds + SWA_ST_M);
    LAS float* stL = (LAS float*)(lds + SWA_ST_L);
#pragma unroll
    for (int g4 = 0; g4 < 4; ++g4) {
        const f32x4 m4 = *(const LAS f32x4*)(msc + 8 * g4 + 4 * hi), l4 = *(const LAS f32x4*)(lsc + 8 * g4 + 4 * hi);
#pragma unroll
        for (int e = 0; e < 4; ++e) {
            const int c = 8 * g4 + 4 * hi + e;
            const int tok = r + dil * (i0 + c) - T0;
            if (pat == 0) { fo[4 * g4 + e] = 0.f; go[4 * g4 + e] = 1.f; rl[4 * g4 + e] = 1.f; if (a == 0) { stM[tok] = m4[e]; stL[tok] = l4[e]; } }
            else {
                const float Mo = stM[tok], Lo = stL[tok];
                const float Mn = fmaxf(Mo, m4[e]);
                const float f = fexp2(Mo - Mn), g = fexp2(m4[e] - Mn);
                const float Ln = Lo * f + l4[e] * g;
                fo[4 * g4 + e] = f; go[4 * g4 + e] = g; rl[4 * g4 + e] = 1.0f / Ln;
                if (pat == 1 && a == 0) { stM[tok] = Mn; stL[tok] = Ln; }
            }
        }
    }
#pragma unroll
    for (int db = 0; db < 2; ++db) {
        VM_WAIT();
        f32x16 O;
#pragma unroll
        for (int e = 0; e < 16; ++e) O[e] = 0.f;
#pragma unroll
        for (int j = 0; j < 5; ++j) if (j >= jmin) {
#pragma unroll
            for (int s = 0; s < 2; ++s) {
                const s16x4 lo = tr16(vreg + j * 2048 + (2 * s) * 512 + trb), hh = tr16(vreg + j * 2048 + (2 * s + 1) * 512 + trb);
                const bf16x8 vb = {lo[0], lo[1], lo[2], lo[3], hh[0], hh[1], hh[2], hh[3]};
                const bf16x8 pf = __builtin_bit_cast(bf16x8, (u32x4){pa[j][s][0], pa[j][s][1], pa[j][s][2], pa[j][s][3]});
                O = mfma32(pf, vb, O);
            }
        }
        if (db == 0) { LDS_WAIT(); SWA_DMA_V(1); }
        LAS bf16_t* stO = (LAS bf16_t*)(lds + SWA_ST_O);
        const int d = 32 * db + a;
#pragma unroll
        for (int e = 0; e < 16; ++e) {
            const int c = (e & 3) + 8 * (e >> 2) + 4 * hi;
            const int tok = r + dil * (i0 + c) - T0;
            if (pat == 0) stO[tok * 64 + d] = (bf16_t)(pk_bf16(O[e], 0.f) & 0xffffu);
            else {
                const float on = bf2f(stO[tok * 64 + d]) * fo[e] + O[e] * go[e];
                stO[tok * 64 + d] = (bf16_t)(pk_bf16(pat == 1 ? on : on * rl[e], 0.f) & 0xffffu);
            }
        }
    }
#undef SWA_DMA_V
}
__device__ __forceinline__ void swa_unit(const Params& P, LAS unsigned char* lds, int wave, int lane, int b, int h, int chunk) {
    const int T0 = chunk * 512;
#pragma unroll 1
    for (int pat = 0; pat < 3; ++pat) {
#pragma unroll 1
        for (int tt = 0; tt < 2; ++tt) {
            const int k = wave + 8 * tt;
            int dil, r, i0;
            if (pat == 0) { dil = 1; r = 0; i0 = T0 + 32 * k; }
            else if (pat == 1) { dil = 4; r = k & 3; i0 = (T0 >> 2) + 32 * (k >> 2); }
            else { dil = 16; r = k; i0 = T0 >> 4; }
            swa_task(P, lds, wave, lane, b, h, dil, r, i0, pat, T0);
        }
        __syncthreads();
    }
    {
        const bf16_t* HB = (const bf16_t*)(P.ws + WS_HB);
        bf16_t* MIX = (bf16_t*)(P.ws + WS_MIX);
        const int tid = wave * 64 + lane, ch = tid & 7;
#pragma unroll
        for (int it = 0; it < 8; ++it) {
            const int tok = (tid >> 3) + 64 * it;
            const size_t row = (size_t)b * SEQ + T0 + tok;
            const u32x4 o = *(const LAS u32x4*)(lds + SWA_ST_O + tok * 128 + ch * 16);
            const u32x4 g = *(const u32x4*)(HB + row * HP + C_SG + h * 64 + ch * 8);
            u32x4 w;
            w.x = pk_bf16(bf_lo(o.x) * bf_lo(g.x), bf_hi(o.x) * bf_hi(g.x)); w.y = pk_bf16(bf_lo(o.y) * bf_lo(g.y), bf_hi(o.y) * bf_hi(g.y));
            w.z = pk_bf16(bf_lo(o.z) * bf_lo(g.z), bf_hi(o.z) * bf_hi(g.z)); w.w = pk_bf16(bf_lo(o.w) * bf_lo(g.w), bf_hi(o.w) * bf_hi(g.w));
            *(u32x4*)(MIX + row * DMIX + 512 + h * 64 + ch * 8) = w;
        }
    }
    __syncthreads();
}

constexpr int MEM_K = 0, MEM_V = 65536, MEM_SC = 131072;
__device__ __forceinline__ void mem_unit(const Params& P, LAS unsigned char* lds, int wave, int lane, int b, int h, int qb) {
    const bf16_t* HB = (const bf16_t*)(P.ws + WS_HB);
    const bf16_t* MKV = (const bf16_t*)(P.ws + WS_MKV);
    bf16_t* MIX = (bf16_t*)(P.ws + WS_MIX);
    const int a = lane & 31, hi = lane >> 5;
    __syncthreads();
#pragma unroll
    for (int i = 0; i < 8; ++i) {
        const int pc = wave * 8 + i;
        { const int key = 4 * pc + (lane >> 4), cp = lane & 15;
          __builtin_amdgcn_global_load_lds((const unsigned*)(MKV + ((size_t)b * NMEM + key) * 1024 + h * 128 + 8 * (cp ^ (key & 15))),
                                           (LAS unsigned*)(lds + MEM_K + pc * 1024), 16, 0, 0); }
        { const int key = 8 * (pc >> 1) + ((lane & 31) >> 2), d = 32 * (2 * (pc & 1) + (lane >> 5)) + 8 * (lane & 3);
          __builtin_amdgcn_global_load_lds((const unsigned*)(MKV + ((size_t)b * NMEM + key) * 1024 + 512 + h * 128 + d),
                                           (LAS unsigned*)(lds + MEM_V + pc * 1024), 16, 0, 0); }
    }
    const size_t Rq = (size_t)b * SEQ + qb * 256 + wave * 32;
    VM_WAIT();
    __syncthreads();
    LAS float* fsc = (LAS float*)(lds + MEM_SC + wave * 256);
    const int trb = (4 * hi + ((lane & 15) >> 2)) * 64 + ((lane >> 4) & 1) * 32 + (lane & 3) * 8;
    f32x16 O[4];
#pragma unroll
    for (int db = 0; db < 4; ++db)
#pragma unroll
        for (int e = 0; e < 16; ++e) O[db][e] = 0.f;
    float M = -INFINITY, L = 0.f;
#pragma unroll 1
    for (int ch = 0; ch < 2; ++ch) {
        bf16x8 qf[8];
        { const bf16_t* qp = HB + (Rq + a) * HP + C_MQ + h * 128 + 8 * hi;
#pragma unroll
          for (int kk = 0; kk < 8; ++kk) qf[kk] = *(const bf16x8*)(qp + 16 * kk); }
        f32x16 S[4];
#pragma unroll
        for (int jt = 0; jt < 4; ++jt) {
            const int key = 32 * (4 * ch + jt) + a;
            f32x16 acc;
#pragma unroll
            for (int e = 0; e < 16; ++e) acc[e] = 0.f;
#pragma unroll
            for (int kk = 0; kk < 8; ++kk) {
                const bf16x8 kf = *(const LAS bf16x8*)(lds + MEM_K + key * 256 + (((2 * kk + hi) ^ (key & 15)) << 4));
                acc = mfma32(kf, qf[kk], acc);
            }
            S[jt] = acc;
        }
        float mc = -INFINITY;
#pragma unroll
        for (int jt = 0; jt < 4; ++jt)
#pragma unroll
            for (int e = 0; e < 16; ++e) mc = fmaxf(mc, S[jt][e]);
        mc = fmaxf(mc, __shfl_xor(mc, 32));
        const float Mn = fmaxf(M, mc);
        const float f = fexp2(M - Mn);
        float ls = 0.f;
        unsigned pa[4][2][4];
#pragma unroll
        for (int jt = 0; jt < 4; ++jt) {
#pragma unroll
            for (int e = 0; e < 16; ++e) { const float p = fexp2(S[jt][e] - Mn); S[jt][e] = p; ls += p; }
#pragma unroll
            for (int s = 0; s < 2; ++s)
#pragma unroll
                for (int w = 0; w < 4; ++w) pa[jt][s][w] = pk_bf16(S[jt][8 * s + 2 * w], S[jt][8 * s + 2 * w + 1]);
        }
        ls += __shfl_xor(ls, 32);
        L = L * f + ls; M = Mn;
        if (ch == 1) {
            LDS_WAIT();
            if (hi == 0) fsc[a] = f;
            LDS_WAIT();
#pragma unroll
            for (int g4 = 0; g4 < 4; ++g4) {
                const f32x4 f4 = *(const LAS f32x4*)(fsc + 8 * g4 + 4 * hi);
#pragma unroll
                for (int db = 0; db < 4; ++db)
#pragma unroll
                    for (int e = 0; e < 4; ++e) O[db][4 * g4 + e] *= f4[e];
            }
        }
#pragma unroll
        for (int jt = 0; jt < 4; ++jt)
#pragma unroll
            for (int s = 0; s < 2; ++s) {
                const bf16x8 pf = __builtin_bit_cast(bf16x8, (u32x4){pa[jt][s][0], pa[jt][s][1], pa[jt][s][2], pa[jt][s][3]});
                const int st0 = (4 * (4 * ch + jt) + 2 * s) * 4;
#pragma unroll
                for (int db = 0; db < 4; ++db) {
                    const s16x4 lo = tr16(lds + MEM_V + (st0 + db) * 512 + trb), hh = tr16(lds + MEM_V + (st0 + 4 + db) * 512 + trb);
                    const bf16x8 vb = {lo[0], lo[1], lo[2], lo[3], hh[0], hh[1], hh[2], hh[3]};
                    O[db] = mfma32(pf, vb, O[db]);
                }
            }
    }
    LDS_WAIT();
    if (hi == 0) fsc[32 + a] = 1.0f / L;
    LDS_WAIT();
    const bf16_t* gp = HB + (Rq + 4 * hi) * HP + C_MG + h * 128 + a;
    bf16_t* mp = MIX + (Rq + 4 * hi) * DMIX + 1024 + h * 128 + a;
#pragma unroll
    for (int g4 = 0; g4 < 4; ++g4) {
        const f32x4 r4 = *(const LAS f32x4*)(fsc + 32 + 8 * g4 + 4 * hi);
#pragma unroll
        for (int e = 0; e < 4; ++e) {
#pragma unroll
            for (int db = 0; db < 4; ++db) {
                const float gate = bf2f(gp[(8 * g4 + e) * HP + 32 * db]);
                mp[(8 * g4 + e) * DMIX + 32 * db] = (bf16_t)(pk_bf16(O[db][4 * g4 + e] * r4[e] * gate, 0.f) & 0xffffu);
            }
        }
        asm volatile("" ::: "memory");
    }
}

constexpr int RT_Q = 0, RT_K = 16384, RT_KD = 32768, RT_V = 49152, RT_R = 81920, RT_O = 98304;
__device__ __forceinline__ void ret_unit(const Params& P, LAS unsigned char* lds, int wave, int lane, int tid, int b, int h) {
    const bf16_t* HB = (const bf16_t*)(P.ws + WS_HB);
    bf16_t* MIX = (bf16_t*)(P.ws + WS_MIX);
    const float gamma = 1.0f - __builtin_amdgcn_exp2f((float)(-5 - h));
    const float lg2c = __builtin_log2f(gamma);
    const int qg = wave & 3, dh = wave >> 2;
    const int dkt = wave & 1, dvt = wave >> 1;
    f32x16 Rt;
#pragma unroll
    for (int e = 0; e < 16; ++e) Rt[e] = 0.f;
    u32x4 pq[2], pk[2], pv[4];
    const size_t rb = (size_t)b * SEQ;
#define RET_ISSUE(n) do { const size_t base_ = rb + 128 * (n); \
        _Pragma("unroll") for (int i = 0; i < 2; ++i) { const int idx = tid + 512 * i, row = idx >> 3, ch = idx & 7; \
            pq[i] = *(const u32x4*)(HB + (base_ + row) * HP + C_RQ + h * 64 + ch * 8); pk[i] = *(const u32x4*)(HB + (base_ + row) * HP + C_RK + h * 64 + ch * 8); } \
        _Pragma("unroll") for (int i = 0; i < 4; ++i) { const int idx = tid + 512 * i, row = idx >> 4, ch = idx & 15; \
            pv[i] = *(const u32x4*)(HB + (base_ + row) * HP + C_RV + h * 128 + ch * 8); } } while (0)
    RET_ISSUE(0);
#pragma unroll 1
    for (int n = 0; n < 16; ++n) {
        float lg2 = lg2c; asm volatile("" : "+v"(lg2));
        int lane_ = lane; asm volatile("" : "+v"(lane_));
        const int a = lane_ & 31, hi = lane_ >> 5, tq = (lane_ & 15) >> 2, tp = lane_ & 3, tg = (lane_ >> 4) & 1;
        __syncthreads();
#pragma unroll
        for (int i = 0; i < 2; ++i) {
            const int idx = tid + 512 * i, row = idx >> 3, ch = idx & 7;
            *(LAS u32x4*)(lds + RT_Q + row * 128 + ((ch ^ (row & 7)) << 4)) = pq[i];
            *(LAS u32x4*)(lds + RT_K + row * 128 + ((ch ^ (row & 7)) << 4)) = pk[i];
            const float fac = fexp2((float)(127 - row) * lg2);
            u32x4 kd;
            kd.x = pk_bf16(bf_lo(pk[i].x) * fac, bf_hi(pk[i].x) * fac); kd.y = pk_bf16(bf_lo(pk[i].y) * fac, bf_hi(pk[i].y) * fac);
            kd.z = pk_bf16(bf_lo(pk[i].z) * fac, bf_hi(pk[i].z) * fac); kd.w = pk_bf16(bf_lo(pk[i].w) * fac, bf_hi(pk[i].w) * fac);
            *(LAS u32x4*)(lds + RT_KD + ((row >> 3) * 2 + (ch >> 2)) * 512 + (row & 7) * 64 + (ch & 3) * 16) = kd;
        }
#pragma unroll
        for (int i = 0; i < 4; ++i) {
            const int idx = tid + 512 * i, row = idx >> 4, ch = idx & 15;
            *(LAS u32x4*)(lds + RT_V + ((row >> 3) * 4 + (ch >> 2)) * 512 + (row & 7) * 64 + (ch & 3) * 16) = pv[i];
        }
        __syncthreads();
        if (n + 1 < 16) RET_ISSUE(n + 1);
        f32x16 O[2];
        bf16x8 qfr[4];
#pragma unroll
        for (int kk = 0; kk < 4; ++kk) { const int row = 32 * qg + a; qfr[kk] = *(const LAS bf16x8*)(lds + RT_Q + row * 128 + (((2 * kk + hi) ^ (row & 7)) << 4)); }
        if (n > 0) {
#pragma unroll
            for (int dt = 0; dt < 2; ++dt) {
                f32x16 X;
#pragma unroll
                for (int e = 0; e < 16; ++e) X[e] = 0.f;
                const int dv = 32 * (2 * dh + dt) + a;
#pragma unroll
                for (int kk = 0; kk < 4; ++kk) {
                    const bf16x8 rf = *(const LAS bf16x8*)(lds + RT_R + dv * 128 + (((2 * kk + hi) ^ (dv & 7)) << 4));
                    X = mfma32(qfr[kk], rf, X);
                }
#pragma unroll
                for (int e = 0; e < 16; ++e) { const int c = (e & 3) + 8 * (e >> 2) + 4 * hi; O[dt][e] = X[e] * fexp2((float)(32 * qg + c + 1) * lg2); }
            }
        } else {
#pragma unroll
            for (int dt = 0; dt < 2; ++dt)
#pragma unroll
                for (int e = 0; e < 16; ++e) O[dt][e] = 0.f;
        }
#pragma unroll
        for (int j = 0; j < 4; ++j) if (j <= qg) {
            f32x16 S;
#pragma unroll
            for (int e = 0; e < 16; ++e) S[e] = 0.f;
#pragma unroll
            for (int kk = 0; kk < 4; ++kk) {
                const int row = 32 * j + a;
                const bf16x8 kf = *(const LAS bf16x8*)(lds + RT_K + row * 128 + (((2 * kk + hi) ^ (row & 7)) << 4));
                S = mfma32(kf, qfr[kk], S);
            }
            unsigned pa[2][4];
#pragma unroll
            for (int e = 0; e < 16; ++e) {
                const int c = (e & 3) + 8 * (e >> 2) + 4 * hi;
                const int diff = 32 * (qg - j) + a - c;
                S[e] = diff >= 0 ? S[e] * fexp2((float)diff * lg2) : 0.f;
            }
#pragma unroll
            for (int s = 0; s < 2; ++s)
#pragma unroll
                for (int w = 0; w < 4; ++w) pa[s][w] = pk_bf16(S[8 * s + 2 * w], S[8 * s + 2 * w + 1]);
#pragma unroll
            for (int s = 0; s < 2; ++s) {
                const bf16x8 pf = __builtin_bit_cast(bf16x8, (u32x4){pa[s][0], pa[s][1], pa[s][2], pa[s][3]});
#pragma unroll
                for (int dt = 0; dt < 2; ++dt) {
                    LAS unsigned char* vb_ = lds + RT_V + ((4 * j + 2 * s) * 4 + (2 * dh + dt)) * 512 + (4 * hi + tq) * 64 + tg * 32 + tp * 8;
                    const s16x4 lo = tr16(vb_), hh = tr16(vb_ + 4 * 512);
                    const bf16x8 vb = {lo[0], lo[1], lo[2], lo[3], hh[0], hh[1], hh[2], hh[3]};
                    O[dt] = mfma32(pf, vb, O[dt]);
                }
            }
        }
        {
            LAS bf16_t* Ob = (LAS bf16_t*)(lds + RT_O);
#pragma unroll
            for (int dt = 0; dt < 2; ++dt)
#pragma unroll
                for (int e = 0; e < 16; ++e) { const int c = (e & 3) + 8 * (e >> 2) + 4 * hi; Ob[(32 * qg + c) * 128 + 32 * (2 * dh + dt) + a] = (bf16_t)(pk_bf16(O[dt][e], 0.f) & 0xffffu); }
        }
        __syncthreads();
        {
            const float g128 = fexp2(128.0f * lg2);
#pragma unroll
            for (int e = 0; e < 16; ++e) Rt[e] *= g128;
#pragma unroll
            for (int s = 0; s < 8; ++s) {
                LAS unsigned char* ka = lds + RT_KD + ((2 * s + hi) * 2 + dkt) * 512 + tq * 64 + tg * 32 + tp * 8;
                LAS unsigned char* va = lds + RT_V + ((2 * s + hi) * 4 + dvt) * 512 + tq * 64 + tg * 32 + tp * 8;
                const s16x4 k0 = tr16(ka), k1 = tr16(ka + 256), v0 = tr16(va), v1 = tr16(va + 256);
                const bf16x8 af = {k0[0], k0[1], k0[2], k0[3], k1[0], k1[1], k1[2], k1[3]};
                const bf16x8 bfv = {v0[0], v0[1], v0[2], v0[3], v1[0], v1[1], v1[2], v1[3]};
                Rt = mfma32(af, bfv, Rt);
            }
            const int dv = 32 * dvt + a;
#pragma unroll
            for (int g4 = 0; g4 < 4; ++g4) {
                const int dk0 = 32 * dkt + 8 * g4 + 4 * hi;
                u32x2 w; w.x = pk_bf16(Rt[4 * g4], Rt[4 * g4 + 1]); w.y = pk_bf16(Rt[4 * g4 + 2], Rt[4 * g4 + 3]);
                *(LAS u32x2*)(lds + RT_R + dv * 128 + (((dk0 >> 3) ^ (dv & 7)) << 4) + (dk0 & 7) * 2) = w;
            }
        }
        {
            const int tok = tid >> 2, part = tid & 3;
            const LAS u32x4* op = (const LAS u32x4*)(lds + RT_O + tok * 256 + part * 64);
            float o[32]; float sm = 0.f;
#pragma unroll
            for (int c4 = 0; c4 < 4; ++c4) {
                const u32x4 w = op[c4];
                o[8 * c4 + 0] = bf_lo(w.x); o[8 * c4 + 1] = bf_hi(w.x); o[8 * c4 + 2] = bf_lo(w.y); o[8 * c4 + 3] = bf_hi(w.y);
                o[8 * c4 + 4] = bf_lo(w.z); o[8 * c4 + 5] = bf_hi(w.z); o[8 * c4 + 6] = bf_lo(w.w); o[8 * c4 + 7] = bf_hi(w.w);
            }
#pragma unroll
            for (int e = 0; e < 32; ++e) sm += o[e];
            sm += __shfl_xor(sm, 1); sm += __shfl_xor(sm, 2);
            const float mean = sm * (1.0f / 128.0f);
            float qq = 0.f;
#pragma unroll
            for (int e = 0; e < 32; ++e) { o[e] -= mean; qq += o[e] * o[e]; }
            qq += __shfl_xor(qq, 1); qq += __shfl_xor(qq, 2);
            const float rstd = 1.0f / sqrtf(qq * (1.0f / 128.0f) + 1e-5f);
            const size_t row = rb + 128 * n + tok;
            const u32x4* gp = (const u32x4*)(HB + row * HP + C_RG + h * 128 + part * 32);
            u32x4* mp = (u32x4*)(MIX + row * DMIX + h * 128 + part * 32);
#pragma unroll
            for (int c4 = 0; c4 < 4; ++c4) {
                const u32x4 g = gp[c4]; u32x4 w;
                w.x = pk_bf16(o[8 * c4 + 0] * rstd * bf_lo(g.x), o[8 * c4 + 1] * rstd * bf_hi(g.x)); w.y = pk_bf16(o[8 * c4 + 2] * rstd * bf_lo(g.y), o[8 * c4 + 3] * rstd * bf_hi(g.y));
                w.z = pk_bf16(o[8 * c4 + 4] * rstd * bf_lo(g.z), o[8 * c4 + 5] * rstd * bf_hi(g.z)); w.w = pk_bf16(o[8 * c4 + 6] * rstd * bf_lo(g.w), o[8 * c4 + 7] * rstd * bf_hi(g.w));
                mp[c4] = w;
            }
        }
    }
#undef RET_ISSUE
    {
        float* outp = P.out + O_RP;
        const int a = lane & 31, hi = lane >> 5;
#pragma unroll
        for (int e = 0; e < 16; ++e) {
            const int pdk = 32 * dkt + (e & 3) + 8 * (e >> 2) + 4 * hi;
            outp[((size_t)((b * 4 + h) * 64 + dmap(pdk))) * 128 + 32 * dvt + a] = Rt[e];
        }
    }
    __syncthreads();
}

#define XB_TMO      128
#define XB_XCNT(j)  (256  + 64 * (j))
#define XB_XSUB(j)  (1280 + 64 * (j))
#define XB_XGEN(j)  (2304 + 64 * (j))
#define XB_TOP      3328
#define XB_TOPGEN   3392
#define XCD_BAR_WORDS 3456
#define XB_SPIN_CAP (1u << 18)

__device__ __forceinline__ unsigned xb_ld(unsigned* p)              { return __hip_atomic_load(p, __ATOMIC_RELAXED, __HIP_MEMORY_SCOPE_AGENT); }
__device__ __forceinline__ unsigned xb_add(unsigned* p, unsigned v) { return __hip_atomic_fetch_add(p, v, __ATOMIC_RELAXED, __HIP_MEMORY_SCOPE_AGENT); }
__device__ __forceinline__ unsigned xb_xcc_id() { return (unsigned)__builtin_amdgcn_s_getreg((3 << 11) | 20) & 0xFu; }
#define XB_SPIN(cond, bar) do { unsigned _sp = 0; while (cond) { __builtin_amdgcn_s_sleep(1); \
    if ((++_sp & 255u) == 0u) { if (xb_ld(&(bar)[XB_TMO])) break; if (_sp > XB_SPIN_CAP) { atomicAdd(&(bar)[XB_TMO], 1u); break; } } } } while (0)

struct XcdBarrier {
    unsigned* bar; unsigned x;
    volatile LAS unsigned* st;
};

__device__ __forceinline__ XcdBarrier xcd_barrier_post(unsigned* bar, volatile LAS unsigned* st) {
    XcdBarrier b; b.bar = bar; b.x = xb_xcc_id(); b.st = st;
    if (threadIdx.x == 0) (void)xb_add(&bar[XB_XCNT(b.x)], 1u);
    return b;
}
__device__ __forceinline__ void xcd_barrier_complete(unsigned* bar, unsigned x, unsigned& nloc, unsigned& nx) {
    const unsigned G = gridDim.x * gridDim.y * gridDim.z;
    unsigned sum, cnt, mine, sp = 0u;
    for (;;) {
        sum = 0u; cnt = 0u; mine = 0u;
#pragma unroll
        for (unsigned j = 0; j < 16; ++j) { const unsigned c = xb_ld(&bar[XB_XCNT(j)]); sum += c; cnt += (c > 0u) ? 1u : 0u; mine = (j == x) ? c : mine; }
        if (sum == G) break;
        __builtin_amdgcn_s_sleep(1);
        if ((++sp & 255u) == 0u) { if (xb_ld(&bar[XB_TMO])) break; if (sp > XB_SPIN_CAP) { atomicAdd(&bar[XB_TMO], 1u); break; } }
    }
    nloc = mine > 0u ? mine : 1u; nx = cnt > 0u ? cnt : 1u;
}

__device__ __forceinline__ void xcd_barrier(const XcdBarrier& b) {
    asm volatile("s_waitcnt vmcnt(0)" ::: "memory");
    __syncthreads();
    if (threadIdx.x == 0) {
        unsigned* bar = b.bar;
        __builtin_amdgcn_s_waitcnt(0);
        unsigned nloc = b.st[0], nx = b.st[1];
        if (nloc == 0u) { xcd_barrier_complete(bar, b.x, nloc, nx); b.st[0] = nloc; b.st[1] = nx; }
        const unsigned old = xb_add(&bar[XB_XSUB(b.x)], 1u);
        const unsigned gen = old / nloc;
        if (old + 1u == (gen + 1u) * nloc) {
            __builtin_amdgcn_fence(__ATOMIC_RELEASE, "agent");
            asm volatile("s_waitcnt vmcnt(0)" ::: "memory");
            const unsigned og = xb_add(&bar[XB_TOP], 1u);
            const unsigned tg = og / nx;
            if (og + 1u == (tg + 1u) * nx) xb_add(&bar[XB_TOPGEN], 1u);
            else XB_SPIN(xb_ld(&bar[XB_TOPGEN]) == tg, bar);
            __builtin_amdgcn_fence(__ATOMIC_ACQUIRE, "agent");
            xb_add(&bar[XB_XGEN(b.x)], 1u);
            asm volatile("s_waitcnt vmcnt(0)" ::: "memory");
        } else {
            XB_SPIN(xb_ld(&bar[XB_XGEN(b.x)]) == gen, bar);
            __builtin_amdgcn_fence(__ATOMIC_ACQUIRE, "agent");
            asm volatile("s_waitcnt vmcnt(0)" ::: "memory");
        }
    }
    __syncthreads();
}

struct P1Order {
    int G, c;
    __device__ __forceinline__ bool next(int i, pg8::Unit& u) const {
        const int L = i * G + c;
        if (L >= 1202) return false;
        if (L < 1170) {
            constexpr int nM = 65, nN = 18, nwg = 1170, q = nwg / 8, r = nwg % 8, WGM = 8;
            const int xcd = L % 8, off = L / 8;
            const int wgid = (xcd < r ? xcd * (q + 1) : r * (q + 1) + (xcd - r) * q) + off;
            const int nig = WGM * nN, gid = wgid / nig, fm = gid * WGM, gsz = (nM - fm) < WGM ? (nM - fm) : WGM;
            u.pm = fm + ((wgid % nig) % gsz); u.pn = (wgid % nig) / gsz;
        } else { const int v = L - 1170; u.pm = 65 + (v >> 2); u.pn = 18 + (v & 3); }
        return true;
    }
    __device__ __forceinline__ void a_ready(const pg8::Unit&) const {}
    __device__ __forceinline__ void done(const pg8::Unit&) const {}
};
struct P1Epi {
    static constexpr bool PERM = false, AFTER_DRAIN = false;
    Params P;
    __device__ __forceinline__ void operator()(const f32x4 (&acc)[2][2][4][2], const pg8::Unit& u, int wr, int wc, int fr, int fq) const {
        if (u.pm < 65) epi_inproj(acc, u.pm, u.pn, P, wr, wc, fr, fq);
        else epi_memkv(acc, u.pm - 65, u.pn - 18, P, wr, wc, fr, fq);
    }
};
struct P3Order {
    int G, c;
    __device__ __forceinline__ bool next(int i, pg8::Unit& u) const { const int L = i * G + c; if (L >= 260) return false; u.pm = L >> 2; u.pn = L & 3; return true; }
    __device__ __forceinline__ void a_ready(const pg8::Unit&) const {}
    __device__ __forceinline__ void done(const pg8::Unit&) const {}
};
struct P3Epi {
    static constexpr bool PERM = false, AFTER_DRAIN = false;
    Params P;
    __device__ __forceinline__ void operator()(const f32x4 (&acc)[2][2][4][2], const pg8::Unit& u, int wr, int wc, int fr, int fq) const { epi_outproj(acc, u.pm, u.pn, P, wr, wc, fr, fq); }
};

constexpr int PRM_OFF = LDS_BYTES - 16 - 128;
__device__ __forceinline__ const void* ld_ptr(LAS unsigned char* lds, int i) {
    volatile LAS unsigned* w = (volatile LAS unsigned*)(lds + PRM_OFF);
    const unsigned lo = (unsigned)__builtin_amdgcn_readfirstlane((int)w[2 * i]), hi = (unsigned)__builtin_amdgcn_readfirstlane((int)w[2 * i + 1]);
    return (const void*)(((unsigned long long)hi << 32) | lo);
}
__device__ __forceinline__ Params load_params(LAS unsigned char* lds) {
    Params P;
    P.x_prompt = (const float*)ld_ptr(lds, 0); P.x_sample = (const float*)ld_ptr(lds, 1); P.state_ret = (const float*)ld_ptr(lds, 2);
    P.cache_k = (const float*)ld_ptr(lds, 3); P.cache_v = (const float*)ld_ptr(lds, 4); P.cmem_k = (const float*)ld_ptr(lds, 5);
    P.cmem_v = (const float*)ld_ptr(lds, 6); P.mem_prompt = (const float*)ld_ptr(lds, 7); P.w_in = (const float*)ld_ptr(lds, 8);
    P.w_mkv = (const float*)ld_ptr(lds, 9); P.w_out = (const float*)ld_ptr(lds, 10); P.ln_g = (const float*)ld_ptr(lds, 11);
    P.ln_b = (const float*)ld_ptr(lds, 12); P.out = (float*)ld_ptr(lds, 13); P.ws = (unsigned char*)ld_ptr(lds, 14);
    return P;
}

#ifndef PROBE
#define PROBE 0
#endif
__global__ void __launch_bounds__(512, 2) fwd_kernel(Params Pk) {
    extern __shared__ __attribute__((aligned(16))) unsigned char lds_raw[];
    LAS unsigned char* lds = (LAS unsigned char*)lds_raw;
    const int tid = threadIdx.x, lane = tid & 63, wave = __builtin_amdgcn_readfirstlane(tid >> 6);
    const int wr = wave >> 2, wc = wave & 3, fr = lane & 15, fq = lane >> 4;
    const int G = gridDim.x;
    if (tid < 4) ((LAS unsigned*)(lds + LDS_BYTES - 16))[tid] = 0u;
    if (tid >= 64 && tid < 94) ((LAS unsigned*)(lds + PRM_OFF))[tid - 64] = ((const unsigned*)__builtin_amdgcn_kernarg_segment_ptr())[tid - 64];
    __syncthreads();
    const XcdBarrier bar = xcd_barrier_post((unsigned*)((unsigned char*)ld_ptr(lds, 14) + WS_CTL) + 4096, (volatile LAS unsigned*)(lds + LDS_BYTES - 16));

    for (int rep0 = 0; rep0 < (PROBE == 10 ? 2 : 1); ++rep0) { const Params P = load_params(lds); phase0(P, lds, tid, lane, wave); }
    xcd_barrier(bar);

    {
        const Params P = load_params(lds);
        const pg8::Gemm g{(const bf16_t*)(P.ws + WS_XB), (const bf16_t*)(P.ws + WS_WTIN), ROWS_ALL, DIN + 1024, DM};
        const P1Order S{G, (int)blockIdx.x};
        const P1Epi E{P};
        for (int rep = 0; rep < (PROBE == 1 ? 2 : 1); ++rep)
        pg8::gemm_phase<P1Epi, P1Order, true, true>(lds, g, S, E);
    }
    xcd_barrier(bar);

    {
        const Params P = load_params(lds);
        unsigned* ctl = (unsigned*)(P.ws + WS_CTL);
        {
        LAS unsigned* qw = (LAS unsigned*)(lds + LDS_BYTES - 160);
        for (;;) {
            __syncthreads();
            if (tid == 0) *qw = atomicAdd(ctl + 128, 1u);
            __syncthreads();
            const int u = (int)*qw;
            if (u >= 256 + 128 + 128 + 32 + 256 + 256) break;
            int tid_ = tid; asm volatile("" : "+v"(tid_));
            const int lane_ = tid_ & 63;
            if (u < 256) swa_sample_unit(P, lds, tid_, wave, u >> 3, u & 7);
            else if (u < 384) { const int v = u - 256; mem_sample_unit(P, lds, tid_, wave, v >> 2, v & 3); }
            else if (u < 512) { const int v = u - 384; ret_scan(P, lds, v >> 2, v & 3, M_PROMPT + (v >> 2) * 4, 4, P.state_ret, P.out + O_RS, tid_); }
            else if (u < 544) { const int v = u - 512; ret_unit(P, lds, wave, lane_, tid_, v >> 2, v & 3); }
            else if (u < 800) { const int v = u - 544; swa_unit(P, lds, wave, lane_, v >> 5, (v >> 2) & 7, v & 3); }
            else { const int v = u - 800; mem_unit(P, lds, wave, lane_, v >> 5, (v >> 3) & 3, v & 7); }
        }
        }
    }
    xcd_barrier(bar);

    {
        const Params P = load_params(lds);
        const pg8::Gemm g{(const bf16_t*)(P.ws + WS_MIX), (const bf16_t*)(P.ws + WS_WTOUT), ROWS_IN, DM, DMIX};
        const P3Order S{G, (int)blockIdx.x};
        const P3Epi E{P};
        for (int rep5 = 0; rep5 < (PROBE == 3 ? 2 : 1); ++rep5)
        pg8::gemm_phase<P3Epi, P3Order, true, true>(lds, g, S, E);
    }
    xcd_barrier(bar);

    {
        const Params P = load_params(lds);
        const int gw = blockIdx.x * 8 + wave, NGW = G * 8;
        for (int r = gw; r < M_PROMPT + M_SAMPLE; r += NGW) {
            float* zr = r < M_PROMPT ? P.out + O_YP + (size_t)r * DM : P.out + O_YS + (size_t)(r - M_PROMPT) * DM;
            f32x4 v[4]; float s = 0.f;
#pragma unroll
            for (int j = 0; j < 4; ++j) { v[j] = ((const f32x4*)zr)[lane + 64 * j]; s += (v[j][0] + v[j][1]) + (v[j][2] + v[j][3]); }
            const float mean = wave_sum(s) * (1.0f / DM);
            float q = 0.f;
#pragma unroll
            for (int j = 0; j < 4; ++j) { v[j] = v[j] - mean; q += (v[j][0] * v[j][0] + v[j][1] * v[j][1]) + (v[j][2] * v[j][2] + v[j][3] * v[j][3]); }
            const float rstd = 1.0f / sqrtf(wave_sum(q) * (1.0f / DM) + 1e-5f);
#pragma unroll
            for (int j = 0; j < 4; ++j) {
                const f32x4 g = ((const f32x4*)P.ln_g)[lane + 64 * j], bb = ((const f32x4*)P.ln_b)[lane + 64 * j];
                ((f32x4*)zr)[lane + 64 * j] = v[j] * rstd * g + bb;
            }
        }
    }
}

extern "C" void kernel_launch(void* const* d_in, const int* in_sizes, int n_in, void* d_out, int out_size, void* d_ws, size_t ws_size, hipStream_t stream) {
    static int grid_blocks = 0;
    if (!grid_blocks) {
        int dev = 0, cus = 0, per_cu = 0;
        hipGetDevice(&dev);
        hipDeviceGetAttribute(&cus, hipDeviceAttributeMultiprocessorCount, dev);
        hipFuncSetAttribute((const void*)fwd_kernel, hipFuncAttributeMaxDynamicSharedMemorySize, LDS_BYTES);
        hipOccupancyMaxActiveBlocksPerMultiprocessor(&per_cu, (const void*)fwd_kernel, 512, LDS_BYTES);
        if (per_cu < 1) { fprintf(stderr, "kernel_launch: occupancy query says %d blocks per CU\n", per_cu); per_cu = 1; }
        grid_blocks = cus;
        if (ws_size < WS_END) fprintf(stderr, "kernel_launch: workspace too small (%zu < %zu)\n", ws_size, (size_t)WS_END);
    }
    hipMemsetAsync((char*)d_ws + WS_CTL, 0, 65536, stream);
    Params p{};
    p.x_prompt = (const float*)d_in[0]; p.x_sample = (const float*)d_in[1]; p.state_ret = (const float*)d_in[2];
    p.cache_k = (const float*)d_in[3]; p.cache_v = (const float*)d_in[4]; p.cmem_k = (const float*)d_in[5]; p.cmem_v = (const float*)d_in[6];
    p.mem_prompt = (const float*)d_in[7]; p.w_in = (const float*)d_in[8]; p.w_mkv = (const float*)d_in[9]; p.w_out = (const float*)d_in[10];
    p.ln_g = (const float*)d_in[11]; p.ln_b = (const float*)d_in[12];
    p.out = (float*)d_out; p.ws = (unsigned char*)d_ws;
    hipLaunchKernelGGL(fwd_kernel, dim3(grid_blocks), dim3(512), LDS_BYTES, stream, p);
    hipError_t e = hipPeekAtLastError();
    if (e != hipSuccess) fprintf(stderr, "launch failed: %s (grid %d)\n", hipGetErrorString(e), grid_blocks);
}
```

```cpp
#include <hip/hip_runtime.h>
#include <hip/hip_cooperative_groups.h>
#include <cstdio>
#include <cstdint>
namespace cg = cooperative_groups;

#define LAS __attribute__((address_space(3)))
typedef unsigned short bf16_t;
typedef short bf16x8 __attribute__((ext_vector_type(8)));
typedef float f32x4 __attribute__((ext_vector_type(4)));
typedef float f32x2 __attribute__((ext_vector_type(2)));
typedef unsigned u32x4 __attribute__((ext_vector_type(4)));
typedef unsigned u32x2 __attribute__((ext_vector_type(2)));
typedef __bf16 bf16x2_t __attribute__((ext_vector_type(2)));

constexpr int DM = 1024, NB = 8, SEQ = 2048, DECB = 32, DECT = 4;
constexpr int NMEM = 256, DIN = 4608, DMIX = 1536;
constexpr int M_PROMPT = NB * SEQ;
constexpr int M_SAMPLE = DECB * DECT;
constexpr int ROWS_IN = M_PROMPT + 256;
constexpr int ROWS_ALL = ROWS_IN + NB * NMEM;
constexpr int HP = DIN;
constexpr int C_RQ = 0, C_RK = 256, C_RV = 512, C_RG = 1024, C_SQ = 1536, C_SK = 2048, C_SV = 2560, C_SG = 3072, C_MQ = 3584, C_MG = 4096;
constexpr size_t O_YP = 0, O_YS = 16777216, O_RP = 16908288, O_RS = 17170432, O_KP = 18219008, O_VP = 26607616,
                 O_KS = 34996224, O_VS = 35061760, O_MK = 35127296, O_MV = 36175872;
constexpr size_t MiB = 1u << 20;
constexpr size_t WS_CTL = 0, WS_ROPE = 1 * MiB, WS_WTIN = 2 * MiB, WS_WTMKV = 11 * MiB, WS_WTOUT = 14 * MiB,
                 WS_XB = 20 * MiB, WS_HB = 64 * MiB, WS_MKV = 212 * MiB, WS_MIX = 216 * MiB, WS_END = 324 * MiB;
constexpr int LDS_BYTES = 163840;
constexpr float LOG2E = 1.4426950408889634f;
constexpr float SQ_SCALE = 0.18033688011112042f;
constexpr float MQ_SCALE = 0.12751743082459868f;
constexpr float ALPHA = 1.189207115002721f;

struct Params {
    const float *x_prompt, *x_sample, *state_ret, *cache_k, *cache_v, *cmem_k, *cmem_v, *mem_prompt, *w_in, *w_mkv, *w_out, *ln_g, *ln_b;
    float* out;
    unsigned char* ws;
};

__device__ __forceinline__ unsigned pk_bf16(float lo, float hi) { f32x2 v = {lo, hi}; bf16x2_t b = __builtin_convertvector(v, bf16x2_t); return __builtin_bit_cast(unsigned, b); }
__device__ __forceinline__ float bf_lo(unsigned u) { return __uint_as_float(u << 16); }
__device__ __forceinline__ float bf_hi(unsigned u) { return __uint_as_float(u & 0xffff0000u); }
__device__ __forceinline__ float bf2f(bf16_t h) { return __uint_as_float(((unsigned)h) << 16); }
__device__ __forceinline__ float fexp2(float x) { return __builtin_amdgcn_exp2f(x); }
__device__ __forceinline__ float frcp(float x) { return __builtin_amdgcn_rcpf(x); }
__device__ __forceinline__ float silu(float x) { return x * frcp(1.0f + fexp2(-x * LOG2E)); }
__device__ __forceinline__ float shx(float v, int o, int lane) { return __int_as_float(__builtin_amdgcn_ds_bpermute(((lane ^ o) & 63) << 2, __float_as_int(v))); }
__device__ __forceinline__ float wave_max(float v, int lane) {
#pragma unroll
    for (int o = 1; o < 64; o <<= 1) v = fmaxf(v, shx(v, o, lane));
    return v;
}
__device__ __forceinline__ float wave_sum(float v, int lane) {
#pragma unroll
    for (int o = 1; o < 64; o <<= 1) v += shx(v, o, lane);
    return v;
}
#define LDS_WAIT() asm volatile("s_waitcnt lgkmcnt(0)" ::: "memory")
__device__ __forceinline__ int lane_id() { return (int)__builtin_amdgcn_mbcnt_hi(~0u, __builtin_amdgcn_mbcnt_lo(~0u, 0u)); }
__device__ __forceinline__ int perm32(int rho) { const int n = rho >> 4, i = rho & 15; return 8 * (i >> 2) + 4 * n + (i & 3); }
__device__ __forceinline__ int dmap(int p) { return 16 * (p >> 5) + 32 * ((p >> 2) & 1) + 4 * ((p >> 3) & 3) + (p & 3); }
__device__ __forceinline__ int src_col_in(int c) {
    const int rho = c & 31;
    const bool rope = (c < 512) || (c >= 1536 && c < 2560);
    if (rope) return (c & ~63) + 16 * ((c >> 5) & 1) + 32 * (rho >> 4) + (rho & 15);
    return (c & ~31) + perm32(rho);
}

__device__ __forceinline__ void transpose_item(const float* W, int K, int N, bf16_t* WT, int mode, LAS float* scr, int item, int lane) {
    const int nblk = N / 32, kb = item / nblk, nb = item % nblk, k0 = 64 * kb, n0 = 32 * nb;
    const int cl = lane & 31;
    const int sc = (mode == 0) ? (n0 + cl) : (mode == 1) ? (n0 + perm32(cl)) : src_col_in(n0 + cl);
    {
        float t[32];
        const float* wp = W + (size_t)(k0 + (lane >> 5)) * N + sc;
#pragma unroll
        for (int i = 0; i < 32; ++i) t[i] = wp[(size_t)(2 * i) * N];
#pragma unroll
        for (int i = 0; i < 32; ++i) scr[(2 * i + (lane >> 5)) * 33 + cl] = t[i];
    }
    LDS_WAIT();
    const int c = lane & 7;
#pragma unroll
    for (int j = 0; j < 4; ++j) {
        const int n = (lane >> 3) + 8 * j; const LAS float* s = scr + (8 * c) * 33 + n;
        u32x4 o; o.x = pk_bf16(s[0 * 33], s[1 * 33]); o.y = pk_bf16(s[2 * 33], s[3 * 33]); o.z = pk_bf16(s[4 * 33], s[5 * 33]); o.w = pk_bf16(s[6 * 33], s[7 * 33]);
        *(u32x4*)(WT + (size_t)(n0 + n) * K + k0 + 8 * c) = o;
    }
    LDS_WAIT();
}
__device__ __forceinline__ void sincos_d(double a, float& s, float& c) {
    const double kd = __builtin_rint(a * 0.63661977236758134308);
    double y = __builtin_fma(-kd, 1.57079632679489655800e+00, a); y = __builtin_fma(-kd, 6.12323399573676603587e-17, y);
    const double y2 = y * y;
    const double sp = y * (1.0 + y2 * (-1.0 / 6 + y2 * (1.0 / 120 + y2 * (-1.0 / 5040 + y2 * (1.0 / 362880 + y2 * (-1.0 / 39916800 + y2 * (1.0 / 6227020800.0)))))));
    const double cp = 1.0 + y2 * (-0.5 + y2 * (1.0 / 24 + y2 * (-1.0 / 720 + y2 * (1.0 / 40320 + y2 * (-1.0 / 3628800 + y2 * (1.0 / 479001600.0))))));
    const int k = ((int)kd) & 3;
    const double sv = (k == 0) ? sp : (k == 1) ? cp : (k == 2) ? -sp : -cp;
    const double cv = (k == 0) ? cp : (k == 1) ? -sp : (k == 2) ? -cp : sp;
    s = (float)sv; c = (float)cv;
}
__device__ __forceinline__ void phase0(const Params& P, LAS unsigned char* lds, int tid, int lane, int wave) {
    unsigned char* ws = P.ws;
    const int gw = blockIdx.x * 8 + wave, NGW = gridDim.x * 8;
    LAS float* scr = (LAS float*)(lds + wave * 8448);
    constexpr int I_IN = (DM / 64) * (DIN / 32), I_MKV = (DM / 64) * (1024 / 32), I_OUT = (DMIX / 64) * (DM / 32);
    for (int it = gw; it < I_IN + I_MKV + I_OUT; it += NGW) {
        int r = it;
        if (r < I_IN) { transpose_item(P.w_in, DM, DIN, (bf16_t*)(ws + WS_WTIN), 2, scr, r, lane); continue; } r -= I_IN;
        if (r < I_MKV) { transpose_item(P.w_mkv, DM, 1024, (bf16_t*)(ws + WS_WTMKV), 1, scr, r, lane); continue; } r -= I_MKV;
        transpose_item(P.w_out, DMIX, DM, (bf16_t*)(ws + WS_WTOUT), 0, scr, r, lane);
    }
    bf16_t* XB = (bf16_t*)(ws + WS_XB);
    for (int m0 = gw; m0 < ROWS_ALL; m0 += 2 * NGW) {
        f32x4 v[2][4];
#pragma unroll
        for (int rr = 0; rr < 2; ++rr) {
            const int m = m0 + rr * NGW;
            const float* src = (m < M_PROMPT) ? P.x_prompt + (size_t)m * DM : (m < M_PROMPT + M_SAMPLE) ? P.x_sample + (size_t)(m - M_PROMPT) * DM
                             : (m < ROWS_IN || m >= ROWS_ALL) ? nullptr : P.mem_prompt + (size_t)(m - ROWS_IN) * DM;
#pragma unroll
            for (int j = 0; j < 4; ++j) { v[rr][j] = (f32x4){0.f, 0.f, 0.f, 0.f}; if (src) v[rr][j] = ((const f32x4*)src)[lane + 64 * j]; }
        }
#pragma unroll
        for (int rr = 0; rr < 2; ++rr) {
            const int m = m0 + rr * NGW;
            if (m < ROWS_ALL) {
                u32x2* dst = (u32x2*)(XB + (size_t)m * DM) + lane;
#pragma unroll
                for (int j = 0; j < 4; ++j) { u32x2 o; o.x = pk_bf16(v[rr][j].x, v[rr][j].y); o.y = pk_bf16(v[rr][j].z, v[rr][j].w); dst[64 * j] = o; }
            }
        }
    }
    float* rope = (float*)(ws + WS_ROPE);
    for (int e = blockIdx.x * 512 + tid; e < 2052 * 32; e += gridDim.x * 512) {
        const int idx = e >> 5, i = e & 31;
        const int pos = idx < 2048 ? idx : 8192 + (idx - 2048);
        double inv = 1.0;
        for (int k = 0; k < i; ++k) inv *= 0.7498942093324559;
        float s, c; sincos_d((double)pos * inv, s, c);
        rope[2 * e] = c; rope[2 * e + 1] = s;
    }
}

template <int K>
__device__ __forceinline__ void gemm_mainloop(const bf16_t* __restrict__ A, const bf16_t* __restrict__ Bt, LAS unsigned char* lds,
                                              f32x4 (&acc)[2][2][4][2], int tid, int wr, int wc, int fr, int fq) {
    constexpr int PITCH = 144;
    LAS unsigned char* As = lds; LAS unsigned char* Bs = lds + 256 * PITCH;
    const int lrow = tid >> 3, lch = tid & 7;
    const bf16_t* ga = A + (size_t)lrow * K + lch * 8;
    const bf16_t* gb = Bt + (size_t)lrow * K + lch * 8;
    u32x4 ra[4], rb[4];
#pragma unroll
    for (int i = 0; i < 4; ++i) { ra[i] = *(const u32x4*)(ga + (size_t)i * 64 * K); rb[i] = *(const u32x4*)(gb + (size_t)i * 64 * K); }
#pragma unroll
    for (int a = 0; a < 2; ++a)
#pragma unroll
        for (int b = 0; b < 2; ++b)
#pragma unroll
            for (int m = 0; m < 4; ++m)
#pragma unroll
                for (int n = 0; n < 2; ++n) acc[a][b][m][n] = (f32x4){0.f, 0.f, 0.f, 0.f};
    for (int kt = 0; kt < K / 64; ++kt) {
        __syncthreads();
#pragma unroll
        for (int i = 0; i < 4; ++i) {
            *(LAS u32x4*)(As + (lrow + 64 * i) * PITCH + lch * 16) = ra[i];
            *(LAS u32x4*)(Bs + (lrow + 64 * i) * PITCH + lch * 16) = rb[i];
        }
        __syncthreads();
        if (kt + 1 < K / 64) {
#pragma unroll
            for (int i = 0; i < 4; ++i) { ra[i] = *(const u32x4*)(ga + (size_t)i * 64 * K + (kt + 1) * 64); rb[i] = *(const u32x4*)(gb + (size_t)i * 64 * K + (kt + 1) * 64); }
        }
#pragma unroll
        for (int ai = 0; ai < 2; ++ai) {
#pragma unroll
            for (int k = 0; k < 2; ++k) {
                bf16x8 At[4];
#pragma unroll
                for (int m = 0; m < 4; ++m) At[m] = *(const LAS bf16x8*)(As + (ai * 128 + wr * 64 + m * 16 + fr) * PITCH + (k * 32 + fq * 8) * 2);
#pragma unroll
                for (int bj = 0; bj < 2; ++bj) {
                    bf16x8 Bf[2];
#pragma unroll
                    for (int n = 0; n < 2; ++n) Bf[n] = *(const LAS bf16x8*)(Bs + (bj * 128 + wc * 32 + n * 16 + fr) * PITCH + (k * 32 + fq * 8) * 2);
#pragma unroll
                    for (int m = 0; m < 4; ++m)
#pragma unroll
                        for (int n = 0; n < 2; ++n) acc[ai][bj][m][n] = __builtin_amdgcn_mfma_f32_16x16x32_bf16(Bf[n], At[m], acc[ai][bj][m][n], 0, 0, 0);
                }
            }
        }
    }
}


namespace pg8 {
#define PG8_LAS __attribute__((address_space(3)))
typedef unsigned short bf16_t;
typedef short bf16x8 __attribute__((ext_vector_type(8)));
typedef float f32x4 __attribute__((ext_vector_type(4)));
constexpr int BM = 256, BK = 64, HALF = 128, HTB = HALF * BK * 2, STAGE_BYTES = 8 * HTB;
__host__ __device__ __forceinline__ int lds_byte(int r, int c) { const int st = (r >> 4) * 2 + (c >> 5), rr = r & 15, cc = c & 31, ob = rr * 64 + cc * 2; return st * 1024 + (ob ^ (((ob >> 9) & 1) << 5)); }
__host__ __device__ __forceinline__ void stage_rc(int b, int& R, int& C) { const int st = b / 1024, sb = b % 1024, swz = sb ^ (((sb >> 9) & 1) << 5); R = (st >> 1) * 16 + swz / 64; C = (st & 1) * 32 + (swz % 64) / 2; }
__host__ __device__ __forceinline__ int perm32(int rho) { const int n = rho >> 4, i = rho & 15; return 8 * (i >> 2) + 4 * n + (i & 3); }
struct Unit { int pm, pn; };
struct Gemm { const bf16_t* A; const bf16_t* Bt; int M, N, K; };
template <class Epi, class Sched, bool ALIGN_EPI = false, bool SP2 = false>
__device__ __forceinline__ void gemm_phase(PG8_LAS unsigned char* lds, const Gemm g, const Sched& S, const Epi& E, int tid_in) {
    int tid = tid_in; asm volatile("" : "+v"(tid));
    const int wid = __builtin_amdgcn_readfirstlane(tid >> 6), lane = tid & 63, wr = wid >> 2, wc = wid & 3, fr = lane & 15, fq = lane >> 4;
    const int K = g.K, nt = K / BK;
    unsigned voffA[2], voffB[2];
#pragma unroll
    for (int i = 0; i < 2; ++i) { int R, C; stage_rc(tid * 16 + i * 8192, R, C); const int Rb = Epi::PERM ? ((R & ~31) + perm32(R & 31)) : R;
        voffA[i] = (unsigned)(R * K + C) * 2u; voffB[i] = (unsigned)(Rb * K + C) * 2u; }
    const size_t kstep = (size_t)(BK * 2);
    const size_t hstep = (size_t)HALF * K * 2;
    const size_t tstep = 2 * hstep;
    const unsigned ldsw = (unsigned)wid * 1024u;
    const int aoff = lds_byte(wr * 64 + fr, fq * 8), boff = lds_byte(wc * 32 + fr, fq * 8);
#define PG8_SA(b, h) (((b) * 2 + (h)) * HTB)
#define PG8_SB(b, h) ((4 + (b) * 2 + (h)) * HTB)
#define PG8_STAGE(bufoff, gbase, voff) do { _Pragma("unroll") for (int _i = 0; _i < 2; ++_i) \
        __builtin_amdgcn_global_load_lds((const unsigned*)((const char*)(gbase) + (voff)[_i]), (PG8_LAS unsigned*)(lds + (bufoff) + ldsw + _i * 8192), 16, 0, 0); } while (0)
#define PG8_LDA(dst, b, h) do { _Pragma("unroll") for (int m = 0; m < 4; ++m) _Pragma("unroll") for (int k = 0; k < 2; ++k) dst[m][k] = *(const PG8_LAS bf16x8*)(lds + PG8_SA(b, h) + aoff + m * 2048 + k * 1024); } while (0)
#define PG8_LDB(dst, b, h) do { _Pragma("unroll") for (int n = 0; n < 2; ++n) _Pragma("unroll") for (int k = 0; k < 2; ++k) dst[n][k] = *(const PG8_LAS bf16x8*)(lds + PG8_SB(b, h) + boff + n * 2048 + k * 1024); } while (0)
#define PG8_MMA(ai, bj, At, Bt) do { __builtin_amdgcn_s_setprio(1); _Pragma("unroll") for (int m = 0; m < 4; ++m) _Pragma("unroll") for (int n = 0; n < 2; ++n) _Pragma("unroll") for (int k = 0; k < 2; ++k) \
        acc[ai][bj][m][n] = __builtin_amdgcn_mfma_f32_16x16x32_bf16(Bt[n][k], At[m][k], acc[ai][bj][m][n], 0, 0, 0); __builtin_amdgcn_s_setprio(0); } while (0)
#define PG8_WAIT_V(n) asm volatile("s_waitcnt vmcnt(" #n ")" ::: "memory")
#define PG8_WAIT_L(n) asm volatile("s_waitcnt lgkmcnt(" #n ")" ::: "memory")
#define PG8_BAR __builtin_amdgcn_s_barrier()
#define PG8_SCHED __builtin_amdgcn_sched_barrier(0)
    Unit cur, nxt; int ui = 0;
    if (!S.next(0, cur)) return;
    f32x4 acc[2][2][4][2];
#pragma unroll
    for (int a = 0; a < 2; ++a)
#pragma unroll
        for (int b = 0; b < 2; ++b)
#pragma unroll
            for (int m = 0; m < 4; ++m)
#pragma unroll
                for (int n = 0; n < 2; ++n) acc[a][b][m][n] = (f32x4){0.f, 0.f, 0.f, 0.f};
    bf16x8 At[4][2], B0[2][2], B1[2][2];
    const char* cA = (const char*)g.A + (size_t)cur.pm * tstep; const char* cB = (const char*)g.Bt + (size_t)cur.pn * tstep;
    S.a_ready(cur);
    if constexpr (SP2) {
        PG8_STAGE(PG8_SB(0, 0), cB, voffB); PG8_STAGE(PG8_SB(0, 1), cB + hstep, voffB); PG8_STAGE(PG8_SA(0, 0), cA, voffA); PG8_STAGE(PG8_SA(0, 1), cA + hstep, voffA);
        if (wr == 1) PG8_BAR;
        PG8_WAIT_V(2); PG8_BAR;
        PG8_STAGE(PG8_SB(1, 0), cB + kstep, voffB); PG8_STAGE(PG8_SA(1, 0), cA + kstep, voffA); PG8_STAGE(PG8_SB(1, 1), cB + hstep + kstep, voffB);
        PG8_WAIT_V(6); PG8_BAR;
    } else {
        PG8_STAGE(PG8_SB(0, 0), cB, voffB); PG8_STAGE(PG8_SA(0, 0), cA, voffA); PG8_STAGE(PG8_SB(0, 1), cB + hstep, voffB); PG8_STAGE(PG8_SA(0, 1), cA + hstep, voffA);
        if (wr == 1) PG8_BAR;
        PG8_WAIT_V(4); PG8_BAR;
        PG8_STAGE(PG8_SB(1, 0), cB + kstep, voffB); PG8_STAGE(PG8_SA(1, 0), cA + kstep, voffA); PG8_STAGE(PG8_SB(1, 1), cB + hstep + kstep, voffB);
        PG8_WAIT_V(6); PG8_BAR;
    }
    for (;;) {
        const bool has_next = S.next(ui + 1, nxt);
        const char* nA = has_next ? (const char*)g.A + (size_t)nxt.pm * tstep : cA; const char* nB = has_next ? (const char*)g.Bt + (size_t)nxt.pn * tstep : cB;
        for (int t = 0; t < nt; t += 2) {
            const bool last = (t == nt - 2);
            const char* a1 = cA + (size_t)(t + 1) * kstep;
            const char* a2 = last ? nA : cA + (size_t)(t + 2) * kstep; const char* b2 = last ? nB : cB + (size_t)(t + 2) * kstep;
            const char* a3 = a2 + kstep; const char* b3 = b2 + kstep;
            if (last && has_next) S.a_ready(nxt);
            if constexpr (SP2) {
            PG8_LDB(B0, 0, 0); PG8_LDB(B1, 0, 1); PG8_SCHED; PG8_LDA(At, 0, 0); PG8_STAGE(PG8_SA(1, 1), a1 + hstep, voffA);
            PG8_WAIT_V(8); PG8_WAIT_L(0); PG8_BAR; PG8_MMA(0, 0, At, B0); PG8_MMA(0, 1, At, B1); PG8_BAR; PG8_SCHED;
            PG8_LDA(At, 0, 1); PG8_STAGE(PG8_SB(0, 0), b2, voffB); PG8_STAGE(PG8_SB(0, 1), b2 + hstep, voffB); PG8_STAGE(PG8_SA(0, 0), a2, voffA);
            PG8_WAIT_V(8); PG8_WAIT_L(0); PG8_BAR; PG8_MMA(1, 0, At, B0); PG8_MMA(1, 1, At, B1); PG8_BAR; PG8_SCHED;
            PG8_LDB(B0, 1, 0); PG8_LDB(B1, 1, 1); PG8_SCHED; PG8_LDA(At, 1, 0); PG8_STAGE(PG8_SA(0, 1), a2 + hstep, voffA);
            PG8_WAIT_V(8); PG8_WAIT_L(0); PG8_BAR; PG8_MMA(0, 0, At, B0); PG8_MMA(0, 1, At, B1); PG8_BAR; PG8_SCHED;
            PG8_LDA(At, 1, 1); PG8_STAGE(PG8_SB(1, 0), b3, voffB); PG8_STAGE(PG8_SB(1, 1), b3 + hstep, voffB); PG8_STAGE(PG8_SA(1, 0), a3, voffA);
            PG8_WAIT_V(8); PG8_WAIT_L(0); PG8_BAR; PG8_MMA(1, 0, At, B0); PG8_MMA(1, 1, At, B1); PG8_BAR; PG8_SCHED;
            } else {
            PG8_LDB(B0, 0, 0); PG8_SCHED; PG8_LDA(At, 0, 0); PG8_STAGE(PG8_SA(1, 1), a1 + hstep, voffA);
            PG8_WAIT_L(8); PG8_BAR; PG8_WAIT_L(0); PG8_MMA(0, 0, At, B0); PG8_BAR; PG8_SCHED;
            PG8_LDB(B1, 0, 1); PG8_STAGE(PG8_SB(0, 0), b2, voffB);
            PG8_BAR; PG8_WAIT_L(0); PG8_MMA(0, 1, At, B1); PG8_BAR;
            PG8_LDA(At, 0, 1); PG8_STAGE(PG8_SA(0, 0), a2, voffA);
            PG8_BAR; PG8_WAIT_L(0); PG8_MMA(1, 0, At, B0); PG8_BAR; PG8_SCHED;
            PG8_STAGE(PG8_SB(0, 1), b2 + hstep, voffB);
            PG8_WAIT_V(6); PG8_BAR; PG8_MMA(1, 1, At, B1); PG8_BAR;
            PG8_LDB(B0, 1, 0); PG8_SCHED; PG8_LDA(At, 1, 0); PG8_STAGE(PG8_SA(0, 1), a2 + hstep, voffA);
            PG8_WAIT_L(8); PG8_BAR; PG8_WAIT_L(0); PG8_MMA(0, 0, At, B0); PG8_BAR; PG8_SCHED;
            PG8_LDB(B1, 1, 1); PG8_STAGE(PG8_SB(1, 0), b3, voffB);
            PG8_BAR; PG8_WAIT_L(0); PG8_MMA(0, 1, At, B1); PG8_BAR;
            PG8_LDA(At, 1, 1); PG8_STAGE(PG8_SA(1, 0), a3, voffA);
            PG8_BAR; PG8_WAIT_L(0); PG8_MMA(1, 0, At, B0); PG8_BAR; PG8_SCHED;
            PG8_STAGE(PG8_SB(1, 1), b3 + hstep, voffB);
            PG8_WAIT_V(6); PG8_BAR; PG8_MMA(1, 1, At, B1); PG8_BAR;
            }
        }
        if constexpr (ALIGN_EPI) { if (wr == 0) PG8_BAR; }
        if constexpr (!Epi::AFTER_DRAIN) { E(acc, cur, wr, wc, fr, fq); S.done(cur); }
        if (!has_next) break;
#pragma unroll
        for (int a = 0; a < 2; ++a)
#pragma unroll
            for (int b = 0; b < 2; ++b)
#pragma unroll
                for (int m = 0; m < 4; ++m)
#pragma unroll
                    for (int n = 0; n < 2; ++n) acc[a][b][m][n] = (f32x4){0.f, 0.f, 0.f, 0.f};
        cur = nxt; cA = nA; cB = nB; ++ui;
        if constexpr (ALIGN_EPI) { if (wr == 1) PG8_BAR; }
    }
    PG8_WAIT_V(0);
    if constexpr (!ALIGN_EPI) { if (wr == 0) PG8_BAR; }
    PG8_BAR;
    if constexpr (Epi::AFTER_DRAIN) { E.fused(acc, cur, wr, wc, fr, fq, lds, wid, lane); S.done(cur); }
#undef PG8_SA
#undef PG8_SB
#undef PG8_STAGE
#undef PG8_LDA
#undef PG8_LDB
#undef PG8_MMA
#undef PG8_WAIT_V
#undef PG8_WAIT_L
#undef PG8_BAR
#undef PG8_SCHED
}
}

__device__ __forceinline__ void epi_inproj(const f32x4 (&acc)[2][2][4][2], int pm, int pn, const Params& P, int wr, int wc, int fr, int fq) {
    bf16_t* HB = (bf16_t*)(P.ws + WS_HB);
    const float* rope = (const float*)(P.ws + WS_ROPE);
    int type = 0; float scale = 1.0f; int f32out = 0;
    if (pn == 0) { type = 1; }
    else if (pn == 1) { type = 1; scale = 0.125f; }
    else if (pn == 4 || pn == 5 || pn == 12 || pn == 13 || pn == 16 || pn == 17) { type = 2; }
    else if (pn == 6 || pn == 7) { type = 1; scale = SQ_SCALE; }
    else if (pn == 8 || pn == 9) { type = 1; f32out = 1; }
    else if (pn == 10 || pn == 11) { f32out = 2; }
    else if (pn == 14 || pn == 15) { scale = MQ_SCALE; }
#pragma unroll
    for (int ai = 0; ai < 2; ++ai)
#pragma unroll
        for (int m = 0; m < 4; ++m) {
            const int r = pm * 256 + ai * 128 + wr * 64 + m * 16 + fr;
            const int pi = r < M_PROMPT ? (r & 2047) : 2048 + ((r - M_PROMPT) & 3);
            const bool live = r < M_PROMPT + M_SAMPLE;
#pragma unroll
            for (int bj = 0; bj < 2; ++bj) {
                const int cb = pn * 256 + bj * 128 + wc * 32;
                f32x4 v0 = acc[ai][bj][m][0], v1 = acc[ai][bj][m][1];
                if (type == 1) {
                    const int d1 = 16 * ((cb >> 5) & 1) + 4 * fq;
                    const f32x4* rp = (const f32x4*)(rope + ((size_t)pi * 32 + d1) * 2);
                    const f32x4 cs0 = rp[0], cs1 = rp[1];
                    f32x4 y1, y2;
                    y1[0] = v0[0] * cs0[0] - v1[0] * cs0[1]; y2[0] = v1[0] * cs0[0] + v0[0] * cs0[1];
                    y1[1] = v0[1] * cs0[2] - v1[1] * cs0[3]; y2[1] = v1[1] * cs0[2] + v0[1] * cs0[3];
                    y1[2] = v0[2] * cs1[0] - v1[2] * cs1[1]; y2[2] = v1[2] * cs1[0] + v0[2] * cs1[1];
                    y1[3] = v0[3] * cs1[2] - v1[3] * cs1[3]; y2[3] = v1[3] * cs1[2] + v0[3] * cs1[3];
                    if (f32out == 1 && live) {
                        float* o = (r < M_PROMPT ? P.out + O_KP + (size_t)r * 512 : P.out + O_KS + (size_t)(r - M_PROMPT) * 512) + ((cb - C_SK) >> 6) * 64 + d1;
                        *(f32x4*)o = y1; *(f32x4*)(o + 32) = y2;
                    }
                    v0 = y1 * scale; v1 = y2 * scale;
                } else if (type == 2) {
#pragma unroll
                    for (int e = 0; e < 4; ++e) { v0[e] = silu(v0[e]); v1[e] = silu(v1[e]); }
                } else {
                    if (f32out == 2 && live) {
                        float* o = (r < M_PROMPT ? P.out + O_VP + (size_t)r * 512 : P.out + O_VS + (size_t)(r - M_PROMPT) * 512) + (cb - C_SV) + 8 * fq;
                        *(f32x4*)o = v0; *(f32x4*)(o + 4) = v1;
                    }
                    v0 = v0 * scale; v1 = v1 * scale;
                }
                u32x4 w; w.x = pk_bf16(v0[0], v0[1]); w.y = pk_bf16(v0[2], v0[3]); w.z = pk_bf16(v1[0], v1[1]); w.w = pk_bf16(v1[2], v1[3]);
                *(u32x4*)(HB + (size_t)r * HP + cb + 8 * fq) = w;
            }
        }
}
__device__ __forceinline__ void epi_memkv(const f32x4 (&acc)[2][2][4][2], int pm, int pn, const Params& P, int wr, int wc, int fr, int fq) {
    bf16_t* MKV = (bf16_t*)(P.ws + WS_MKV);
#pragma unroll
    for (int ai = 0; ai < 2; ++ai)
#pragma unroll
        for (int m = 0; m < 4; ++m) {
            const int r = pm * 256 + ai * 128 + wr * 64 + m * 16 + fr;
#pragma unroll
            for (int bj = 0; bj < 2; ++bj) {
                const int c0 = pn * 256 + bj * 128 + wc * 32 + 8 * fq;
                const f32x4 v0 = acc[ai][bj][m][0], v1 = acc[ai][bj][m][1];
                float* o = (c0 < 512) ? P.out + O_MK + (size_t)r * 512 + c0 : P.out + O_MV + (size_t)r * 512 + (c0 - 512);
                *(f32x4*)o = v0; *(f32x4*)(o + 4) = v1;
                u32x4 w; w.x = pk_bf16(v0[0], v0[1]); w.y = pk_bf16(v0[2], v0[3]); w.z = pk_bf16(v1[0], v1[1]); w.w = pk_bf16(v1[2], v1[3]);
                *(u32x4*)(MKV + (size_t)r * 1024 + c0) = w;
            }
        }
}
constexpr size_t WS_Z = 290 * MiB;
__device__ __forceinline__ void epi_outproj(const f32x4 (&acc)[2][2][4][2], int pm, int pn, const Params& P, int wr, int wc, int fr, int fq) {
    const bf16_t* XB = (const bf16_t*)(P.ws + WS_XB);
    bf16_t* Z = (bf16_t*)(P.ws + WS_Z);
#pragma unroll
    for (int ai = 0; ai < 2; ++ai)
#pragma unroll
        for (int m = 0; m < 4; ++m) {
            const size_t r = (size_t)pm * 256 + ai * 128 + wr * 64 + m * 16 + fr;
#pragma unroll
            for (int bj = 0; bj < 2; ++bj)
#pragma unroll
                for (int n = 0; n < 2; ++n) {
                    const int c = pn * 256 + bj * 128 + wc * 32 + 16 * n + 4 * fq;
                    const u32x2 xv = *(const u32x2*)(XB + r * DM + c);
                    const f32x4 a = acc[ai][bj][m][n];
                    u32x2 w; w.x = pk_bf16(bf_lo(xv.x) * ALPHA + a[0], bf_hi(xv.x) * ALPHA + a[1]); w.y = pk_bf16(bf_lo(xv.y) * ALPHA + a[2], bf_hi(xv.y) * ALPHA + a[3]);
                    *(u32x2*)(Z + r * DM + c) = w;
                }
        }
}

__device__ __forceinline__ void ret_scan(const Params& P, LAS unsigned char* lds, int b, int h, int row0, int ntok, const float* init, float* outstate, int tid) {
    const bf16_t* HB = (const bf16_t*)(P.ws + WS_HB);
    bf16_t* MIX = (bf16_t*)(P.ws + WS_MIX);
    LAS float* qs = (LAS float*)lds;
    LAS float* ks = qs + 32 * 64;
    LAS float* vs = ks + 32 * 64;
    LAS float* po = vs + 32 * 128;
    const int vv = tid & 127, kq = tid >> 7, lane = tid & 63;
    const float gamma = 1.0f - __builtin_amdgcn_exp2f((float)(-5 - h));
    float S[16];
#pragma unroll
    for (int j = 0; j < 16; ++j) S[j] = init ? init[((size_t)((b * 4 + h) * 64 + dmap(16 * kq + j))) * 128 + vv] : 0.f;
    for (int t0 = 0; t0 < ntok; t0 += 32) {
        const int nb = (ntok - t0) < 32 ? (ntok - t0) : 32;
        __syncthreads();
        {
            const int tt = (tid & 255) >> 3, ch = tid & 7;
            if (tt < nb) {
                const u32x4 w = *(const u32x4*)(HB + (size_t)(row0 + t0 + tt) * HP + (tid < 256 ? C_RQ : C_RK) + h * 64 + ch * 8);
                LAS float* dst = (tid < 256 ? qs : ks) + tt * 64 + ch * 8;
                dst[0] = bf_lo(w.x); dst[1] = bf_hi(w.x); dst[2] = bf_lo(w.y); dst[3] = bf_hi(w.y);
                dst[4] = bf_lo(w.z); dst[5] = bf_hi(w.z); dst[6] = bf_lo(w.w); dst[7] = bf_hi(w.w);
            }
            const int tv = tid >> 4, cv = tid & 15;
            if (tv < nb) {
                const u32x4 w = *(const u32x4*)(HB + (size_t)(row0 + t0 + tv) * HP + C_RV + h * 128 + cv * 8);
                LAS float* dst = vs + tv * 128 + cv * 8;
                dst[0] = bf_lo(w.x); dst[1] = bf_hi(w.x); dst[2] = bf_lo(w.y); dst[3] = bf_hi(w.y);
                dst[4] = bf_lo(w.z); dst[5] = bf_hi(w.z); dst[6] = bf_lo(w.w); dst[7] = bf_hi(w.w);
            }
        }
        __syncthreads();
        for (int tt = 0; tt < nb; ++tt) {
            const float vval = vs[tt * 128 + vv];
            float o = 0.f;
#pragma unroll
            for (int j4 = 0; j4 < 4; ++j4) {
                const f32x4 k4 = *(const LAS f32x4*)(ks + tt * 64 + 16 * kq + 4 * j4);
                const f32x4 q4 = *(const LAS f32x4*)(qs + tt * 64 + 16 * kq + 4 * j4);
#pragma unroll
                for (int e = 0; e < 4; ++e) { S[4 * j4 + e] = fmaf(gamma, S[4 * j4 + e], k4[e] * vval); o = fmaf(q4[e], S[4 * j4 + e], o); }
            }
            po[(tt * 4 + kq) * 128 + vv] = o;
        }
        __syncthreads();
        {
            const int tf = tid >> 4, c8 = (tid & 15) * 8;
            float o[8]; float s = 0.f;
#pragma unroll
            for (int e = 0; e < 8; ++e) { o[e] = (po[(tf * 4 + 0) * 128 + c8 + e] + po[(tf * 4 + 1) * 128 + c8 + e]) + (po[(tf * 4 + 2) * 128 + c8 + e] + po[(tf * 4 + 3) * 128 + c8 + e]); s += o[e]; }
            s += shx(s, 1, lane); s += shx(s, 2, lane); s += shx(s, 4, lane); s += shx(s, 8, lane);
            const float mean = s * (1.0f / 128.0f);
            float q = 0.f;
#pragma unroll
            for (int e = 0; e < 8; ++e) { o[e] -= mean; q += o[e] * o[e]; }
            q += shx(q, 1, lane); q += shx(q, 2, lane); q += shx(q, 4, lane); q += shx(q, 8, lane);
            const float rstd = 1.0f / sqrtf(q * (1.0f / 128.0f) + 1e-5f);
            if (tf < nb) {
                const size_t row = (size_t)(row0 + t0 + tf);
                const u32x4 g = *(const u32x4*)(HB + row * HP + C_RG + h * 128 + c8);
                u32x4 w;
                w.x = pk_bf16(o[0] * rstd * bf_lo(g.x), o[1] * rstd * bf_hi(g.x)); w.y = pk_bf16(o[2] * rstd * bf_lo(g.y), o[3] * rstd * bf_hi(g.y));
                w.z = pk_bf16(o[4] * rstd * bf_lo(g.z), o[5] * rstd * bf_hi(g.z)); w.w = pk_bf16(o[6] * rstd * bf_lo(g.w), o[7] * rstd * bf_hi(g.w));
                *(u32x4*)(MIX + row * DMIX + h * 128 + c8) = w;
            }
        }
    }
    __syncthreads();
#pragma unroll
    for (int j = 0; j < 16; ++j) outstate[((size_t)((b * 4 + h) * 64 + dmap(16 * kq + j))) * 128 + vv] = S[j];
}

__device__ __forceinline__ float dot4(f32x4 a, f32x4 b) { return (a[0] * b[0] + a[1] * b[1]) + (a[2] * b[2] + a[3] * b[3]); }
__device__ __forceinline__ void swa_sample_unit(const Params& P, LAS unsigned char* lds, int tid, int wave, int b, int h) {
    const bf16_t* HB = (const bf16_t*)(P.ws + WS_HB);
    bf16_t* MIX = (bf16_t*)(P.ws + WS_MIX);
    LAS float* qo = (LAS float*)lds; LAS float* kn = qo + 256; LAS float* vn = kn + 256;
    LAS float* sc = (LAS float*)(lds + 4096); LAS float* ls = (LAS float*)(lds + 10496); LAS float* red = (LAS float*)(lds + 12288);
    const int lane = tid & 63;
    __syncthreads();
    if (tid < 256) {
        const int i = tid >> 6, p = tid & 63; const size_t R = (size_t)M_PROMPT + b * 4 + i;
        qo[i * 64 + dmap(p)] = bf2f(HB[R * HP + C_SQ + h * 64 + p]);
        kn[i * 64 + dmap(p)] = bf2f(HB[R * HP + C_SK + h * 64 + p]);
        vn[i * 64 + p] = bf2f(HB[R * HP + C_SV + h * 64 + p]);
    }
    __syncthreads();
#pragma unroll 1
    for (int rnd = 0; rnd < 4; ++rnd) {
        const int tr = tid + 512 * rnd;
        if (tr < 1548) {
            const int i = tr / 387, rem = tr - i * 387, g = rem / 129, s = rem - g * 129;
            const int dil = (g == 0) ? 1 : (g == 1) ? 4 : 16;
            const int idx = 2048 + i - dil * s;
            float a = 0.f;
            if (idx < 2048) {
                const f32x4* kc = (const f32x4*)(P.cache_k + (((size_t)b * 2048 + idx) * 8 + h) * 64);
                f32x4 kv[16];
#pragma unroll
                for (int c = 0; c < 16; ++c) kv[c] = kc[c];
#pragma unroll
                for (int c = 0; c < 16; ++c) a += dot4(kv[c], *(const LAS f32x4*)(qo + i * 64 + 4 * c));
            } else {
                const LAS f32x4* kc = (const LAS f32x4*)(kn + (idx - 2048) * 64);
#pragma unroll
                for (int c = 0; c < 16; ++c) a += dot4(kc[c], *(const LAS f32x4*)(qo + i * 64 + 4 * c));
            }
            sc[tr] = a;
        }
    }
    __syncthreads();
    if (wave < 4) {
        const int i = wave;
        float m = -INFINITY;
#pragma unroll
        for (int k = 0; k < 7; ++k) { const int e = lane + 64 * k; if (e < 387) m = fmaxf(m, sc[i * 387 + e]); }
        m = wave_max(m, lane);
        float l = 0.f;
#pragma unroll
        for (int k = 0; k < 7; ++k) { const int e = lane + 64 * k; if (e < 387) { const float p = fexp2(sc[i * 387 + e] - m); sc[i * 387 + e] = p; l += p; } }
        l = wave_sum(l, lane);
        if (lane == 0) ls[i] = l;
    }
    __syncthreads();
    {
        const int d4 = tid & 15, slot = tid >> 4;
#pragma unroll 1
        for (int i = 0; i < 4; ++i) {
            f32x4 acc = {0.f, 0.f, 0.f, 0.f};
            f32x4 vv[13]; float pp[13];
#pragma unroll
            for (int k = 0; k < 13; ++k) {
                const int e0 = slot + 32 * k; const bool ok = e0 < 387; const int e = ok ? e0 : 0;
                const int g = e / 129, s = e - g * 129;
                const int dil = (g == 0) ? 1 : (g == 1) ? 4 : 16;
                const int idx = 2048 + i - dil * s;
                pp[k] = ok ? sc[i * 387 + e] : 0.f;
                vv[k] = (idx < 2048) ? *(const f32x4*)(P.cache_v + (((size_t)b * 2048 + idx) * 8 + h) * 64 + d4 * 4)
                                     : *(const LAS f32x4*)(vn + (idx - 2048) * 64 + d4 * 4);
            }
#pragma unroll
            for (int k = 0; k < 13; ++k) acc = acc + vv[k] * pp[k];
            *(LAS f32x4*)(red + (slot * 4 + i) * 64 + d4 * 4) = acc;
        }
    }
    __syncthreads();
    if (tid < 256) {
        const int i = tid >> 6, d = tid & 63;
        float s = 0.f;
#pragma unroll
        for (int sl = 0; sl < 32; ++sl) s += red[(sl * 4 + i) * 64 + d];
        const size_t R = (size_t)M_PROMPT + b * 4 + i;
        const float gate = bf2f(HB[R * HP + C_SG + h * 64 + d]);
        MIX[R * DMIX + 512 + h * 64 + d] = (bf16_t)(pk_bf16(s / ls[i] * gate, 0.f) & 0xffffu);
    }
}
__device__ __forceinline__ void mem_sample_unit(const Params& P, LAS unsigned char* lds, int tid, int wave, int b, int h) {
    const bf16_t* HB = (const bf16_t*)(P.ws + WS_HB);
    bf16_t* MIX = (bf16_t*)(P.ws + WS_MIX);
    LAS float* qm = (LAS float*)lds; LAS float* part = (LAS float*)(lds + 2048); LAS float* pr = (LAS float*)(lds + 10240);
    LAS float* ls = (LAS float*)(lds + 14336); LAS float* red = (LAS float*)(lds + 16384);
    const int lane = tid & 63;
    __syncthreads();
    { const int i = tid >> 7, d = tid & 127; qm[i * 128 + d] = bf2f(HB[((size_t)M_PROMPT + b * 4 + i) * HP + C_MQ + h * 128 + d]); }
    __syncthreads();
    {
        const int m = tid & 255, half = tid >> 8;
        const f32x4* kc = (const f32x4*)(P.cmem_k + (((size_t)b * NMEM + m) * 4 + h) * 128 + half * 64);
        f32x4 kv[16];
#pragma unroll
        for (int c = 0; c < 16; ++c) kv[c] = kc[c];
#pragma unroll
        for (int i = 0; i < 4; ++i) {
            float a = 0.f;
#pragma unroll
            for (int c = 0; c < 16; ++c) a += dot4(kv[c], *(const LAS f32x4*)(qm + i * 128 + half * 64 + 4 * c));
            part[(half * 4 + i) * 256 + m] = a;
        }
    }
    __syncthreads();
    if (wave < 4) {
        const int i = wave;
        float s[4]; float m = -INFINITY;
#pragma unroll
        for (int k = 0; k < 4; ++k) { s[k] = part[i * 256 + lane + 64 * k] + part[(4 + i) * 256 + lane + 64 * k]; m = fmaxf(m, s[k]); }
        m = wave_max(m, lane);
        float l = 0.f;
#pragma unroll
        for (int k = 0; k < 4; ++k) { const float p = fexp2(s[k] - m); pr[i * 256 + lane + 64 * k] = p; l += p; }
        l = wave_sum(l, lane);
        if (lane == 0) ls[i] = l;
    }
    __syncthreads();
    {
        const int d4 = tid & 31, slot = tid >> 5;
        f32x4 acc[4];
#pragma unroll
        for (int i = 0; i < 4; ++i) acc[i] = (f32x4){0.f, 0.f, 0.f, 0.f};
        f32x4 vv[16];
#pragma unroll
        for (int k = 0; k < 16; ++k) vv[k] = *(const f32x4*)(P.cmem_v + (((size_t)b * NMEM + slot + 16 * k) * 4 + h) * 128 + d4 * 4);
#pragma unroll
        for (int k = 0; k < 16; ++k)
#pragma unroll
            for (int i = 0; i < 4; ++i) acc[i] = acc[i] + vv[k] * pr[i * 256 + slot + 16 * k];
#pragma unroll
        for (int i = 0; i < 4; ++i) *(LAS f32x4*)(red + (slot * 4 + i) * 128 + d4 * 4) = acc[i];
    }
    __syncthreads();
    {
        const int i = tid >> 7, d = tid & 127;
        float s = 0.f;
#pragma unroll
        for (int sl = 0; sl < 16; ++sl) s += red[(sl * 4 + i) * 128 + d];
        const size_t R = (size_t)M_PROMPT + b * 4 + i;
        const float gate = bf2f(HB[R * HP + C_MG + h * 128 + d]);
        MIX[R * DMIX + 1024 + h * 128 + d] = (bf16_t)(pk_bf16(s / ls[i] * gate, 0.f) & 0xffffu);
    }
}

typedef float f32x16 __attribute__((ext_vector_type(16)));
typedef short s16x4 __attribute__((ext_vector_type(4)));
constexpr int SWA_ST_O = 0, SWA_ST_M = 65536, SWA_ST_L = 65536 + 2048, SWA_WV = 69632, SWA_WV_STRIDE = 10240 + 768;
__device__ __forceinline__ s16x4 tr16(LAS unsigned char* p) { return __builtin_bit_cast(s16x4, __builtin_amdgcn_ds_read_tr16_b64_v4i16((LAS s16x4*)p)); }
__device__ __forceinline__ f32x16 mfma32(bf16x8 a, bf16x8 b, f32x16 c) { return __builtin_amdgcn_mfma_f32_32x32x16_bf16(a, b, c, 0, 0, 0); }
#define VM_WAIT() asm volatile("s_waitcnt vmcnt(0)" ::: "memory")

struct SwaT { int dil, r, i0, pat; };
__device__ __forceinline__ SwaT swa_params(int i, int wave, int T0) {
    const int pat = i >> 1, k = wave + 8 * (i & 1);
    SwaT t; t.pat = pat;
    if (pat == 0) { t.dil = 1; t.r = 0; t.i0 = T0 + 32 * k; }
    else if (pat == 1) { t.dil = 4; t.r = k & 3; t.i0 = (T0 >> 2) + 32 * (k >> 2); }
    else { t.dil = 16; t.r = k; t.i0 = T0 >> 4; }
    return t;
}
__device__ __forceinline__ void swa_loadqk(const Params& P, const SwaT& t, int b, int h, int lane, bf16x8 (&qf)[4], bf16x8 (&kf)[5][4]) {
    const bf16_t* HB = (const bf16_t*)(P.ws + WS_HB);
    const int a = lane & 31, hi = lane >> 5;
    const size_t rowbase = (size_t)b * SEQ + t.r;
    { const bf16_t* qp = HB + (rowbase + (size_t)t.dil * (t.i0 + a)) * HP + C_SQ + h * 64 + 8 * hi;
#pragma unroll
      for (int kk = 0; kk < 4; ++kk) qf[kk] = *(const bf16x8*)(qp + 16 * kk); }
#pragma unroll
    for (int j = 0; j < 5; ++j) {
        const int ik0 = t.i0 - 128 + 32 * j + a, ik = ik0 < 0 ? 0 : ik0;
        const bf16_t* kp = HB + (rowbase + (size_t)t.dil * ik) * HP + C_SK + h * 64 + 8 * hi;
#pragma unroll
        for (int kk = 0; kk < 4; ++kk) kf[j][kk] = *(const bf16x8*)(kp + 16 * kk);
    }
}
__device__ __forceinline__ void swa_task(const Params& P, LAS unsigned char* lds, int wave, int lane, int b, int h, const SwaT& tk, int T0,
                                         const bf16x8 (&qf)[4], const bf16x8 (&kf)[5][4], const SwaT& nx, bf16x8 (&qn)[4], bf16x8 (&kn)[5][4], bool bar_before_merge) {
    const bf16_t* HB = (const bf16_t*)(P.ws + WS_HB);
    const int dil = tk.dil, r = tk.r, i0 = tk.i0, pat = tk.pat;
    const int a = lane & 31, hi = lane >> 5;
    LAS unsigned char* vreg = lds + SWA_WV + wave * SWA_WV_STRIDE;
    LAS float* msc = (LAS float*)(vreg + 10240);
    LAS float* lsc = msc + 32;
    const size_t rowbase = (size_t)b * SEQ + r;
    const int jmin = i0 >= 128 ? 0 : ((128 - i0) >> 5);
    const int vrow = ((lane >> 5) << 3) + ((lane >> 2) & 7), vch = lane & 3;
    const int trb = (4 * hi + ((lane & 15) >> 2)) * 64 + ((lane >> 4) & 1) * 32 + (lane & 3) * 8;

#define SWA_DMA_V(db) do { _Pragma("unroll") for (int j = 0; j < 5; ++j) if (j >= jmin) { _Pragma("unroll") for (int it2 = 0; it2 < 2; ++it2) { \
        const int ik = i0 - 128 + 32 * j + 16 * it2 + vrow; \
        __builtin_amdgcn_global_load_lds((const unsigned*)(HB + (rowbase + (size_t)dil * ik) * HP + C_SV + h * 64 + 32 * (db) + 8 * vch), \
                                         (LAS unsigned*)(vreg + j * 2048 + it2 * 1024), 16, 0, 0); } } } while (0)

    LDS_WAIT();
    SWA_DMA_V(0);
    f32x16 S[5];
    float mx4[4] = {-INFINITY, -INFINITY, -INFINITY, -INFINITY};
#pragma unroll
    for (int j = 0; j < 5; ++j) {
        f32x16 acc;
#pragma unroll
        for (int e = 0; e < 16; ++e) acc[e] = 0.f;
#pragma unroll
        for (int kk = 0; kk < 4; ++kk) acc = mfma32(kf[j][kk], qf[kk], acc);
        if (j == 0) {
#pragma unroll
            for (int e = 0; e < 16; ++e) { const int c = (e & 3) + 8 * (e >> 2) + 4 * hi; if (c < a) acc[e] = -INFINITY; }
        }
        if (j == 4) {
#pragma unroll
            for (int e = 0; e < 16; ++e) { const int c = (e & 3) + 8 * (e >> 2) + 4 * hi; if (c > a) acc[e] = -INFINITY; }
        }
        if (j < jmin) {
#pragma unroll
            for (int e = 0; e < 16; ++e) acc[e] = -INFINITY;
        }
#pragma unroll
        for (int e = 0; e < 16; ++e) mx4[e & 3] = fmaxf(mx4[e & 3], acc[e]);
        S[j] = acc;
    }
    asm volatile("" ::: "memory");
    swa_loadqk(P, nx, b, h, lane, qn, kn);
    asm volatile("" ::: "memory");
    float mx = fmaxf(fmaxf(mx4[0], mx4[1]), fmaxf(mx4[2], mx4[3]));
    mx = fmaxf(mx, shx(mx, 32, lane));
    float ls4[4] = {0.f, 0.f, 0.f, 0.f};
    unsigned pa[5][2][4];
#pragma unroll
    for (int j = 0; j < 5; ++j) {
#pragma unroll
        for (int e = 0; e < 16; ++e) { const float p = fexp2(S[j][e] - mx); S[j][e] = p; ls4[e & 3] += p; }
#pragma unroll
        for (int s = 0; s < 2; ++s)
#pragma unroll
            for (int w = 0; w < 4; ++w) pa[j][s][w] = pk_bf16(S[j][8 * s + 2 * w], S[j][8 * s + 2 * w + 1]);
    }
    float lsum = (ls4[0] + ls4[1]) + (ls4[2] + ls4[3]);
    lsum += shx(lsum, 32, lane);
    if (bar_before_merge) __syncthreads();
    LAS float* fsc = msc; LAS float* gsc = msc + 32; LAS float* rsc = msc + 64;
    {
        LAS float* stM = (LAS float*)(lds + SWA_ST_M);
        LAS float* stL = (LAS float*)(lds + SWA_ST_L);
        LDS_WAIT();
        if (hi == 0) {
            const int tok = r + dil * (i0 + a) - T0;
            if (pat == 0) { fsc[a] = 0.f; gsc[a] = 1.f; rsc[a] = 1.f; stM[tok] = mx; stL[tok] = lsum; }
            else {
                const float Mo = stM[tok], Lo = stL[tok];
                const float Mn = fmaxf(Mo, mx);
                const float f = fexp2(Mo - Mn), g = fexp2(mx - Mn);
                const float Ln = Lo * f + lsum * g;
                fsc[a] = f; gsc[a] = g; rsc[a] = 1.0f / Ln;
                if (pat == 1) { stM[tok] = Mn; stL[tok] = Ln; }
            }
        }
        LDS_WAIT();
    }
#pragma unroll
    for (int db = 0; db < 2; ++db) {
        if (db == 0) asm volatile("s_waitcnt vmcnt(24)" ::: "memory"); else VM_WAIT();
        f32x16 O;
#pragma unroll
        for (int e = 0; e < 16; ++e) O[e] = 0.f;
#pragma unroll
        for (int j = 0; j < 5; ++j) if (j >= jmin) {
#pragma unroll
            for (int s = 0; s < 2; ++s) {
                const s16x4 lo = tr16(vreg + j * 2048 + (2 * s) * 512 + trb), hh = tr16(vreg + j * 2048 + (2 * s + 1) * 512 + trb);
                const bf16x8 vb = {lo[0], lo[1], lo[2], lo[3], hh[0], hh[1], hh[2], hh[3]};
                const bf16x8 pf = __builtin_bit_cast(bf16x8, (u32x4){pa[j][s][0], pa[j][s][1], pa[j][s][2], pa[j][s][3]});
                O = mfma32(pf, vb, O);
            }
        }
        if (db == 0) { LDS_WAIT(); SWA_DMA_V(1); }
        LAS bf16_t* stO = (LAS bf16_t*)(lds + SWA_ST_O);
        const int d = 32 * db + a;
#pragma unroll
        for (int g4 = 0; g4 < 4; ++g4) {
            const f32x4 f4 = *(const LAS f32x4*)(fsc + 8 * g4 + 4 * hi), g4v = *(const LAS f32x4*)(gsc + 8 * g4 + 4 * hi), r4 = *(const LAS f32x4*)(rsc + 8 * g4 + 4 * hi);
#pragma unroll
            for (int e4 = 0; e4 < 4; ++e4) {
                const int e = 4 * g4 + e4, c = 8 * g4 + 4 * hi + e4;
                const int tok = r + dil * (i0 + c) - T0;
                if (pat == 0) stO[tok * 64 + d] = (bf16_t)(pk_bf16(O[e], 0.f) & 0xffffu);
                else {
                    const float on = bf2f(stO[tok * 64 + d]) * f4[e4] + O[e] * g4v[e4];
                    stO[tok * 64 + d] = (bf16_t)(pk_bf16(pat == 1 ? on : on * r4[e4], 0.f) & 0xffffu);
                }
            }
        }
    }
#undef SWA_DMA_V
}
__device__ __forceinline__ void swa_unit(const Params& P, LAS unsigned char* lds, int wave, int lane, int b, int h, int chunk) {
    const int T0 = chunk * 512;
    bf16x8 qf[4], kf[5][4];
    SwaT cur = swa_params(0, wave, T0);
    swa_loadqk(P, cur, b, h, lane, qf, kf);
#pragma unroll 1
    for (int i = 0; i < 6; ++i) {
        const SwaT nxt = swa_params(i < 5 ? i + 1 : 5, wave, T0);
        bf16x8 qn[4], kn[5][4];
        swa_task(P, lds, wave, lane, b, h, cur, T0, qf, kf, nxt, qn, kn, i == 2 || i == 4);
#pragma unroll
        for (int kk = 0; kk < 4; ++kk) qf[kk] = qn[kk];
#pragma unroll
        for (int j = 0; j < 5; ++j)
#pragma unroll
            for (int kk = 0; kk < 4; ++kk) kf[j][kk] = kn[j][kk];
        cur = nxt;
    }
    __syncthreads();
    {
        const bf16_t* HB = (const bf16_t*)(P.ws + WS_HB);
        bf16_t* MIX = (bf16_t*)(P.ws + WS_MIX);
        const int tid = wave * 64 + lane, ch = tid & 7;
#pragma unroll
        for (int it = 0; it < 8; ++it) {
            const int tok = (tid >> 3) + 64 * it;
            const size_t row = (size_t)b * SEQ + T0 + tok;
            const u32x4 o = *(const LAS u32x4*)(lds + SWA_ST_O + tok * 128 + ch * 16);
            const u32x4 g = *(const u32x4*)(HB + row * HP + C_SG + h * 64 + ch * 8);
            u32x4 w;
            w.x = pk_bf16(bf_lo(o.x) * bf_lo(g.x), bf_hi(o.x) * bf_hi(g.x)); w.y = pk_bf16(bf_lo(o.y) * bf_lo(g.y), bf_hi(o.y) * bf_hi(g.y));
            w.z = pk_bf16(bf_lo(o.z) * bf_lo(g.z), bf_hi(o.z) * bf_hi(g.z)); w.w = pk_bf16(bf_lo(o.w) * bf_lo(g.w), bf_hi(o.w) * bf_hi(g.w));
            *(u32x4*)(MIX + row * DMIX + 512 + h * 64 + ch * 8) = w;
        }
    }
    __syncthreads();
}

constexpr int MEM_K = 0, MEM_V = 65536, MEM_SC = 131072, MEM_OST = 133120;
__device__ __forceinline__ void mem_unit(const Params& P, LAS unsigned char* lds, int wave, int lane, int b, int h, int qb) {
    const bf16_t* HB = (const bf16_t*)(P.ws + WS_HB);
    const bf16_t* MKV = (const bf16_t*)(P.ws + WS_MKV);
    bf16_t* MIX = (bf16_t*)(P.ws + WS_MIX);
    const int a = lane & 31, hi = lane >> 5;
    __syncthreads();
#pragma unroll
    for (int i = 0; i < 8; ++i) {
        const int pc = wave * 8 + i;
        { const int key = 4 * pc + (lane >> 4), cp = lane & 15;
          __builtin_amdgcn_global_load_lds((const unsigned*)(MKV + ((size_t)b * NMEM + key) * 1024 + h * 128 + 8 * (cp ^ (key & 15))),
                                           (LAS unsigned*)(lds + MEM_K + pc * 1024), 16, 0, 0); }
        { const int key = 8 * (pc >> 1) + ((lane & 31) >> 2), d = 32 * (2 * (pc & 1) + (lane >> 5)) + 8 * (lane & 3);
          __builtin_amdgcn_global_load_lds((const unsigned*)(MKV + ((size_t)b * NMEM + key) * 1024 + 512 + h * 128 + d),
                                           (LAS unsigned*)(lds + MEM_V + pc * 1024), 16, 0, 0); }
    }
    VM_WAIT();
    __syncthreads();
#pragma unroll 1
    for (int q2 = 0; q2 < 2; ++q2) {
    const size_t Rq = (size_t)b * SEQ + (2 * qb + q2) * 256 + wave * 32;
    LAS float* fsc = (LAS float*)(lds + MEM_SC + wave * 256);
    const int trb = (4 * hi + ((lane & 15) >> 2)) * 64 + ((lane >> 4) & 1) * 32 + (lane & 3) * 8;
    f32x16 O[4];
#pragma unroll
    for (int db = 0; db < 4; ++db)
#pragma unroll
        for (int e = 0; e < 16; ++e) O[db][e] = 0.f;
    float M = -INFINITY, L = 0.f;
#pragma unroll 1
    for (int ch = 0; ch < 2; ++ch) {
        bf16x8 qf[8];
        { const bf16_t* qp = HB + (Rq + a) * HP + C_MQ + h * 128 + 8 * hi;
#pragma unroll
          for (int kk = 0; kk < 8; ++kk) qf[kk] = *(const bf16x8*)(qp + 16 * kk); }
        f32x16 S[4];
#pragma unroll
        for (int jt = 0; jt < 4; ++jt) {
            const int key = 32 * (4 * ch + jt) + a;
            f32x16 acc;
#pragma unroll
            for (int e = 0; e < 16; ++e) acc[e] = 0.f;
#pragma unroll
            for (int kk = 0; kk < 8; ++kk) {
                const bf16x8 kf = *(const LAS bf16x8*)(lds + MEM_K + key * 256 + (((2 * kk + hi) ^ (key & 15)) << 4));
                acc = mfma32(kf, qf[kk], acc);
            }
            S[jt] = acc;
        }
        float mc = -INFINITY;
#pragma unroll
        for (int jt = 0; jt < 4; ++jt)
#pragma unroll
            for (int e = 0; e < 16; ++e) mc = fmaxf(mc, S[jt][e]);
        mc = fmaxf(mc, shx(mc, 32, lane));
        const float Mn = fmaxf(M, mc);
        const float f = fexp2(M - Mn);
        float ls = 0.f;
        unsigned pa[4][2][4];
#pragma unroll
        for (int jt = 0; jt < 4; ++jt) {
#pragma unroll
            for (int e = 0; e < 16; ++e) { const float p = fexp2(S[jt][e] - Mn); S[jt][e] = p; ls += p; }
#pragma unroll
            for (int s = 0; s < 2; ++s)
#pragma unroll
                for (int w = 0; w < 4; ++w) pa[jt][s][w] = pk_bf16(S[jt][8 * s + 2 * w], S[jt][8 * s + 2 * w + 1]);
        }
        ls += shx(ls, 32, lane);
        L = L * f + ls; M = Mn;
        if (ch == 1) {
            LDS_WAIT();
            if (hi == 0) fsc[a] = f;
            LDS_WAIT();
#pragma unroll
            for (int g4 = 0; g4 < 4; ++g4) {
                const f32x4 f4 = *(const LAS f32x4*)(fsc + 8 * g4 + 4 * hi);
#pragma unroll
                for (int db = 0; db < 4; ++db)
#pragma unroll
                    for (int e = 0; e < 4; ++e) O[db][4 * g4 + e] *= f4[e];
            }
        }
#pragma unroll
        for (int jt = 0; jt < 4; ++jt)
#pragma unroll
            for (int s = 0; s < 2; ++s) {
                const bf16x8 pf = __builtin_bit_cast(bf16x8, (u32x4){pa[jt][s][0], pa[jt][s][1], pa[jt][s][2], pa[jt][s][3]});
                const int st0 = (4 * (4 * ch + jt) + 2 * s) * 4;
#pragma unroll
                for (int db = 0; db < 4; ++db) {
                    const s16x4 lo = tr16(lds + MEM_V + (st0 + db) * 512 + trb), hh = tr16(lds + MEM_V + (st0 + 4 + db) * 512 + trb);
                    const bf16x8 vb = {lo[0], lo[1], lo[2], lo[3], hh[0], hh[1], hh[2], hh[3]};
                    O[db] = mfma32(pf, vb, O[db]);
                }
            }
    }
    LDS_WAIT();
    if (hi == 0) fsc[32 + a] = 1.0f / L;
    LDS_WAIT();
    {
        LAS bf16_t* ost = (LAS bf16_t*)(lds + MEM_OST + wave * 2048);
        f32x4 r4[4];
#pragma unroll
        for (int g4 = 0; g4 < 4; ++g4) r4[g4] = *(const LAS f32x4*)(fsc + 32 + 8 * g4 + 4 * hi);
#pragma unroll
        for (int db = 0; db < 4; ++db) {
#pragma unroll
            for (int g4 = 0; g4 < 4; ++g4)
#pragma unroll
                for (int e = 0; e < 4; ++e) ost[(8 * g4 + 4 * hi + e) * 32 + a] = (bf16_t)(pk_bf16(O[db][4 * g4 + e] * r4[g4][e], 0.f) & 0xffffu);
            LDS_WAIT();
#pragma unroll
            for (int it = 0; it < 2; ++it) {
                const int q = (lane >> 2) + 16 * it, ch = lane & 3;
                const size_t row = Rq + q;
                const u32x4 o = *(const LAS u32x4*)(ost + q * 32 + ch * 8);
                const u32x4 g = *(const u32x4*)(HB + row * HP + C_MG + h * 128 + 32 * db + ch * 8);
                u32x4 w;
                w.x = pk_bf16(bf_lo(o.x) * bf_lo(g.x), bf_hi(o.x) * bf_hi(g.x)); w.y = pk_bf16(bf_lo(o.y) * bf_lo(g.y), bf_hi(o.y) * bf_hi(g.y));
                w.z = pk_bf16(bf_lo(o.z) * bf_lo(g.z), bf_hi(o.z) * bf_hi(g.z)); w.w = pk_bf16(bf_lo(o.w) * bf_lo(g.w), bf_hi(o.w) * bf_hi(g.w));
                *(u32x4*)(MIX + row * DMIX + 1024 + h * 128 + 32 * db + ch * 8) = w;
            }
            LDS_WAIT();
        }
    }
    }
}

constexpr int RT_Q = 0, RT_K = 16384, RT_KD = 32768, RT_V = 49152, RT_R = 81920, RT_O = 98304;
constexpr size_t WS_KVC = 272 * MiB;
__device__ __forceinline__ void ra_unit(const Params& P, LAS unsigned char* lds, int wave, int lane, int tid, int b, int h, int n) {
    const bf16_t* HB = (const bf16_t*)(P.ws + WS_HB);
    float* KVC = (float*)(P.ws + WS_KVC);
    const float gamma = 1.0f - __builtin_amdgcn_exp2f((float)(-5 - h));
    const float lg2 = __builtin_log2f(gamma);
    const int a = lane & 31, hi = lane >> 5, tq = (lane & 15) >> 2, tp = lane & 3, tg = (lane >> 4) & 1;
    const int dkt = wave & 1, dvt = wave >> 1;
    const size_t base = (size_t)b * SEQ + 128 * n;
    u32x4 pk[2], pv[4];
#pragma unroll
    for (int i = 0; i < 2; ++i) { const int idx = tid + 512 * i, row = idx >> 3, ch = idx & 7; pk[i] = *(const u32x4*)(HB + (base + row) * HP + C_RK + h * 64 + ch * 8); }
#pragma unroll
    for (int i = 0; i < 4; ++i) { const int idx = tid + 512 * i, row = idx >> 4, ch = idx & 15; pv[i] = *(const u32x4*)(HB + (base + row) * HP + C_RV + h * 128 + ch * 8); }
    __syncthreads();
#pragma unroll
    for (int i = 0; i < 2; ++i) {
        const int idx = tid + 512 * i, row = idx >> 3, ch = idx & 7;
        const float fac = fexp2((float)(127 - row) * lg2);
        u32x4 kd;
        kd.x = pk_bf16(bf_lo(pk[i].x) * fac, bf_hi(pk[i].x) * fac); kd.y = pk_bf16(bf_lo(pk[i].y) * fac, bf_hi(pk[i].y) * fac);
        kd.z = pk_bf16(bf_lo(pk[i].z) * fac, bf_hi(pk[i].z) * fac); kd.w = pk_bf16(bf_lo(pk[i].w) * fac, bf_hi(pk[i].w) * fac);
        *(LAS u32x4*)(lds + RT_KD + ((row >> 3) * 2 + (ch >> 2)) * 512 + (row & 7) * 64 + (ch & 3) * 16) = kd;
    }
#pragma unroll
    for (int i = 0; i < 4; ++i) {
        const int idx = tid + 512 * i, row = idx >> 4, ch = idx & 15;
        *(LAS u32x4*)(lds + RT_V + ((row >> 3) * 4 + (ch >> 2)) * 512 + (row & 7) * 64 + (ch & 3) * 16) = pv[i];
    }
    __syncthreads();
    f32x16 Rt;
#pragma unroll
    for (int e = 0; e < 16; ++e) Rt[e] = 0.f;
#pragma unroll
    for (int s = 0; s < 8; ++s) {
        LAS unsigned char* ka = lds + RT_KD + ((2 * s + hi) * 2 + dkt) * 512 + tq * 64 + tg * 32 + tp * 8;
        LAS unsigned char* va = lds + RT_V + ((2 * s + hi) * 4 + dvt) * 512 + tq * 64 + tg * 32 + tp * 8;
        const s16x4 k0 = tr16(ka), k1 = tr16(ka + 256), v0 = tr16(va), v1 = tr16(va + 256);
        const bf16x8 af = {k0[0], k0[1], k0[2], k0[3], k1[0], k1[1], k1[2], k1[3]};
        const bf16x8 bfv = {v0[0], v0[1], v0[2], v0[3], v1[0], v1[1], v1[2], v1[3]};
        Rt = mfma32(af, bfv, Rt);
    }
    float* dst = KVC + ((size_t)((b * 4 + h) * 16 + n)) * 8192 + 32 * dvt + a;
#pragma unroll
    for (int e = 0; e < 16; ++e) dst[(32 * dkt + (e & 3) + 8 * (e >> 2) + 4 * hi) * 128] = Rt[e];
}
__device__ __forceinline__ void rb_unit(const Params& P, LAS unsigned char* lds, int wave, int lane, int tid, int b, int h, int n) {
    const bf16_t* HB = (const bf16_t*)(P.ws + WS_HB);
    bf16_t* MIX = (bf16_t*)(P.ws + WS_MIX);
    const float* KVC = (const float*)(P.ws + WS_KVC) + ((size_t)((b * 4 + h) * 16)) * 8192;
    const float gamma = 1.0f - __builtin_amdgcn_exp2f((float)(-5 - h));
    const float lg2 = __builtin_log2f(gamma);
    const int a = lane & 31, hi = lane >> 5, tq = (lane & 15) >> 2, tp = lane & 3, tg = (lane >> 4) & 1;
    const int qg = wave & 3, dh = wave >> 2;
    const size_t base = (size_t)b * SEQ + 128 * n;
    u32x4 pq[2], pk[2], pv[4];
#pragma unroll
    for (int i = 0; i < 2; ++i) { const int idx = tid + 512 * i, row = idx >> 3, ch = idx & 7;
        pq[i] = *(const u32x4*)(HB + (base + row) * HP + C_RQ + h * 64 + ch * 8); pk[i] = *(const u32x4*)(HB + (base + row) * HP + C_RK + h * 64 + ch * 8); }
#pragma unroll
    for (int i = 0; i < 4; ++i) { const int idx = tid + 512 * i, row = idx >> 4, ch = idx & 15; pv[i] = *(const u32x4*)(HB + (base + row) * HP + C_RV + h * 128 + ch * 8); }
    const float g128 = fexp2(128.0f * lg2);
    f32x4 rr[4];
#pragma unroll
    for (int i = 0; i < 4; ++i) rr[i] = (f32x4){0.f, 0.f, 0.f, 0.f};
    const int dv4 = 4 * (tid & 31), dkb = tid >> 5;
    {
        const int nb4 = (n + 3) >> 2, c00 = n - 4 * nb4;
#pragma unroll 1
        for (int bq = 0; bq < nb4; ++bq) {
            f32x4 t[4][4];
#pragma unroll
            for (int k = 0; k < 4; ++k) {
                const int c = c00 + 4 * bq + k, cc = c < 0 ? 0 : c;
                const float* src = KVC + (size_t)cc * 8192 + dkb * 128 + dv4;
#pragma unroll
                for (int i = 0; i < 4; ++i) t[k][i] = *(const f32x4*)(src + 16 * i * 128);
            }
#pragma unroll
            for (int k = 0; k < 4; ++k) {
                const float wgt = (c00 + 4 * bq + k) < 0 ? 0.f : 1.f;
#pragma unroll
                for (int i = 0; i < 4; ++i) rr[i] = rr[i] * g128 + t[k][i] * wgt;
            }
        }
    }
    if (n == 15) {
        const float* src = KVC + (size_t)15 * 8192 + dkb * 128 + dv4;
#pragma unroll
        for (int i = 0; i < 4; ++i) {
            const f32x4 t = *(const f32x4*)(src + 16 * i * 128);
            *(f32x4*)(P.out + O_RP + ((size_t)((b * 4 + h) * 64 + dmap(dkb + 16 * i))) * 128 + dv4) = rr[i] * g128 + t;
        }
    }
    __syncthreads();
#pragma unroll
    for (int i = 0; i < 4; ++i) {
        const int dk = dkb + 16 * i;
#pragma unroll
        for (int e = 0; e < 4; ++e) { const int dv = dv4 + e; *(LAS bf16_t*)(lds + RT_R + dv * 128 + (((dk >> 3) ^ (dv & 7)) << 4) + (dk & 7) * 2) = (bf16_t)(pk_bf16(rr[i][e], 0.f) & 0xffffu); }
    }
#pragma unroll
    for (int i = 0; i < 2; ++i) {
        const int idx = tid + 512 * i, row = idx >> 3, ch = idx & 7;
        *(LAS u32x4*)(lds + RT_Q + row * 128 + ((ch ^ (row & 7)) << 4)) = pq[i];
        *(LAS u32x4*)(lds + RT_K + row * 128 + ((ch ^ (row & 7)) << 4)) = pk[i];
    }
#pragma unroll
    for (int i = 0; i < 4; ++i) {
        const int idx = tid + 512 * i, row = idx >> 4, ch = idx & 15;
        *(LAS u32x4*)(lds + RT_V + ((row >> 3) * 4 + (ch >> 2)) * 512 + (row & 7) * 64 + (ch & 3) * 16) = pv[i];
    }
    __syncthreads();
    f32x16 O[2];
    bf16x8 qfr[4];
#pragma unroll
    for (int kk = 0; kk < 4; ++kk) { const int row = 32 * qg + a; qfr[kk] = *(const LAS bf16x8*)(lds + RT_Q + row * 128 + (((2 * kk + hi) ^ (row & 7)) << 4)); }
    if (n > 0) {
#pragma unroll
        for (int dt = 0; dt < 2; ++dt) {
            f32x16 X;
#pragma unroll
            for (int e = 0; e < 16; ++e) X[e] = 0.f;
            const int dv = 32 * (2 * dh + dt) + a;
#pragma unroll
            for (int kk = 0; kk < 4; ++kk) {
                const bf16x8 rf = *(const LAS bf16x8*)(lds + RT_R + dv * 128 + (((2 * kk + hi) ^ (dv & 7)) << 4));
                X = mfma32(qfr[kk], rf, X);
            }
#pragma unroll
            for (int e = 0; e < 16; ++e) { const int c = (e & 3) + 8 * (e >> 2) + 4 * hi; O[dt][e] = X[e] * fexp2((float)(32 * qg + c + 1) * lg2); }
        }
    } else {
#pragma unroll
        for (int dt = 0; dt < 2; ++dt)
#pragma unroll
            for (int e = 0; e < 16; ++e) O[dt][e] = 0.f;
    }
#pragma unroll
    for (int j = 0; j < 4; ++j) if (j <= qg) {
        f32x16 S;
#pragma unroll
        for (int e = 0; e < 16; ++e) S[e] = 0.f;
#pragma unroll
        for (int kk = 0; kk < 4; ++kk) {
            const int row = 32 * j + a;
            const bf16x8 kf = *(const LAS bf16x8*)(lds + RT_K + row * 128 + (((2 * kk + hi) ^ (row & 7)) << 4));
            S = mfma32(kf, qfr[kk], S);
        }
        unsigned pa[2][4];
#pragma unroll
        for (int e = 0; e < 16; ++e) {
            const int c = (e & 3) + 8 * (e >> 2) + 4 * hi;
            const int diff = 32 * (qg - j) + a - c;
            S[e] = diff >= 0 ? S[e] * fexp2((float)diff * lg2) : 0.f;
        }
#pragma unroll
        for (int s = 0; s < 2; ++s)
#pragma unroll
            for (int w = 0; w < 4; ++w) pa[s][w] = pk_bf16(S[8 * s + 2 * w], S[8 * s + 2 * w + 1]);
#pragma unroll
        for (int s = 0; s < 2; ++s) {
            const bf16x8 pf = __builtin_bit_cast(bf16x8, (u32x4){pa[s][0], pa[s][1], pa[s][2], pa[s][3]});
#pragma unroll
            for (int dt = 0; dt < 2; ++dt) {
                LAS unsigned char* vb_ = lds + RT_V + ((4 * j + 2 * s) * 4 + (2 * dh + dt)) * 512 + (4 * hi + tq) * 64 + tg * 32 + tp * 8;
                const s16x4 lo = tr16(vb_), hh = tr16(vb_ + 4 * 512);
                const bf16x8 vb = {lo[0], lo[1], lo[2], lo[3], hh[0], hh[1], hh[2], hh[3]};
                O[dt] = mfma32(pf, vb, O[dt]);
            }
        }
    }
    {
        LAS bf16_t* Ob = (LAS bf16_t*)(lds + RT_O);
#pragma unroll
        for (int dt = 0; dt < 2; ++dt)
#pragma unroll
            for (int e = 0; e < 16; ++e) { const int c = (e & 3) + 8 * (e >> 2) + 4 * hi; Ob[(32 * qg + c) * 128 + 32 * (2 * dh + dt) + a] = (bf16_t)(pk_bf16(O[dt][e], 0.f) & 0xffffu); }
    }
    __syncthreads();
    {
        const int tok = tid >> 2, part = tid & 3;
        const LAS u32x4* op = (const LAS u32x4*)(lds + RT_O + tok * 256 + part * 64);
        float o[32]; float sm = 0.f;
#pragma unroll
        for (int c4 = 0; c4 < 4; ++c4) {
            const u32x4 w = op[c4];
            o[8 * c4 + 0] = bf_lo(w.x); o[8 * c4 + 1] = bf_hi(w.x); o[8 * c4 + 2] = bf_lo(w.y); o[8 * c4 + 3] = bf_hi(w.y);
            o[8 * c4 + 4] = bf_lo(w.z); o[8 * c4 + 5] = bf_hi(w.z); o[8 * c4 + 6] = bf_lo(w.w); o[8 * c4 + 7] = bf_hi(w.w);
        }
#pragma unroll
        for (int e = 0; e < 32; ++e) sm += o[e];
        sm += shx(sm, 1, lane); sm += shx(sm, 2, lane);
        const float mean = sm * (1.0f / 128.0f);
        float qq = 0.f;
#pragma unroll
        for (int e = 0; e < 32; ++e) { o[e] -= mean; qq += o[e] * o[e]; }
        qq += shx(qq, 1, lane); qq += shx(qq, 2, lane);
        const float rstd = 1.0f / sqrtf(qq * (1.0f / 128.0f) + 1e-5f);
        const size_t row = base + tok;
        const u32x4* gp = (const u32x4*)(HB + row * HP + C_RG + h * 128 + part * 32);
        u32x4* mp = (u32x4*)(MIX + row * DMIX + h * 128 + part * 32);
#pragma unroll
        for (int c4 = 0; c4 < 4; ++c4) {
            const u32x4 g = gp[c4]; u32x4 w;
            w.x = pk_bf16(o[8 * c4 + 0] * rstd * bf_lo(g.x), o[8 * c4 + 1] * rstd * bf_hi(g.x)); w.y = pk_bf16(o[8 * c4 + 2] * rstd * bf_lo(g.y), o[8 * c4 + 3] * rstd * bf_hi(g.y));
            w.z = pk_bf16(o[8 * c4 + 4] * rstd * bf_lo(g.z), o[8 * c4 + 5] * rstd * bf_hi(g.z)); w.w = pk_bf16(o[8 * c4 + 6] * rstd * bf_lo(g.w), o[8 * c4 + 7] * rstd * bf_hi(g.w));
            mp[c4] = w;
        }
    }
}

#define XB_TMO      128
#define XB_XCNT(j)  (256  + 64 * (j))
#define XB_XSUB(j)  (1280 + 64 * (j))
#define XB_XGEN(j)  (2304 + 64 * (j))
#define XB_TOP      3328
#define XB_TOPGEN   3392
#define XCD_BAR_WORDS 3456
#define XB_SPIN_CAP (1u << 18)

__device__ __forceinline__ unsigned xb_ld(unsigned* p)              { return __hip_atomic_load(p, __ATOMIC_RELAXED, __HIP_MEMORY_SCOPE_AGENT); }
__device__ __forceinline__ unsigned xb_add(unsigned* p, unsigned v) { return __hip_atomic_fetch_add(p, v, __ATOMIC_RELAXED, __HIP_MEMORY_SCOPE_AGENT); }
__device__ __forceinline__ unsigned xb_xcc_id() { return (unsigned)__builtin_amdgcn_s_getreg((3 << 11) | 20) & 0xFu; }
#define XB_SPIN(cond, bar) do { unsigned _sp = 0; while (cond) { __builtin_amdgcn_s_sleep(1); \
    if ((++_sp & 255u) == 0u) { if (xb_ld(&(bar)[XB_TMO])) break; if (_sp > XB_SPIN_CAP) { atomicAdd(&(bar)[XB_TMO], 1u); break; } } } } while (0)

struct XcdBarrier {
    unsigned* bar; unsigned x;
    volatile LAS unsigned* st;
};

__device__ __forceinline__ XcdBarrier xcd_barrier_post(unsigned* bar, volatile LAS unsigned* st, bool leader) {
    XcdBarrier b; b.bar = bar; b.x = xb_xcc_id(); b.st = st;
    if (leader) (void)xb_add(&bar[XB_XCNT(b.x)], 1u);
    return b;
}
__device__ __forceinline__ void xcd_barrier_complete(unsigned* bar, unsigned x, unsigned& nloc, unsigned& nx) {
    const unsigned G = gridDim.x * gridDim.y * gridDim.z;
    unsigned sum, cnt, mine, sp = 0u;
    for (;;) {
        sum = 0u; cnt = 0u; mine = 0u;
#pragma unroll
        for (unsigned j = 0; j < 16; ++j) { const unsigned c = xb_ld(&bar[XB_XCNT(j)]); sum += c; cnt += (c > 0u) ? 1u : 0u; mine = (j == x) ? c : mine; }
        if (sum == G) break;
        __builtin_amdgcn_s_sleep(1);
        if ((++sp & 255u) == 0u) { if (xb_ld(&bar[XB_TMO])) break; if (sp > XB_SPIN_CAP) { atomicAdd(&bar[XB_TMO], 1u); break; } }
    }
    nloc = mine > 0u ? mine : 1u; nx = cnt > 0u ? cnt : 1u;
}

__device__ __forceinline__ void xcd_barrier(const XcdBarrier& b, bool leader) {
    asm volatile("s_waitcnt vmcnt(0)" ::: "memory");
    __syncthreads();
    if (leader) {
        unsigned* bar = b.bar;
        __builtin_amdgcn_s_waitcnt(0);
        unsigned nloc = b.st[0], nx = b.st[1];
        if (nloc == 0u) { xcd_barrier_complete(bar, b.x, nloc, nx); b.st[0] = nloc; b.st[1] = nx; }
        const unsigned old = xb_add(&bar[XB_XSUB(b.x)], 1u);
        const unsigned gen = old / nloc;
        if (old + 1u == (gen + 1u) * nloc) {
            __builtin_amdgcn_fence(__ATOMIC_RELEASE, "agent");
            asm volatile("s_waitcnt vmcnt(0)" ::: "memory");
            const unsigned og = xb_add(&bar[XB_TOP], 1u);
            const unsigned tg = og / nx;
            if (og + 1u == (tg + 1u) * nx) xb_add(&bar[XB_TOPGEN], 1u);
            else XB_SPIN(xb_ld(&bar[XB_TOPGEN]) == tg, bar);
            __builtin_amdgcn_fence(__ATOMIC_ACQUIRE, "agent");
            xb_add(&bar[XB_XGEN(b.x)], 1u);
            asm volatile("s_waitcnt vmcnt(0)" ::: "memory");
        } else {
            XB_SPIN(xb_ld(&bar[XB_XGEN(b.x)]) == gen, bar);
            __builtin_amdgcn_fence(__ATOMIC_ACQUIRE, "agent");
            asm volatile("s_waitcnt vmcnt(0)" ::: "memory");
        }
    }
    __syncthreads();
}

constexpr int P3_A = 131072, P3_RED = 143360;
__device__ __forceinline__ int hswz(int x) { return (0x78 >> (2 * x)) & 3; }
__device__ __forceinline__ void p3_unit(const Params& P, LAS unsigned char* lds, int wave, int lane, int u) {
    const bf16_t* MIX = (const bf16_t*)(P.ws + WS_MIX);
    const bf16_t* WT = (const bf16_t*)(P.ws + WS_WTOUT);
    const int fr = lane & 15, fq = lane >> 4;
    const size_t row0 = (size_t)64 * u;
    const int rl = lane >> 2, chs = (lane & 3) ^ hswz((rl >> 2) & 3);
    const bf16_t* bsrc = WT + (size_t)(128 * wave + rl) * DMIX + 8 * chs;
    const bf16_t* asrc = MIX + (row0 + 16 * (wave & 3) + rl) * DMIX + 8 * chs;
    LAS unsigned char* bdst = lds + wave * 16384;
    LAS unsigned char* adst = lds + P3_A + (wave & 3) * 1024;
    const int offl = fr * 64 + ((fq ^ hswz((fr >> 2) & 3)) << 4);
    f32x4 acc[4][8];
#pragma unroll
    for (int m = 0; m < 4; ++m)
#pragma unroll
        for (int n = 0; n < 8; ++n) acc[m][n] = (f32x4){0.f, 0.f, 0.f, 0.f};
#define P3_ISSUE(s_, bb_, ab_) do { _Pragma("unroll") for (int i = 0; i < 8; ++i) \
        __builtin_amdgcn_global_load_lds((const unsigned*)(bsrc + (size_t)16 * i * DMIX + 32 * (s_)), (LAS unsigned*)(bdst + (bb_) * 8192 + i * 1024), 16, 0, 0); \
        if (wave < 4) __builtin_amdgcn_global_load_lds((const unsigned*)(asrc + 32 * (s_)), (LAS unsigned*)(adst + (ab_) * 4096), 16, 0, 0); } while (0)
    __builtin_amdgcn_s_barrier();
    P3_ISSUE(0, 0, 0);
    int ab = 0;
#pragma unroll 1
    for (int s = 0; s < 48; ++s) {
        const int bb = s & 1, abn = (ab == 2) ? 0 : ab + 1;
        asm volatile("s_waitcnt lgkmcnt(0)" ::: "memory");
        if (s + 1 < 48) {
            P3_ISSUE(s + 1, bb ^ 1, abn);
            if (wave < 4) asm volatile("s_waitcnt vmcnt(9)" ::: "memory"); else asm volatile("s_waitcnt vmcnt(8)" ::: "memory");
        } else asm volatile("s_waitcnt vmcnt(0)" ::: "memory");
        __builtin_amdgcn_s_barrier();
        asm volatile("" ::: "memory");
        bf16x8 Af[4], Bf[8];
#pragma unroll
        for (int m = 0; m < 4; ++m) Af[m] = *(const LAS bf16x8*)(lds + P3_A + ab * 4096 + m * 1024 + offl);
#pragma unroll
        for (int n = 0; n < 8; ++n) Bf[n] = *(const LAS bf16x8*)(bdst + bb * 8192 + n * 1024 + offl);
#pragma unroll
        for (int m = 0; m < 4; ++m)
#pragma unroll
            for (int n = 0; n < 8; ++n) acc[m][n] = __builtin_amdgcn_mfma_f32_16x16x32_bf16(Bf[n], Af[m], acc[m][n], 0, 0, 0);
        ab = abn;
    }
#undef P3_ISSUE
    const float* xb = P.x_prompt + row0 * DM + 128 * wave + 4 * fq;
    float* yb = P.out + O_YP + row0 * DM + 128 * wave + 4 * fq;
    LAS float* red = (LAS float*)(lds + P3_RED);
    float mean[4], rstd[4];
#pragma unroll
    for (int m = 0; m < 4; ++m) {
        f32x4 xv[8];
#pragma unroll
        for (int n = 0; n < 8; ++n) xv[n] = *(const f32x4*)(xb + (size_t)(16 * m + fr) * DM + 16 * n);
        float s = 0.f;
#pragma unroll
        for (int n = 0; n < 8; ++n) { acc[m][n] = acc[m][n] + xv[n] * ALPHA; s += (acc[m][n][0] + acc[m][n][1]) + (acc[m][n][2] + acc[m][n][3]); }
        s += shx(s, 16, lane); s += shx(s, 32, lane);
        if (fq == 0) red[(16 * m + fr) * 8 + wave] = s;
    }
    asm volatile("s_waitcnt lgkmcnt(0)" ::: "memory"); __builtin_amdgcn_s_barrier(); asm volatile("" ::: "memory");
#pragma unroll
    for (int m = 0; m < 4; ++m) {
        const f32x4 r0 = *(const LAS f32x4*)(red + (16 * m + fr) * 8), r1 = *(const LAS f32x4*)(red + (16 * m + fr) * 8 + 4);
        mean[m] = ((r0[0] + r0[1]) + (r0[2] + r0[3]) + (r1[0] + r1[1]) + (r1[2] + r1[3])) * (1.0f / DM);
    }
    asm volatile("s_waitcnt lgkmcnt(0)" ::: "memory"); __builtin_amdgcn_s_barrier(); asm volatile("" ::: "memory");
#pragma unroll
    for (int m = 0; m < 4; ++m) {
        float q = 0.f;
#pragma unroll
        for (int n = 0; n < 8; ++n) { acc[m][n] = acc[m][n] - mean[m]; q += (acc[m][n][0] * acc[m][n][0] + acc[m][n][1] * acc[m][n][1]) + (acc[m][n][2] * acc[m][n][2] + acc[m][n][3] * acc[m][n][3]); }
        q += shx(q, 16, lane); q += shx(q, 32, lane);
        if (fq == 0) red[(16 * m + fr) * 8 + wave] = q;
    }
    asm volatile("s_waitcnt lgkmcnt(0)" ::: "memory"); __builtin_amdgcn_s_barrier(); asm volatile("" ::: "memory");
#pragma unroll
    for (int m = 0; m < 4; ++m) {
        const f32x4 r0 = *(const LAS f32x4*)(red + (16 * m + fr) * 8), r1 = *(const LAS f32x4*)(red + (16 * m + fr) * 8 + 4);
        rstd[m] = 1.0f / sqrtf(((r0[0] + r0[1]) + (r0[2] + r0[3]) + (r1[0] + r1[1]) + (r1[2] + r1[3])) * (1.0f / DM) + 1e-5f);
    }
#pragma unroll
    for (int n = 0; n < 8; ++n) {
        const f32x4 g4 = *(const f32x4*)(P.ln_g + 128 * wave + 16 * n + 4 * fq), b4 = *(const f32x4*)(P.ln_b + 128 * wave + 16 * n + 4 * fq);
#pragma unroll
        for (int m = 0; m < 4; ++m) *(f32x4*)(yb + (size_t)(16 * m + fr) * DM + 16 * n) = acc[m][n] * rstd[m] * g4 + b4;
    }
    asm volatile("s_waitcnt lgkmcnt(0)" ::: "memory"); __builtin_amdgcn_s_barrier(); asm volatile("" ::: "memory");
}
__device__ __forceinline__ void p3_sample_slice(const Params& P, int wave, int lane, int sl) {
    const bf16_t* MIX = (const bf16_t*)(P.ws + WS_MIX);
    const bf16_t* WT = (const bf16_t*)(P.ws + WS_WTOUT);
    const int fr = lane & 15, fq = lane >> 4;
    const bf16_t* ap = MIX + ((size_t)M_PROMPT + 16 * wave + fr) * DMIX + 8 * fq;
    const bf16_t* bp = WT + (size_t)(16 * sl + fr) * DMIX + 8 * fq;
    f32x4 acc = {0.f, 0.f, 0.f, 0.f};
#pragma unroll 8
    for (int s = 0; s < 48; ++s) acc = __builtin_amdgcn_mfma_f32_16x16x32_bf16(*(const bf16x8*)(bp + 32 * s), *(const bf16x8*)(ap + 32 * s), acc, 0, 0, 0);
    const size_t r = (size_t)M_PROMPT + 16 * wave + fr; const int c = 16 * sl + 4 * fq;
    const u32x2 xv = *(const u32x2*)((const bf16_t*)(P.ws + WS_XB) + r * DM + c);
    u32x2 w; w.x = pk_bf16(bf_lo(xv.x) * ALPHA + acc[0], bf_hi(xv.x) * ALPHA + acc[1]); w.y = pk_bf16(bf_lo(xv.y) * ALPHA + acc[2], bf_hi(xv.y) * ALPHA + acc[3]);
    *(u32x2*)((bf16_t*)(P.ws + WS_Z) + r * DM + c) = w;
}

struct P1Order {
    int G, c;
    __device__ __forceinline__ bool next(int i, pg8::Unit& u) const {
        const int L = i * G + c;
        if (L >= 1202) return false;
        if (L < 1170) {
            constexpr int nM = 65, nN = 18, nwg = 1170, q = nwg / 8, r = nwg % 8, WGM = 8;
            const int xcd = L % 8, off = L / 8;
            const int wgid = (xcd < r ? xcd * (q + 1) : r * (q + 1) + (xcd - r) * q) + off;
            const int nig = WGM * nN, gid = wgid / nig, fm = gid * WGM, gsz = (nM - fm) < WGM ? (nM - fm) : WGM;
            u.pm = fm + ((wgid % nig) % gsz); u.pn = (wgid % nig) / gsz;
        } else { const int v = L - 1170; u.pm = 65 + (v >> 2); u.pn = 18 + (v & 3); }
        return true;
    }
    __device__ __forceinline__ void a_ready(const pg8::Unit&) const {}
    __device__ __forceinline__ void done(const pg8::Unit&) const {}
};
struct P1Epi {
    static constexpr bool PERM = false, AFTER_DRAIN = false;
    Params P;
    __device__ __forceinline__ void operator()(const f32x4 (&acc)[2][2][4][2], const pg8::Unit& u, int wr, int wc, int fr, int fq) const {
        if (u.pm < 65) epi_inproj(acc, u.pm, u.pn, P, wr, wc, fr, fq);
        else epi_memkv(acc, u.pm - 65, u.pn - 18, P, wr, wc, fr, fq);
    }
};
struct P3Order {
    int G, c;
    __device__ __forceinline__ bool next(int i, pg8::Unit& u) const { const int L = i * G + c; if (L >= 256) return false; u.pm = L >> 2; u.pn = L & 3; return true; }
    __device__ __forceinline__ void a_ready(const pg8::Unit&) const {}
    __device__ __forceinline__ void done(const pg8::Unit&) const {}
};
struct P3Epi {
    static constexpr bool PERM = false, AFTER_DRAIN = false;
    Params P;
    __device__ __forceinline__ void operator()(const f32x4 (&acc)[2][2][4][2], const pg8::Unit& u, int wr, int wc, int fr, int fq) const { epi_outproj(acc, u.pm, u.pn, P, wr, wc, fr, fq); }
};

constexpr int PRM_OFF = LDS_BYTES - 16 - 128;
__device__ __forceinline__ const void* ld_ptr(LAS unsigned char* lds, int i) {
    volatile LAS unsigned* w = (volatile LAS unsigned*)(lds + PRM_OFF);
    const unsigned lo = (unsigned)__builtin_amdgcn_readfirstlane((int)w[2 * i]), hi = (unsigned)__builtin_amdgcn_readfirstlane((int)w[2 * i + 1]);
    return (const void*)(__attribute__((address_space(1))) const void*)(((unsigned long long)hi << 32) | lo);
}
__device__ __forceinline__ Params load_params(LAS unsigned char* lds) {
    Params P;
    P.x_prompt = (const float*)ld_ptr(lds, 0); P.x_sample = (const float*)ld_ptr(lds, 1); P.state_ret = (const float*)ld_ptr(lds, 2);
    P.cache_k = (const float*)ld_ptr(lds, 3); P.cache_v = (const float*)ld_ptr(lds, 4); P.cmem_k = (const float*)ld_ptr(lds, 5);
    P.cmem_v = (const float*)ld_ptr(lds, 6); P.mem_prompt = (const float*)ld_ptr(lds, 7); P.w_in = (const float*)ld_ptr(lds, 8);
    P.w_mkv = (const float*)ld_ptr(lds, 9); P.w_out = (const float*)ld_ptr(lds, 10); P.ln_g = (const float*)ld_ptr(lds, 11);
    P.ln_b = (const float*)ld_ptr(lds, 12); P.out = (float*)ld_ptr(lds, 13); P.ws = (unsigned char*)ld_ptr(lds, 14);
    return P;
}

#ifndef PROBE
#define PROBE 0
#endif
#ifndef DIAG
#define DIAG 0
#endif
#if DIAG
#define STAMP(k) do { if (blockIdx.x == 0 && TID() == 0) ((LAS unsigned long long*)(lds + LDS_BYTES - 256))[k] = __builtin_amdgcn_s_memrealtime(); } while (0)
#else
#define STAMP(k) do {} while (0)
#endif
__global__ void __launch_bounds__(512, 2) fwd_kernel(Params Pk) {
    extern __shared__ __attribute__((aligned(16))) unsigned char lds_raw[];
    LAS unsigned char* lds = (LAS unsigned char*)lds_raw;
    const int wave = __builtin_amdgcn_readfirstlane((int)(threadIdx.x >> 6));
#define TID() (wave * 64 + lane_id())
    const int tid = TID(), lane = tid & 63;
    const int wr = wave >> 2, wc = wave & 3, fr = lane & 15, fq = lane >> 4;
    const int G = gridDim.x;
    if (tid < 4) ((LAS unsigned*)(lds + LDS_BYTES - 16))[tid] = 0u;
    if (tid >= 64 && tid < 94) ((LAS unsigned*)(lds + PRM_OFF))[tid - 64] = ((const unsigned*)__builtin_amdgcn_kernarg_segment_ptr())[tid - 64];
    __syncthreads();
    (void)xcd_barrier_post((unsigned*)((unsigned char*)ld_ptr(lds, 14) + WS_CTL) + 4096, (volatile LAS unsigned*)(lds + LDS_BYTES - 16), TID() == 0);
#define GRID_BAR() do { XcdBarrier bb_; bb_.bar = (unsigned*)((unsigned char*)ld_ptr(lds, 14) + WS_CTL) + 4096; bb_.x = xb_xcc_id(); \
        bb_.st = (volatile LAS unsigned*)(lds + LDS_BYTES - 16); xcd_barrier(bb_, TID() == 0); } while (0)

    STAMP(0);
    for (int rep0 = 0; rep0 < (PROBE == 10 ? 2 : 1); ++rep0) { const Params P = load_params(lds); phase0(P, lds, tid, lane, wave); }
    GRID_BAR();
    STAMP(1);

    {
        const Params P = load_params(lds);
        const pg8::Gemm g{(const bf16_t*)(P.ws + WS_XB), (const bf16_t*)(P.ws + WS_WTIN), ROWS_ALL, DIN + 1024, DM};
        const P1Order S{G, (int)blockIdx.x};
        const P1Epi E{P};
        for (int rep = 0; rep < (PROBE == 1 ? 2 : 1); ++rep)
        pg8::gemm_phase<P1Epi, P1Order, true, true>(lds, g, S, E, TID());
    }
    GRID_BAR();
    STAMP(2);

    {
        const Params P = load_params(lds);
        unsigned* ctl = (unsigned*)(P.ws + WS_CTL);
        int tid2_ = TID(); asm volatile("" : "+v"(tid2_));
        const int tid = tid2_, lane = tid2_ & 63;
        {
        for (int u = blockIdx.x; u < 512; u += G) { int tid_ = TID(); asm volatile("" : "+v"(tid_)); ra_unit(P, lds, wave, tid_ & 63, tid_, u >> 6, (u >> 4) & 3, u & 15); }
        GRID_BAR();
        LAS unsigned* qw = (LAS unsigned*)(lds + LDS_BYTES - 160);
        const int myx = (int)(xb_xcc_id() & 7u);
        for (int k = 0; k < 8; ++k) {
            const int x = (myx + k) & 7;
            for (;;) {
                __syncthreads();
                if (TID() == 0) *qw = atomicAdd(ctl + 128 + 64 * x, 1u);
                __syncthreads();
                const int q = (int)*qw;
                if (q >= 176) break;
                int tid_ = TID(); asm volatile("" : "+v"(tid_));
                const int lane_ = tid_ & 63;
                if (q < 32) swa_sample_unit(P, lds, tid_, wave, q, x);
                else if (q < 48) { const int v = q - 32, bh = 8 * v + x; mem_sample_unit(P, lds, tid_, wave, bh >> 2, bh & 3); }
                else if (q < 64) { const int v = q - 48, bh = 8 * v + x; ret_scan(P, lds, bh >> 2, bh & 3, M_PROMPT + (bh >> 2) * 4, 4, P.state_ret, P.out + O_RS, tid_); }
                else if (q < 96) { const int v = q - 64; swa_unit(P, lds, wave, lane_, v >> 2, x, v & 3); }
                else if (q < 112) { const int v = q - 96, bh = 8 * (v >> 2) + x; mem_unit(P, lds, wave, lane_, bh >> 2, bh & 3, v & 3); }
                else { const int v = q - 112, bh = 8 * (v >> 4) + x; rb_unit(P, lds, wave, lane_, tid_, bh >> 2, bh & 3, v & 15); }
            }
        }
        }
    }
    GRID_BAR();
    STAMP(3);

    {
        const Params P = load_params(lds);
        const pg8::Gemm g{(const bf16_t*)(P.ws + WS_MIX), (const bf16_t*)(P.ws + WS_WTOUT), M_PROMPT, DM, DMIX};
        const P3Order S{G, (int)blockIdx.x};
        const P3Epi E{P};
        pg8::gemm_phase<P3Epi, P3Order, true, true>(lds, g, S, E, TID());
        { int t3_ = TID(); asm volatile("" : "+v"(t3_)); for (int sl = blockIdx.x; sl < 64; sl += G) p3_sample_slice(P, wave, t3_ & 63, sl); }
    }
    GRID_BAR();
    STAMP(4);

    {
        const Params P = load_params(lds);
        const bf16_t* Z = (const bf16_t*)(P.ws + WS_Z);
        int t4_ = TID(); asm volatile("" : "+v"(t4_));
        const int lane = t4_ & 63;
        const int gw = blockIdx.x * 8 + wave, NGW = G * 8;
        for (int r = gw; r < M_PROMPT + M_SAMPLE; r += NGW) {
            float* yr = r < M_PROMPT ? P.out + O_YP + (size_t)r * DM : P.out + O_YS + (size_t)(r - M_PROMPT) * DM;
            f32x4 v[4]; float s = 0.f;
#pragma unroll
            for (int j = 0; j < 4; ++j) { const u32x2 w = ((const u32x2*)(Z + (size_t)r * DM))[lane + 64 * j]; v[j] = (f32x4){bf_lo(w.x), bf_hi(w.x), bf_lo(w.y), bf_hi(w.y)}; s += (v[j][0] + v[j][1]) + (v[j][2] + v[j][3]); }
            const float mean = wave_sum(s, lane) * (1.0f / DM);
            float q = 0.f;
#pragma unroll
            for (int j = 0; j < 4; ++j) { v[j] = v[j] - mean; q += (v[j][0] * v[j][0] + v[j][1] * v[j][1]) + (v[j][2] * v[j][2] + v[j][3] * v[j][3]); }
            const float rstd = 1.0f / sqrtf(wave_sum(q, lane) * (1.0f / DM) + 1e-5f);
#pragma unroll
            for (int j = 0; j < 4; ++j) {
                const f32x4 g = ((const f32x4*)P.ln_g)[lane + 64 * j], bb = ((const f32x4*)P.ln_b)[lane + 64 * j];
                ((f32x4*)yr)[lane + 64 * j] = v[j] * rstd * g + bb;
            }
        }
    }
#if DIAG
    STAMP(5);
    __syncthreads();
    if (blockIdx.x == 0) {
        const Params P = load_params(lds);
        LAS unsigned long long* ts = (LAS unsigned long long*)(lds + LDS_BYTES - 256);
        const unsigned long long dtk = (DIAG == 6) ? (ts[5] - ts[0]) : (ts[DIAG] - ts[DIAG - 1]);
        const float eps = sqrtf((float)dtk * 0.01f * 1e-4f);
        for (int i = tid; i < 65536; i += 512) P.out[O_KS + i] *= (1.0f + eps);
    }
#endif
}


extern "C" void kernel_launch(void* const* d_in, const int* in_sizes, int n_in, void* d_out, int out_size, void* d_ws, size_t ws_size, hipStream_t stream) {
    static int grid_blocks = 0;
    if (!grid_blocks) {
        int dev = 0, cus = 0, per_cu = 0;
        hipGetDevice(&dev);
        hipDeviceGetAttribute(&cus, hipDeviceAttributeMultiprocessorCount, dev);
        hipFuncSetAttribute((const void*)fwd_kernel, hipFuncAttributeMaxDynamicSharedMemorySize, LDS_BYTES);
        hipOccupancyMaxActiveBlocksPerMultiprocessor(&per_cu, (const void*)fwd_kernel, 512, LDS_BYTES);
        if (per_cu < 1) { fprintf(stderr, "kernel_launch: occupancy query says %d blocks per CU\n", per_cu); per_cu = 1; }
        grid_blocks = cus;
        if (ws_size < WS_END) fprintf(stderr, "kernel_launch: workspace too small (%zu < %zu)\n", ws_size, (size_t)WS_END);
    }
    hipMemsetAsync((char*)d_ws + WS_CTL, 0, 65536, stream);
    Params p{};
    p.x_prompt = (const float*)d_in[0]; p.x_sample = (const float*)d_in[1]; p.state_ret = (const float*)d_in[2];
    p.cache_k = (const float*)d_in[3]; p.cache_v = (const float*)d_in[4]; p.cmem_k = (const float*)d_in[5]; p.cmem_v = (const float*)d_in[6];
    p.mem_prompt = (const float*)d_in[7]; p.w_in = (const float*)d_in[8]; p.w_mkv = (const float*)d_in[9]; p.w_out = (const float*)d_in[10];
    p.ln_g = (const float*)d_in[11]; p.ln_b = (const float*)d_in[12];
    p.out = (float*)d_out; p.ws = (unsigned char*)d_ws;
    hipLaunchKernelGGL(fwd_kernel, dim3(grid_blocks), dim3(512), LDS_BYTES, stream, p);
    hipError_t e = hipPeekAtLastError();
    if (e != hipSuccess) fprintf(stderr, "launch failed: %s (grid %d)\n", hipGetErrorString(e), grid_blocks);
}
```

```cpp
#include <hip/hip_runtime.h>
#include <hip/hip_cooperative_groups.h>
#include <cstdio>
#include <cstdint>
namespace cg = cooperative_groups;

#define LAS __attribute__((address_space(3)))
typedef unsigned short bf16_t;
typedef short bf16x8 __attribute__((ext_vector_type(8)));
typedef float f32x4 __attribute__((ext_vector_type(4)));
typedef float f32x2 __attribute__((ext_vector_type(2)));
typedef unsigned u32x4 __attribute__((ext_vector_type(4)));
typedef unsigned u32x2 __attribute__((ext_vector_type(2)));
typedef __bf16 bf16x2_t __attribute__((ext_vector_type(2)));

constexpr int DM = 1024, NB = 8, SEQ = 2048, DECB = 32, DECT = 4;
constexpr int NMEM = 256, DIN = 4608, DMIX = 1536;
constexpr int M_PROMPT = NB * SEQ;
constexpr int M_SAMPLE = DECB * DECT;
constexpr int ROWS_IN = M_PROMPT + 256;
constexpr int ROWS_ALL = ROWS_IN + NB * NMEM;
constexpr int HP = DIN;
constexpr int C_RQ = 0, C_RK = 256, C_RV = 512, C_RG = 1024, C_SQ = 1536, C_SK = 2048, C_SV = 2560, C_SG = 3072, C_MQ = 3584, C_MG = 4096;
constexpr size_t O_YP = 0, O_YS = 16777216, O_RP = 16908288, O_RS = 17170432, O_KP = 18219008, O_VP = 26607616,
                 O_KS = 34996224, O_VS = 35061760, O_MK = 35127296, O_MV = 36175872;
constexpr size_t MiB = 1u << 20;
constexpr size_t WS_CTL = 0, WS_ROPE = 1 * MiB, WS_WTIN = 2 * MiB, WS_WTMKV = 11 * MiB, WS_WTOUT = 14 * MiB,
                 WS_XB = 20 * MiB, WS_HB = 64 * MiB, WS_MKV = 212 * MiB, WS_MIX = 216 * MiB, WS_END = 324 * MiB;
constexpr int LDS_BYTES = 163840;
constexpr float LOG2E = 1.4426950408889634f;
constexpr float SQ_SCALE = 0.18033688011112042f;
constexpr float MQ_SCALE = 0.12751743082459868f;
constexpr float ALPHA = 1.189207115002721f;

struct Params {
    const float *x_prompt, *x_sample, *state_ret, *cache_k, *cache_v, *cmem_k, *cmem_v, *mem_prompt, *w_in, *w_mkv, *w_out, *ln_g, *ln_b;
    float* out;
    unsigned char* ws;
};

__device__ __forceinline__ unsigned pk_bf16(float lo, float hi) { f32x2 v = {lo, hi}; bf16x2_t b = __builtin_convertvector(v, bf16x2_t); return __builtin_bit_cast(unsigned, b); }
__device__ __forceinline__ float bf_lo(unsigned u) { return __uint_as_float(u << 16); }
__device__ __forceinline__ float bf_hi(unsigned u) { return __uint_as_float(u & 0xffff0000u); }
__device__ __forceinline__ float bf2f(bf16_t h) { return __uint_as_float(((unsigned)h) << 16); }
__device__ __forceinline__ float fexp2(float x) { return __builtin_amdgcn_exp2f(x); }
__device__ __forceinline__ float frcp(float x) { return __builtin_amdgcn_rcpf(x); }
__device__ __forceinline__ float silu(float x) { return x * frcp(1.0f + fexp2(-x * LOG2E)); }
__device__ __forceinline__ float shx(float v, int o, int lane) { return __int_as_float(__builtin_amdgcn_ds_bpermute(((lane ^ o) & 63) << 2, __float_as_int(v))); }
__device__ __forceinline__ float wave_max(float v, int lane) {
#pragma unroll
    for (int o = 1; o < 64; o <<= 1) v = fmaxf(v, shx(v, o, lane));
    return v;
}
__device__ __forceinline__ float wave_sum(float v, int lane) {
#pragma unroll
    for (int o = 1; o < 64; o <<= 1) v += shx(v, o, lane);
    return v;
}
#define LDS_WAIT() asm volatile("s_waitcnt lgkmcnt(0)" ::: "memory")
__device__ __forceinline__ int lane_id() { return (int)__builtin_amdgcn_mbcnt_hi(~0u, __builtin_amdgcn_mbcnt_lo(~0u, 0u)); }
__device__ __forceinline__ int perm32(int rho) { const int n = rho >> 4, i = rho & 15; return 8 * (i >> 2) + 4 * n + (i & 3); }
__device__ __forceinline__ int dmap(int p) { return 16 * (p >> 5) + 32 * ((p >> 2) & 1) + 4 * ((p >> 3) & 3) + (p & 3); }
__device__ __forceinline__ int src_col_in(int c) {
    const int rho = c & 31;
    const bool rope = (c < 512) || (c >= 1536 && c < 2560);
    if (rope) return (c & ~63) + 16 * ((c >> 5) & 1) + 32 * (rho >> 4) + (rho & 15);
    return (c & ~31) + perm32(rho);
}

__device__ __forceinline__ void transpose_item(const float* W, int K, int N, bf16_t* WT, int mode, LAS float* scr, int item, int lane) {
    const int nblk = N / 32, kb = item / nblk, nb = item % nblk, k0 = 64 * kb, n0 = 32 * nb;
    const int cl = lane & 31;
    const int sc = (mode == 0) ? (n0 + cl) : (mode == 1) ? (n0 + perm32(cl)) : src_col_in(n0 + cl);
    {
        float t[32];
        const float* wp = W + (size_t)(k0 + (lane >> 5)) * N + sc;
#pragma unroll
        for (int i = 0; i < 32; ++i) t[i] = wp[(size_t)(2 * i) * N];
#pragma unroll
        for (int i = 0; i < 32; ++i) scr[(2 * i + (lane >> 5)) * 33 + cl] = t[i];
    }
    LDS_WAIT();
    const int c = lane & 7;
#pragma unroll
    for (int j = 0; j < 4; ++j) {
        const int n = (lane >> 3) + 8 * j; const LAS float* s = scr + (8 * c) * 33 + n;
        u32x4 o; o.x = pk_bf16(s[0 * 33], s[1 * 33]); o.y = pk_bf16(s[2 * 33], s[3 * 33]); o.z = pk_bf16(s[4 * 33], s[5 * 33]); o.w = pk_bf16(s[6 * 33], s[7 * 33]);
        *(u32x4*)(WT + (size_t)(n0 + n) * K + k0 + 8 * c) = o;
    }
    LDS_WAIT();
}
__device__ __forceinline__ void sincos_d(double a, float& s, float& c) {
    const double kd = __builtin_rint(a * 0.63661977236758134308);
    double y = __builtin_fma(-kd, 1.57079632679489655800e+00, a); y = __builtin_fma(-kd, 6.12323399573676603587e-17, y);
    const double y2 = y * y;
    const double sp = y * (1.0 + y2 * (-1.0 / 6 + y2 * (1.0 / 120 + y2 * (-1.0 / 5040 + y2 * (1.0 / 362880 + y2 * (-1.0 / 39916800 + y2 * (1.0 / 6227020800.0)))))));
    const double cp = 1.0 + y2 * (-0.5 + y2 * (1.0 / 24 + y2 * (-1.0 / 720 + y2 * (1.0 / 40320 + y2 * (-1.0 / 3628800 + y2 * (1.0 / 479001600.0))))));
    const int k = ((int)kd) & 3;
    const double sv = (k == 0) ? sp : (k == 1) ? cp : (k == 2) ? -sp : -cp;
    const double cv = (k == 0) ? cp : (k == 1) ? -sp : (k == 2) ? -cp : sp;
    s = (float)sv; c = (float)cv;
}
__device__ __forceinline__ void phase0(const Params& P, LAS unsigned char* lds, int tid, int lane, int wave) {
    unsigned char* ws = P.ws;
    const int gw = blockIdx.x * 8 + wave, NGW = gridDim.x * 8;
    LAS float* scr = (LAS float*)(lds + wave * 8448);
    constexpr int I_IN = (DM / 64) * (DIN / 32), I_MKV = (DM / 64) * (1024 / 32), I_OUT = (DMIX / 64) * (DM / 32);
    for (int it = gw; it < I_IN + I_MKV + I_OUT; it += NGW) {
        int r = it;
        if (r < I_IN) { transpose_item(P.w_in, DM, DIN, (bf16_t*)(ws + WS_WTIN), 2, scr, r, lane); continue; } r -= I_IN;
        if (r < I_MKV) { transpose_item(P.w_mkv, DM, 1024, (bf16_t*)(ws + WS_WTMKV), 1, scr, r, lane); continue; } r -= I_MKV;
        transpose_item(P.w_out, DMIX, DM, (bf16_t*)(ws + WS_WTOUT), 0, scr, r, lane);
    }
    bf16_t* XB = (bf16_t*)(ws + WS_XB);
    for (int m0 = gw; m0 < ROWS_ALL; m0 += 2 * NGW) {
        f32x4 v[2][4];
#pragma unroll
        for (int rr = 0; rr < 2; ++rr) {
            const int m = m0 + rr * NGW;
            const float* src = (m < M_PROMPT) ? P.x_prompt + (size_t)m * DM : (m < M_PROMPT + M_SAMPLE) ? P.x_sample + (size_t)(m - M_PROMPT) * DM
                             : (m < ROWS_IN || m >= ROWS_ALL) ? nullptr : P.mem_prompt + (size_t)(m - ROWS_IN) * DM;
#pragma unroll
            for (int j = 0; j < 4; ++j) { v[rr][j] = (f32x4){0.f, 0.f, 0.f, 0.f}; if (src) v[rr][j] = ((const f32x4*)src)[lane + 64 * j]; }
        }
#pragma unroll
        for (int rr = 0; rr < 2; ++rr) {
            const int m = m0 + rr * NGW;
            if (m < ROWS_ALL) {
                u32x2* dst = (u32x2*)(XB + (size_t)m * DM) + lane;
#pragma unroll
                for (int j = 0; j < 4; ++j) { u32x2 o; o.x = pk_bf16(v[rr][j].x, v[rr][j].y); o.y = pk_bf16(v[rr][j].z, v[rr][j].w); dst[64 * j] = o; }
            }
        }
    }
    float* rope = (float*)(ws + WS_ROPE);
    for (int e = blockIdx.x * 512 + tid; e < 2052 * 32; e += gridDim.x * 512) {
        const int idx = e >> 5, i = e & 31;
        const int pos = idx < 2048 ? idx : 8192 + (idx - 2048);
        double inv = 1.0;
        for (int k = 0; k < i; ++k) inv *= 0.7498942093324559;
        float s, c; sincos_d((double)pos * inv, s, c);
        rope[2 * e] = c; rope[2 * e + 1] = s;
    }
}

template <int K>
__device__ __forceinline__ void gemm_mainloop(const bf16_t* __restrict__ A, const bf16_t* __restrict__ Bt, LAS unsigned char* lds,
                                              f32x4 (&acc)[2][2][4][2], int tid, int wr, int wc, int fr, int fq) {
    constexpr int PITCH = 144;
    LAS unsigned char* As = lds; LAS unsigned char* Bs = lds + 256 * PITCH;
    const int lrow = tid >> 3, lch = tid & 7;
    const bf16_t* ga = A + (size_t)lrow * K + lch * 8;
    const bf16_t* gb = Bt + (size_t)lrow * K + lch * 8;
    u32x4 ra[4], rb[4];
#pragma unroll
    for (int i = 0; i < 4; ++i) { ra[i] = *(const u32x4*)(ga + (size_t)i * 64 * K); rb[i] = *(const u32x4*)(gb + (size_t)i * 64 * K); }
#pragma unroll
    for (int a = 0; a < 2; ++a)
#pragma unroll
        for (int b = 0; b < 2; ++b)
#pragma unroll
            for (int m = 0; m < 4; ++m)
#pragma unroll
                for (int n = 0; n < 2; ++n) acc[a][b][m][n] = (f32x4){0.f, 0.f, 0.f, 0.f};
    for (int kt = 0; kt < K / 64; ++kt) {
        __syncthreads();
#pragma unroll
        for (int i = 0; i < 4; ++i) {
            *(LAS u32x4*)(As + (lrow + 64 * i) * PITCH + lch * 16) = ra[i];
            *(LAS u32x4*)(Bs + (lrow + 64 * i) * PITCH + lch * 16) = rb[i];
        }
        __syncthreads();
        if (kt + 1 < K / 64) {
#pragma unroll
            for (int i = 0; i < 4; ++i) { ra[i] = *(const u32x4*)(ga + (size_t)i * 64 * K + (kt + 1) * 64); rb[i] = *(const u32x4*)(gb + (size_t)i * 64 * K + (kt + 1) * 64); }
        }
#pragma unroll
        for (int ai = 0; ai < 2; ++ai) {
#pragma unroll
            for (int k = 0; k < 2; ++k) {
                bf16x8 At[4];
#pragma unroll
                for (int m = 0; m < 4; ++m) At[m] = *(const LAS bf16x8*)(As + (ai * 128 + wr * 64 + m * 16 + fr) * PITCH + (k * 32 + fq * 8) * 2);
#pragma unroll
                for (int bj = 0; bj < 2; ++bj) {
                    bf16x8 Bf[2];
#pragma unroll
                    for (int n = 0; n < 2; ++n) Bf[n] = *(const LAS bf16x8*)(Bs + (bj * 128 + wc * 32 + n * 16 + fr) * PITCH + (k * 32 + fq * 8) * 2);
#pragma unroll
                    for (int m = 0; m < 4; ++m)
#pragma unroll
                        for (int n = 0; n < 2; ++n) acc[ai][bj][m][n] = __builtin_amdgcn_mfma_f32_16x16x32_bf16(Bf[n], At[m], acc[ai][bj][m][n], 0, 0, 0);
                }
            }
        }
    }
}


namespace pg8 {
#define PG8_LAS __attribute__((address_space(3)))
typedef unsigned short bf16_t;
typedef short bf16x8 __attribute__((ext_vector_type(8)));
typedef float f32x4 __attribute__((ext_vector_type(4)));
constexpr int BM = 256, BK = 64, HALF = 128, HTB = HALF * BK * 2, STAGE_BYTES = 8 * HTB;
__host__ __device__ __forceinline__ int lds_byte(int r, int c) { const int st = (r >> 4) * 2 + (c >> 5), rr = r & 15, cc = c & 31, ob = rr * 64 + cc * 2; return st * 1024 + (ob ^ (((ob >> 9) & 1) << 5)); }
__host__ __device__ __forceinline__ void stage_rc(int b, int& R, int& C) { const int st = b / 1024, sb = b % 1024, swz = sb ^ (((sb >> 9) & 1) << 5); R = (st >> 1) * 16 + swz / 64; C = (st & 1) * 32 + (swz % 64) / 2; }
__host__ __device__ __forceinline__ int perm32(int rho) { const int n = rho >> 4, i = rho & 15; return 8 * (i >> 2) + 4 * n + (i & 3); }
struct Unit { int pm, pn; };
struct Gemm { const bf16_t* A; const bf16_t* Bt; int M, N, K; };
template <class Epi, class Sched, bool ALIGN_EPI = false, bool SP2 = false>
__device__ __forceinline__ void gemm_phase(PG8_LAS unsigned char* lds, const Gemm g, const Sched& S, const Epi& E, int tid_in) {
    int tid = tid_in; asm volatile("" : "+v"(tid));
    const int wid = __builtin_amdgcn_readfirstlane(tid >> 6), lane = tid & 63, wr = wid >> 2, wc = wid & 3, fr = lane & 15, fq = lane >> 4;
    const int K = g.K, nt = K / BK;
    unsigned voffA[2], voffB[2];
#pragma unroll
    for (int i = 0; i < 2; ++i) { int R, C; stage_rc(tid * 16 + i * 8192, R, C); const int Rb = Epi::PERM ? ((R & ~31) + perm32(R & 31)) : R;
        voffA[i] = (unsigned)(R * K + C) * 2u; voffB[i] = (unsigned)(Rb * K + C) * 2u; }
    const size_t kstep = (size_t)(BK * 2);
    const size_t hstep = (size_t)HALF * K * 2;
    const size_t tstep = 2 * hstep;
    const unsigned ldsw = (unsigned)wid * 1024u;
    const int aoff = lds_byte(wr * 64 + fr, fq * 8), boff = lds_byte(wc * 32 + fr, fq * 8);
#define PG8_SA(b, h) (((b) * 2 + (h)) * HTB)
#define PG8_SB(b, h) ((4 + (b) * 2 + (h)) * HTB)
#define PG8_STAGE(bufoff, gbase, voff) do { _Pragma("unroll") for (int _i = 0; _i < 2; ++_i) \
        __builtin_amdgcn_global_load_lds((const unsigned*)((const char*)(gbase) + (voff)[_i]), (PG8_LAS unsigned*)(lds + (bufoff) + ldsw + _i * 8192), 16, 0, 0); } while (0)
#define PG8_LDA(dst, b, h) do { _Pragma("unroll") for (int m = 0; m < 4; ++m) _Pragma("unroll") for (int k = 0; k < 2; ++k) dst[m][k] = *(const PG8_LAS bf16x8*)(lds + PG8_SA(b, h) + aoff + m * 2048 + k * 1024); } while (0)
#define PG8_LDB(dst, b, h) do { _Pragma("unroll") for (int n = 0; n < 2; ++n) _Pragma("unroll") for (int k = 0; k < 2; ++k) dst[n][k] = *(const PG8_LAS bf16x8*)(lds + PG8_SB(b, h) + boff + n * 2048 + k * 1024); } while (0)
#define PG8_MMA(ai, bj, At, Bt) do { __builtin_amdgcn_s_setprio(1); _Pragma("unroll") for (int m = 0; m < 4; ++m) _Pragma("unroll") for (int n = 0; n < 2; ++n) _Pragma("unroll") for (int k = 0; k < 2; ++k) \
        acc[ai][bj][m][n] = __builtin_amdgcn_mfma_f32_16x16x32_bf16(Bt[n][k], At[m][k], acc[ai][bj][m][n], 0, 0, 0); __builtin_amdgcn_s_setprio(0); } while (0)
#define PG8_WAIT_V(n) asm volatile("s_waitcnt vmcnt(" #n ")" ::: "memory")
#define PG8_WAIT_L(n) asm volatile("s_waitcnt lgkmcnt(" #n ")" ::: "memory")
#define PG8_BAR __builtin_amdgcn_s_barrier()
#define PG8_SCHED __builtin_amdgcn_sched_barrier(0)
    Unit cur, nxt; int ui = 0;
    if (!S.next(0, cur)) return;
    f32x4 acc[2][2][4][2];
#pragma unroll
    for (int a = 0; a < 2; ++a)
#pragma unroll
        for (int b = 0; b < 2; ++b)
#pragma unroll
            for (int m = 0; m < 4; ++m)
#pragma unroll
                for (int n = 0; n < 2; ++n) acc[a][b][m][n] = (f32x4){0.f, 0.f, 0.f, 0.f};
    bf16x8 At[4][2], B0[2][2], B1[2][2];
    const char* cA = (const char*)g.A + (size_t)cur.pm * tstep; const char* cB = (const char*)g.Bt + (size_t)cur.pn * tstep;
    S.a_ready(cur);
    if constexpr (SP2) {
        PG8_STAGE(PG8_SB(0, 0), cB, voffB); PG8_STAGE(PG8_SB(0, 1), cB + hstep, voffB); PG8_STAGE(PG8_SA(0, 0), cA, voffA); PG8_STAGE(PG8_SA(0, 1), cA + hstep, voffA);
        if (wr == 1) PG8_BAR;
        PG8_WAIT_V(2); PG8_BAR;
        PG8_STAGE(PG8_SB(1, 0), cB + kstep, voffB); PG8_STAGE(PG8_SA(1, 0), cA + kstep, voffA); PG8_STAGE(PG8_SB(1, 1), cB + hstep + kstep, voffB);
        PG8_WAIT_V(6); PG8_BAR;
    } else {
        PG8_STAGE(PG8_SB(0, 0), cB, voffB); PG8_STAGE(PG8_SA(0, 0), cA, voffA); PG8_STAGE(PG8_SB(0, 1), cB + hstep, voffB); PG8_STAGE(PG8_SA(0, 1), cA + hstep, voffA);
        if (wr == 1) PG8_BAR;
        PG8_WAIT_V(4); PG8_BAR;
        PG8_STAGE(PG8_SB(1, 0), cB + kstep, voffB); PG8_STAGE(PG8_SA(1, 0), cA + kstep, voffA); PG8_STAGE(PG8_SB(1, 1), cB + hstep + kstep, voffB);
        PG8_WAIT_V(6); PG8_BAR;
    }
    for (;;) {
        const bool has_next = S.next(ui + 1, nxt);
        const char* nA = has_next ? (const char*)g.A + (size_t)nxt.pm * tstep : cA; const char* nB = has_next ? (const char*)g.Bt + (size_t)nxt.pn * tstep : cB;
        for (int t = 0; t < nt; t += 2) {
            const bool last = (t == nt - 2);
            const char* a1 = cA + (size_t)(t + 1) * kstep;
            const char* a2 = last ? nA : cA + (size_t)(t + 2) * kstep; const char* b2 = last ? nB : cB + (size_t)(t + 2) * kstep;
            const char* a3 = a2 + kstep; const char* b3 = b2 + kstep;
            if (last && has_next) S.a_ready(nxt);
            if constexpr (SP2) {
            PG8_LDB(B0, 0, 0); PG8_LDB(B1, 0, 1); PG8_SCHED; PG8_LDA(At, 0, 0); PG8_STAGE(PG8_SA(1, 1), a1 + hstep, voffA);
            PG8_WAIT_V(8); PG8_WAIT_L(0); PG8_BAR; PG8_MMA(0, 0, At, B0); PG8_MMA(0, 1, At, B1); PG8_BAR; PG8_SCHED;
            PG8_LDA(At, 0, 1); PG8_STAGE(PG8_SB(0, 0), b2, voffB); PG8_STAGE(PG8_SB(0, 1), b2 + hstep, voffB); PG8_STAGE(PG8_SA(0, 0), a2, voffA);
            PG8_WAIT_V(8); PG8_WAIT_L(0); PG8_BAR; PG8_MMA(1, 0, At, B0); PG8_MMA(1, 1, At, B1); PG8_BAR; PG8_SCHED;
            PG8_LDB(B0, 1, 0); PG8_LDB(B1, 1, 1); PG8_SCHED; PG8_LDA(At, 1, 0); PG8_STAGE(PG8_SA(0, 1), a2 + hstep, voffA);
            PG8_WAIT_V(8); PG8_WAIT_L(0); PG8_BAR; PG8_MMA(0, 0, At, B0); PG8_MMA(0, 1, At, B1); PG8_BAR; PG8_SCHED;
            PG8_LDA(At, 1, 1); PG8_STAGE(PG8_SB(1, 0), b3, voffB); PG8_STAGE(PG8_SB(1, 1), b3 + hstep, voffB); PG8_STAGE(PG8_SA(1, 0), a3, voffA);
            PG8_WAIT_V(8); PG8_WAIT_L(0); PG8_BAR; PG8_MMA(1, 0, At, B0); PG8_MMA(1, 1, At, B1); PG8_BAR; PG8_SCHED;
            } else {
            PG8_LDB(B0, 0, 0); PG8_SCHED; PG8_LDA(At, 0, 0); PG8_STAGE(PG8_SA(1, 1), a1 + hstep, voffA);
            PG8_WAIT_L(8); PG8_BAR; PG8_WAIT_L(0); PG8_MMA(0, 0, At, B0); PG8_BAR; PG8_SCHED;
            PG8_LDB(B1, 0, 1); PG8_STAGE(PG8_SB(0, 0), b2, voffB);
            PG8_BAR; PG8_WAIT_L(0); PG8_MMA(0, 1, At, B1); PG8_BAR;
            PG8_LDA(At, 0, 1); PG8_STAGE(PG8_SA(0, 0), a2, voffA);
            PG8_BAR; PG8_WAIT_L(0); PG8_MMA(1, 0, At, B0); PG8_BAR; PG8_SCHED;
            PG8_STAGE(PG8_SB(0, 1), b2 + hstep, voffB);
            PG8_WAIT_V(6); PG8_BAR; PG8_MMA(1, 1, At, B1); PG8_BAR;
            PG8_LDB(B0, 1, 0); PG8_SCHED; PG8_LDA(At, 1, 0); PG8_STAGE(PG8_SA(0, 1), a2 + hstep, voffA);
            PG8_WAIT_L(8); PG8_BAR; PG8_WAIT_L(0); PG8_MMA(0, 0, At, B0); PG8_BAR; PG8_SCHED;
            PG8_LDB(B1, 1, 1); PG8_STAGE(PG8_SB(1, 0), b3, voffB);
            PG8_BAR; PG8_WAIT_L(0); PG8_MMA(0, 1, At, B1); PG8_BAR;
            PG8_LDA(At, 1, 1); PG8_STAGE(PG8_SA(1, 0), a3, voffA);
            PG8_BAR; PG8_WAIT_L(0); PG8_MMA(1, 0, At, B0); PG8_BAR; PG8_SCHED;
            PG8_STAGE(PG8_SB(1, 1), b3 + hstep, voffB);
            PG8_WAIT_V(6); PG8_BAR; PG8_MMA(1, 1, At, B1); PG8_BAR;
            }
        }
        if constexpr (ALIGN_EPI) { if (wr == 0) PG8_BAR; }
        if constexpr (!Epi::AFTER_DRAIN) { E(acc, cur, wr, wc, fr, fq); S.done(cur); }
        if (!has_next) break;
#pragma unroll
        for (int a = 0; a < 2; ++a)
#pragma unroll
            for (int b = 0; b < 2; ++b)
#pragma unroll
                for (int m = 0; m < 4; ++m)
#pragma unroll
                    for (int n = 0; n < 2; ++n) acc[a][b][m][n] = (f32x4){0.f, 0.f, 0.f, 0.f};
        cur = nxt; cA = nA; cB = nB; ++ui;
        if constexpr (ALIGN_EPI) { if (wr == 1) PG8_BAR; }
    }
    PG8_WAIT_V(0);
    if constexpr (!ALIGN_EPI) { if (wr == 0) PG8_BAR; }
    PG8_BAR;
    if constexpr (Epi::AFTER_DRAIN) { E.fused(acc, cur, wr, wc, fr, fq, lds, wid, lane); S.done(cur); }
#undef PG8_SA
#undef PG8_SB
#undef PG8_STAGE
#undef PG8_LDA
#undef PG8_LDB
#undef PG8_MMA
#undef PG8_WAIT_V
#undef PG8_WAIT_L
#undef PG8_BAR
#undef PG8_SCHED
}
}

__device__ __forceinline__ void epi_inproj(const f32x4 (&acc)[2][2][4][2], int pm, int pn, const Params& P, int wr, int wc, int fr, int fq) {
    bf16_t* HB = (bf16_t*)(P.ws + WS_HB);
    const float* rope = (const float*)(P.ws + WS_ROPE);
    int type = 0; float scale = 1.0f; int f32out = 0;
    if (pn == 0) { type = 1; }
    else if (pn == 1) { type = 1; scale = 0.125f; }
    else if (pn == 4 || pn == 5 || pn == 12 || pn == 13 || pn == 16 || pn == 17) { type = 2; }
    else if (pn == 6 || pn == 7) { type = 1; scale = SQ_SCALE; }
    else if (pn == 8 || pn == 9) { type = 1; f32out = 1; }
    else if (pn == 10 || pn == 11) { f32out = 2; }
    else if (pn == 14 || pn == 15) { scale = MQ_SCALE; }
#pragma unroll
    for (int ai = 0; ai < 2; ++ai)
#pragma unroll
        for (int m = 0; m < 4; ++m) {
            const int r = pm * 256 + ai * 128 + wr * 64 + m * 16 + fr;
            const int pi = r < M_PROMPT ? (r & 2047) : 2048 + ((r - M_PROMPT) & 3);
            const bool live = r < M_PROMPT + M_SAMPLE;
#pragma unroll
            for (int bj = 0; bj < 2; ++bj) {
                const int cb = pn * 256 + bj * 128 + wc * 32;
                f32x4 v0 = acc[ai][bj][m][0], v1 = acc[ai][bj][m][1];
                if (type == 1) {
                    const int d1 = 16 * ((cb >> 5) & 1) + 4 * fq;
                    const f32x4* rp = (const f32x4*)(rope + ((size_t)pi * 32 + d1) * 2);
                    const f32x4 cs0 = rp[0], cs1 = rp[1];
                    f32x4 y1, y2;
                    y1[0] = v0[0] * cs0[0] - v1[0] * cs0[1]; y2[0] = v1[0] * cs0[0] + v0[0] * cs0[1];
                    y1[1] = v0[1] * cs0[2] - v1[1] * cs0[3]; y2[1] = v1[1] * cs0[2] + v0[1] * cs0[3];
                    y1[2] = v0[2] * cs1[0] - v1[2] * cs1[1]; y2[2] = v1[2] * cs1[0] + v0[2] * cs1[1];
                    y1[3] = v0[3] * cs1[2] - v1[3] * cs1[3]; y2[3] = v1[3] * cs1[2] + v0[3] * cs1[3];
                    if (f32out == 1 && live) {
                        float* o = (r < M_PROMPT ? P.out + O_KP + (size_t)r * 512 : P.out + O_KS + (size_t)(r - M_PROMPT) * 512) + ((cb - C_SK) >> 6) * 64 + d1;
                        *(f32x4*)o = y1; *(f32x4*)(o + 32) = y2;
                    }
                    v0 = y1 * scale; v1 = y2 * scale;
                } else if (type == 2) {
#pragma unroll
                    for (int e = 0; e < 4; ++e) { v0[e] = silu(v0[e]); v1[e] = silu(v1[e]); }
                } else {
                    if (f32out == 2 && live) {
                        float* o = (r < M_PROMPT ? P.out + O_VP + (size_t)r * 512 : P.out + O_VS + (size_t)(r - M_PROMPT) * 512) + (cb - C_SV) + 8 * fq;
                        *(f32x4*)o = v0; *(f32x4*)(o + 4) = v1;
                    }
                    v0 = v0 * scale; v1 = v1 * scale;
                }
                u32x4 w; w.x = pk_bf16(v0[0], v0[1]); w.y = pk_bf16(v0[2], v0[3]); w.z = pk_bf16(v1[0], v1[1]); w.w = pk_bf16(v1[2], v1[3]);
                *(u32x4*)(HB + (size_t)r * HP + cb + 8 * fq) = w;
            }
        }
}
__device__ __forceinline__ void epi_memkv(const f32x4 (&acc)[2][2][4][2], int pm, int pn, const Params& P, int wr, int wc, int fr, int fq) {
    bf16_t* MKV = (bf16_t*)(P.ws + WS_MKV);
#pragma unroll
    for (int ai = 0; ai < 2; ++ai)
#pragma unroll
        for (int m = 0; m < 4; ++m) {
            const int r = pm * 256 + ai * 128 + wr * 64 + m * 16 + fr;
#pragma unroll
            for (int bj = 0; bj < 2; ++bj) {
                const int c0 = pn * 256 + bj * 128 + wc * 32 + 8 * fq;
                const f32x4 v0 = acc[ai][bj][m][0], v1 = acc[ai][bj][m][1];
                float* o = (c0 < 512) ? P.out + O_MK + (size_t)r * 512 + c0 : P.out + O_MV + (size_t)r * 512 + (c0 - 512);
                *(f32x4*)o = v0; *(f32x4*)(o + 4) = v1;
                u32x4 w; w.x = pk_bf16(v0[0], v0[1]); w.y = pk_bf16(v0[2], v0[3]); w.z = pk_bf16(v1[0], v1[1]); w.w = pk_bf16(v1[2], v1[3]);
                *(u32x4*)(MKV + (size_t)r * 1024 + c0) = w;
            }
        }
}
constexpr size_t WS_Z = 290 * MiB;
__device__ __forceinline__ void epi_outproj(const f32x4 (&acc)[2][2][4][2], int pm, int pn, const Params& P, int wr, int wc, int fr, int fq) {
    const bf16_t* XB = (const bf16_t*)(P.ws + WS_XB);
    bf16_t* Z = (bf16_t*)(P.ws + WS_Z);
#pragma unroll
    for (int ai = 0; ai < 2; ++ai)
#pragma unroll
        for (int m = 0; m < 4; ++m) {
            const size_t r = (size_t)pm * 256 + ai * 128 + wr * 64 + m * 16 + fr;
#pragma unroll
            for (int bj = 0; bj < 2; ++bj)
#pragma unroll
                for (int n = 0; n < 2; ++n) {
                    const int c = pn * 256 + bj * 128 + wc * 32 + 16 * n + 4 * fq;
                    const u32x2 xv = *(const u32x2*)(XB + r * DM + c);
                    const f32x4 a = acc[ai][bj][m][n];
                    u32x2 w; w.x = pk_bf16(bf_lo(xv.x) * ALPHA + a[0], bf_hi(xv.x) * ALPHA + a[1]); w.y = pk_bf16(bf_lo(xv.y) * ALPHA + a[2], bf_hi(xv.y) * ALPHA + a[3]);
                    *(u32x2*)(Z + r * DM + c) = w;
                }
        }
}

__device__ __forceinline__ void ret_scan(const Params& P, LAS unsigned char* lds, int b, int h, int row0, int ntok, const float* init, float* outstate, int tid) {
    const bf16_t* HB = (const bf16_t*)(P.ws + WS_HB);
    bf16_t* MIX = (bf16_t*)(P.ws + WS_MIX);
    LAS float* qs = (LAS float*)lds;
    LAS float* ks = qs + 32 * 64;
    LAS float* vs = ks + 32 * 64;
    LAS float* po = vs + 32 * 128;
    const int vv = tid & 127, kq = tid >> 7, lane = tid & 63;
    const float gamma = 1.0f - __builtin_amdgcn_exp2f((float)(-5 - h));
    float S[16];
#pragma unroll
    for (int j = 0; j < 16; ++j) S[j] = init ? init[((size_t)((b * 4 + h) * 64 + dmap(16 * kq + j))) * 128 + vv] : 0.f;
    for (int t0 = 0; t0 < ntok; t0 += 32) {
        const int nb = (ntok - t0) < 32 ? (ntok - t0) : 32;
        __syncthreads();
        {
            const int tt = (tid & 255) >> 3, ch = tid & 7;
            if (tt < nb) {
                const u32x4 w = *(const u32x4*)(HB + (size_t)(row0 + t0 + tt) * HP + (tid < 256 ? C_RQ : C_RK) + h * 64 + ch * 8);
                LAS float* dst = (tid < 256 ? qs : ks) + tt * 64 + ch * 8;
                dst[0] = bf_lo(w.x); dst[1] = bf_hi(w.x); dst[2] = bf_lo(w.y); dst[3] = bf_hi(w.y);
                dst[4] = bf_lo(w.z); dst[5] = bf_hi(w.z); dst[6] = bf_lo(w.w); dst[7] = bf_hi(w.w);
            }
            const int tv = tid >> 4, cv = tid & 15;
            if (tv < nb) {
                const u32x4 w = *(const u32x4*)(HB + (size_t)(row0 + t0 + tv) * HP + C_RV + h * 128 + cv * 8);
                LAS float* dst = vs + tv * 128 + cv * 8;
                dst[0] = bf_lo(w.x); dst[1] = bf_hi(w.x); dst[2] = bf_lo(w.y); dst[3] = bf_hi(w.y);
                dst[4] = bf_lo(w.z); dst[5] = bf_hi(w.z); dst[6] = bf_lo(w.w); dst[7] = bf_hi(w.w);
            }
        }
        __syncthreads();
        for (int tt = 0; tt < nb; ++tt) {
            const float vval = vs[tt * 128 + vv];
            float o = 0.f;
#pragma unroll
            for (int j4 = 0; j4 < 4; ++j4) {
                const f32x4 k4 = *(const LAS f32x4*)(ks + tt * 64 + 16 * kq + 4 * j4);
                const f32x4 q4 = *(const LAS f32x4*)(qs + tt * 64 + 16 * kq + 4 * j4);
#pragma unroll
                for (int e = 0; e < 4; ++e) { S[4 * j4 + e] = fmaf(gamma, S[4 * j4 + e], k4[e] * vval); o = fmaf(q4[e], S[4 * j4 + e], o); }
            }
            po[(tt * 4 + kq) * 128 + vv] = o;
        }
        __syncthreads();
        {
            const int tf = tid >> 4, c8 = (tid & 15) * 8;
            float o[8]; float s = 0.f;
#pragma unroll
            for (int e = 0; e < 8; ++e) { o[e] = (po[(tf * 4 + 0) * 128 + c8 + e] + po[(tf * 4 + 1) * 128 + c8 + e]) + (po[(tf * 4 + 2) * 128 + c8 + e] + po[(tf * 4 + 3) * 128 + c8 + e]); s += o[e]; }
            s += shx(s, 1, lane); s += shx(s, 2, lane); s += shx(s, 4, lane); s += shx(s, 8, lane);
            const float mean = s * (1.0f / 128.0f);
            float q = 0.f;
#pragma unroll
            for (int e = 0; e < 8; ++e) { o[e] -= mean; q += o[e] * o[e]; }
            q += shx(q, 1, lane); q += shx(q, 2, lane); q += shx(q, 4, lane); q += shx(q, 8, lane);
            const float rstd = 1.0f / sqrtf(q * (1.0f / 128.0f) + 1e-5f);
            if (tf < nb) {
                const size_t row = (size_t)(row0 + t0 + tf);
                const u32x4 g = *(const u32x4*)(HB + row * HP + C_RG + h * 128 + c8);
                u32x4 w;
                w.x = pk_bf16(o[0] * rstd * bf_lo(g.x), o[1] * rstd * bf_hi(g.x)); w.y = pk_bf16(o[2] * rstd * bf_lo(g.y), o[3] * rstd * bf_hi(g.y));
                w.z = pk_bf16(o[4] * rstd * bf_lo(g.z), o[5] * rstd * bf_hi(g.z)); w.w = pk_bf16(o[6] * rstd * bf_lo(g.w), o[7] * rstd * bf_hi(g.w));
                *(u32x4*)(MIX + row * DMIX + h * 128 + c8) = w;
            }
        }
    }
    __syncthreads();
#pragma unroll
    for (int j = 0; j < 16; ++j) outstate[((size_t)((b * 4 + h) * 64 + dmap(16 * kq + j))) * 128 + vv] = S[j];
}

__device__ __forceinline__ float dot4(f32x4 a, f32x4 b) { return (a[0] * b[0] + a[1] * b[1]) + (a[2] * b[2] + a[3] * b[3]); }
__device__ __forceinline__ void swa_sample_unit(const Params& P, LAS unsigned char* lds, int tid, int wave, int b, int h) {
    const bf16_t* HB = (const bf16_t*)(P.ws + WS_HB);
    bf16_t* MIX = (bf16_t*)(P.ws + WS_MIX);
    LAS float* qo = (LAS float*)lds; LAS float* kn = qo + 256; LAS float* vn = kn + 256;
    LAS float* sc = (LAS float*)(lds + 4096); LAS float* ls = (LAS float*)(lds + 10496); LAS float* red = (LAS float*)(lds + 12288);
    const int lane = tid & 63;
    __syncthreads();
    if (tid < 256) {
        const int i = tid >> 6, p = tid & 63; const size_t R = (size_t)M_PROMPT + b * 4 + i;
        qo[i * 64 + dmap(p)] = bf2f(HB[R * HP + C_SQ + h * 64 + p]);
        kn[i * 64 + dmap(p)] = bf2f(HB[R * HP + C_SK + h * 64 + p]);
        vn[i * 64 + p] = bf2f(HB[R * HP + C_SV + h * 64 + p]);
    }
    __syncthreads();
#pragma unroll 1
    for (int rnd = 0; rnd < 4; ++rnd) {
        const int tr = tid + 512 * rnd;
        if (tr < 1548) {
            const int i = tr / 387, rem = tr - i * 387, g = rem / 129, s = rem - g * 129;
            const int dil = (g == 0) ? 1 : (g == 1) ? 4 : 16;
            const int idx = 2048 + i - dil * s;
            float a = 0.f;
            if (idx < 2048) {
                const f32x4* kc = (const f32x4*)(P.cache_k + (((size_t)b * 2048 + idx) * 8 + h) * 64);
                f32x4 kv[16];
#pragma unroll
                for (int c = 0; c < 16; ++c) kv[c] = kc[c];
#pragma unroll
                for (int c = 0; c < 16; ++c) a += dot4(kv[c], *(const LAS f32x4*)(qo + i * 64 + 4 * c));
            } else {
                const LAS f32x4* kc = (const LAS f32x4*)(kn + (idx - 2048) * 64);
#pragma unroll
                for (int c = 0; c < 16; ++c) a += dot4(kc[c], *(const LAS f32x4*)(qo + i * 64 + 4 * c));
            }
            sc[tr] = a;
        }
    }
    __syncthreads();
    if (wave < 4) {
        const int i = wave;
        float m = -INFINITY;
#pragma unroll
        for (int k = 0; k < 7; ++k) { const int e = lane + 64 * k; if (e < 387) m = fmaxf(m, sc[i * 387 + e]); }
        m = wave_max(m, lane);
        float l = 0.f;
#pragma unroll
        for (int k = 0; k < 7; ++k) { const int e = lane + 64 * k; if (e < 387) { const float p = fexp2(sc[i * 387 + e] - m); sc[i * 387 + e] = p; l += p; } }
        l = wave_sum(l, lane);
        if (lane == 0) ls[i] = l;
    }
    __syncthreads();
    {
        const int d4 = tid & 15, slot = tid >> 4;
#pragma unroll 1
        for (int i = 0; i < 4; ++i) {
            f32x4 acc = {0.f, 0.f, 0.f, 0.f};
            f32x4 vv[13]; float pp[13];
#pragma unroll
            for (int k = 0; k < 13; ++k) {
                const int e0 = slot + 32 * k; const bool ok = e0 < 387; const int e = ok ? e0 : 0;
                const int g = e / 129, s = e - g * 129;
                const int dil = (g == 0) ? 1 : (g == 1) ? 4 : 16;
                const int idx = 2048 + i - dil * s;
                pp[k] = ok ? sc[i * 387 + e] : 0.f;
                vv[k] = (idx < 2048) ? *(const f32x4*)(P.cache_v + (((size_t)b * 2048 + idx) * 8 + h) * 64 + d4 * 4)
                                     : *(const LAS f32x4*)(vn + (idx - 2048) * 64 + d4 * 4);
            }
#pragma unroll
            for (int k = 0; k < 13; ++k) acc = acc + vv[k] * pp[k];
            *(LAS f32x4*)(red + (slot * 4 + i) * 64 + d4 * 4) = acc;
        }
    }
    __syncthreads();
    if (tid < 256) {
        const int i = tid >> 6, d = tid & 63;
        float s = 0.f;
#pragma unroll
        for (int sl = 0; sl < 32; ++sl) s += red[(sl * 4 + i) * 64 + d];
        const size_t R = (size_t)M_PROMPT + b * 4 + i;
        const float gate = bf2f(HB[R * HP + C_SG + h * 64 + d]);
        MIX[R * DMIX + 512 + h * 64 + d] = (bf16_t)(pk_bf16(s / ls[i] * gate, 0.f) & 0xffffu);
    }
}
__device__ __forceinline__ void mem_sample_unit(const Params& P, LAS unsigned char* lds, int tid, int wave, int b, int h) {
    const bf16_t* HB = (const bf16_t*)(P.ws + WS_HB);
    bf16_t* MIX = (bf16_t*)(P.ws + WS_MIX);
    LAS float* qm = (LAS float*)lds; LAS float* part = (LAS float*)(lds + 2048); LAS float* pr = (LAS float*)(lds + 10240);
    LAS float* ls = (LAS float*)(lds + 14336); LAS float* red = (LAS float*)(lds + 16384);
    const int lane = tid & 63;
    __syncthreads();
    { const int i = tid >> 7, d = tid & 127; qm[i * 128 + d] = bf2f(HB[((size_t)M_PROMPT + b * 4 + i) * HP + C_MQ + h * 128 + d]); }
    __syncthreads();
    {
        const int m = tid & 255, half = tid >> 8;
        const f32x4* kc = (const f32x4*)(P.cmem_k + (((size_t)b * NMEM + m) * 4 + h) * 128 + half * 64);
        f32x4 kv[16];
#pragma unroll
        for (int c = 0; c < 16; ++c) kv[c] = kc[c];
#pragma unroll
        for (int i = 0; i < 4; ++i) {
            float a = 0.f;
#pragma unroll
            for (int c = 0; c < 16; ++c) a += dot4(kv[c], *(const LAS f32x4*)(qm + i * 128 + half * 64 + 4 * c));
            part[(half * 4 + i) * 256 + m] = a;
        }
    }
    __syncthreads();
    if (wave < 4) {
        const int i = wave;
        float s[4]; float m = -INFINITY;
#pragma unroll
        for (int k = 0; k < 4; ++k) { s[k] = part[i * 256 + lane + 64 * k] + part[(4 + i) * 256 + lane + 64 * k]; m = fmaxf(m, s[k]); }
        m = wave_max(m, lane);
        float l = 0.f;
#pragma unroll
        for (int k = 0; k < 4; ++k) { const float p = fexp2(s[k] - m); pr[i * 256 + lane + 64 * k] = p; l += p; }
        l = wave_sum(l, lane);
        if (lane == 0) ls[i] = l;
    }
    __syncthreads();
    {
        const int d4 = tid & 31, slot = tid >> 5;
        f32x4 acc[4];
#pragma unroll
        for (int i = 0; i < 4; ++i) acc[i] = (f32x4){0.f, 0.f, 0.f, 0.f};
        f32x4 vv[16];
#pragma unroll
        for (int k = 0; k < 16; ++k) vv[k] = *(const f32x4*)(P.cmem_v + (((size_t)b * NMEM + slot + 16 * k) * 4 + h) * 128 + d4 * 4);
#pragma unroll
        for (int k = 0; k < 16; ++k)
#pragma unroll
            for (int i = 0; i < 4; ++i) acc[i] = acc[i] + vv[k] * pr[i * 256 + slot + 16 * k];
#pragma unroll
        for (int i = 0; i < 4; ++i) *(LAS f32x4*)(red + (slot * 4 + i) * 128 + d4 * 4) = acc[i];
    }
    __syncthreads();
    {
        const int i = tid >> 7, d = tid & 127;
        float s = 0.f;
#pragma unroll
        for (int sl = 0; sl < 16; ++sl) s += red[(sl * 4 + i) * 128 + d];
        const size_t R = (size_t)M_PROMPT + b * 4 + i;
        const float gate = bf2f(HB[R * HP + C_MG + h * 128 + d]);
        MIX[R * DMIX + 1024 + h * 128 + d] = (bf16_t)(pk_bf16(s / ls[i] * gate, 0.f) & 0xffffu);
    }
}

typedef float f32x16 __attribute__((ext_vector_type(16)));
typedef short s16x4 __attribute__((ext_vector_type(4)));
constexpr int SWA_ST_O = 0, SWA_ST_M = 65536, SWA_ST_L = 65536 + 2048, SWA_WV = 69632, SWA_WV_STRIDE = 10240 + 768;
__device__ __forceinline__ s16x4 tr16(LAS unsigned char* p) { return __builtin_bit_cast(s16x4, __builtin_amdgcn_ds_read_tr16_b64_v4i16((LAS s16x4*)p)); }
__device__ __forceinline__ f32x16 mfma32(bf16x8 a, bf16x8 b, f32x16 c) { return __builtin_amdgcn_mfma_f32_32x32x16_bf16(a, b, c, 0, 0, 0); }
#define VM_WAIT() asm volatile("s_waitcnt vmcnt(0)" ::: "memory")

struct SwaT { int dil, r, i0, pat; };
__device__ __forceinline__ SwaT swa_params(int i, int wave, int T0) {
    const int pat = i >> 1, k = wave + 8 * (i & 1);
    SwaT t; t.pat = pat;
    if (pat == 0) { t.dil = 1; t.r = 0; t.i0 = T0 + 32 * k; }
    else if (pat == 1) { t.dil = 4; t.r = k & 3; t.i0 = (T0 >> 2) + 32 * (k >> 2); }
    else { t.dil = 16; t.r = k; t.i0 = T0 >> 4; }
    return t;
}
__device__ __forceinline__ void swa_loadqk(const Params& P, const SwaT& t, int b, int h, int lane, bf16x8 (&qf)[4], bf16x8 (&kf)[5][4]) {
    const bf16_t* HB = (const bf16_t*)(P.ws + WS_HB);
    const int a = lane & 31, hi = lane >> 5;
    const size_t rowbase = (size_t)b * SEQ + t.r;
    { const bf16_t* qp = HB + (rowbase + (size_t)t.dil * (t.i0 + a)) * HP + C_SQ + h * 64 + 8 * hi;
#pragma unroll
      for (int kk = 0; kk < 4; ++kk) qf[kk] = *(const bf16x8*)(qp + 16 * kk); }
#pragma unroll
    for (int j = 0; j < 5; ++j) {
        const int ik0 = t.i0 - 128 + 32 * j + a, ik = ik0 < 0 ? 0 : ik0;
        const bf16_t* kp = HB + (rowbase + (size_t)t.dil * ik) * HP + C_SK + h * 64 + 8 * hi;
#pragma unroll
        for (int kk = 0; kk < 4; ++kk) kf[j][kk] = *(const bf16x8*)(kp + 16 * kk);
    }
}
__device__ __forceinline__ void swa_task(const Params& P, LAS unsigned char* lds, int wave, int lane, int b, int h, const SwaT& tk, int T0,
                                         const bf16x8 (&qf)[4], const bf16x8 (&kf)[5][4], const SwaT& nx, bf16x8 (&qn)[4], bf16x8 (&kn)[5][4], bool bar_before_merge) {
    const bf16_t* HB = (const bf16_t*)(P.ws + WS_HB);
    const int dil = tk.dil, r = tk.r, i0 = tk.i0, pat = tk.pat;
    const int a = lane & 31, hi = lane >> 5;
    LAS unsigned char* vreg = lds + SWA_WV + wave * SWA_WV_STRIDE;
    LAS float* msc = (LAS float*)(vreg + 10240);
    LAS float* lsc = msc + 32;
    const size_t rowbase = (size_t)b * SEQ + r;
    const int jmin = i0 >= 128 ? 0 : ((128 - i0) >> 5);
    const int vrow = ((lane >> 5) << 3) + ((lane >> 2) & 7), vch = lane & 3;
    const int trb = (4 * hi + ((lane & 15) >> 2)) * 64 + ((lane >> 4) & 1) * 32 + (lane & 3) * 8;

#define SWA_DMA_V(db) do { _Pragma("unroll") for (int j = 0; j < 5; ++j) if (j >= jmin) { _Pragma("unroll") for (int it2 = 0; it2 < 2; ++it2) { \
        const int ik = i0 - 128 + 32 * j + 16 * it2 + vrow; \
        __builtin_amdgcn_global_load_lds((const unsigned*)(HB + (rowbase + (size_t)dil * ik) * HP + C_SV + h * 64 + 32 * (db) + 8 * vch), \
                                         (LAS unsigned*)(vreg + j * 2048 + it2 * 1024), 16, 0, 0); } } } while (0)

    LDS_WAIT();
    SWA_DMA_V(0);
    f32x16 S[5];
    float mx4[4] = {-INFINITY, -INFINITY, -INFINITY, -INFINITY};
#pragma unroll
    for (int j = 0; j < 5; ++j) {
        f32x16 acc;
#pragma unroll
        for (int e = 0; e < 16; ++e) acc[e] = 0.f;
#pragma unroll
        for (int kk = 0; kk < 4; ++kk) acc = mfma32(kf[j][kk], qf[kk], acc);
        if (j == 0) {
#pragma unroll
            for (int e = 0; e < 16; ++e) { const int c = (e & 3) + 8 * (e >> 2) + 4 * hi; if (c < a) acc[e] = -INFINITY; }
        }
        if (j == 4) {
#pragma unroll
            for (int e = 0; e < 16; ++e) { const int c = (e & 3) + 8 * (e >> 2) + 4 * hi; if (c > a) acc[e] = -INFINITY; }
        }
        if (j < jmin) {
#pragma unroll
            for (int e = 0; e < 16; ++e) acc[e] = -INFINITY;
        }
#pragma unroll
        for (int e = 0; e < 16; ++e) mx4[e & 3] = fmaxf(mx4[e & 3], acc[e]);
        S[j] = acc;
    }
    asm volatile("" ::: "memory");
    swa_loadqk(P, nx, b, h, lane, qn, kn);
    asm volatile("" ::: "memory");
    float mx = fmaxf(fmaxf(mx4[0], mx4[1]), fmaxf(mx4[2], mx4[3]));
    mx = fmaxf(mx, shx(mx, 32, lane));
    float ls4[4] = {0.f, 0.f, 0.f, 0.f};
    unsigned pa[5][2][4];
#pragma unroll
    for (int j = 0; j < 5; ++j) {
#pragma unroll
        for (int e = 0; e < 16; ++e) { const float p = fexp2(S[j][e] - mx); S[j][e] = p; ls4[e & 3] += p; }
#pragma unroll
        for (int s = 0; s < 2; ++s)
#pragma unroll
            for (int w = 0; w < 4; ++w) pa[j][s][w] = pk_bf16(S[j][8 * s + 2 * w], S[j][8 * s + 2 * w + 1]);
    }
    float lsum = (ls4[0] + ls4[1]) + (ls4[2] + ls4[3]);
    lsum += shx(lsum, 32, lane);
    if (bar_before_merge) __syncthreads();
    LAS float* fsc = msc; LAS float* gsc = msc + 32; LAS float* rsc = msc + 64;
    {
        LAS float* stM = (LAS float*)(lds + SWA_ST_M);
        LAS float* stL = (LAS float*)(lds + SWA_ST_L);
        LDS_WAIT();
        if (hi == 0) {
            const int tok = r + dil * (i0 + a) - T0;
            if (pat == 0) { fsc[a] = 0.f; gsc[a] = 1.f; rsc[a] = 1.f; stM[tok] = mx; stL[tok] = lsum; }
            else {
                const float Mo = stM[tok], Lo = stL[tok];
                const float Mn = fmaxf(Mo, mx);
                const float f = fexp2(Mo - Mn), g = fexp2(mx - Mn);
                const float Ln = Lo * f + lsum * g;
                fsc[a] = f; gsc[a] = g; rsc[a] = 1.0f / Ln;
                if (pat == 1) { stM[tok] = Mn; stL[tok] = Ln; }
            }
        }
        LDS_WAIT();
    }
#pragma unroll
    for (int db = 0; db < 2; ++db) {
        if (db == 0) asm volatile("s_waitcnt vmcnt(24)" ::: "memory"); else VM_WAIT();
        f32x16 O;
#pragma unroll
        for (int e = 0; e < 16; ++e) O[e] = 0.f;
#pragma unroll
        for (int j = 0; j < 5; ++j) if (j >= jmin) {
#pragma unroll
            for (int s = 0; s < 2; ++s) {
                const s16x4 lo = tr16(vreg + j * 2048 + (2 * s) * 512 + trb), hh = tr16(vreg + j * 2048 + (2 * s + 1) * 512 + trb);
                const bf16x8 vb = {lo[0], lo[1], lo[2], lo[3], hh[0], hh[1], hh[2], hh[3]};
                const bf16x8 pf = __builtin_bit_cast(bf16x8, (u32x4){pa[j][s][0], pa[j][s][1], pa[j][s][2], pa[j][s][3]});
                O = mfma32(pf, vb, O);
            }
        }
        if (db == 0) { LDS_WAIT(); SWA_DMA_V(1); }
        LAS bf16_t* stO = (LAS bf16_t*)(lds + SWA_ST_O);
        const int d = 32 * db + a;
#pragma unroll
        for (int g4 = 0; g4 < 4; ++g4) {
            const f32x4 f4 = *(const LAS f32x4*)(fsc + 8 * g4 + 4 * hi), g4v = *(const LAS f32x4*)(gsc + 8 * g4 + 4 * hi), r4 = *(const LAS f32x4*)(rsc + 8 * g4 + 4 * hi);
#pragma unroll
            for (int e4 = 0; e4 < 4; ++e4) {
                const int e = 4 * g4 + e4, c = 8 * g4 + 4 * hi + e4;
                const int tok = r + dil * (i0 + c) - T0;
                if (pat == 0) stO[tok * 64 + d] = (bf16_t)(pk_bf16(O[e], 0.f) & 0xffffu);
                else {
                    const float on = bf2f(stO[tok * 64 + d]) * f4[e4] + O[e] * g4v[e4];
                    stO[tok * 64 + d] = (bf16_t)(pk_bf16(pat == 1 ? on : on * r4[e4], 0.f) & 0xffffu);
                }
            }
        }
    }
#undef SWA_DMA_V
}
__device__ __forceinline__ void swa_unit(const Params& P, LAS unsigned char* lds, int wave, int lane, int b, int h, int chunk) {
    const int T0 = chunk * 512;
    bf16x8 qf[4], kf[5][4];
    SwaT cur = swa_params(0, wave, T0);
    swa_loadqk(P, cur, b, h, lane, qf, kf);
#pragma unroll 1
    for (int i = 0; i < 6; ++i) {
        const SwaT nxt = swa_params(i < 5 ? i + 1 : 5, wave, T0);
        bf16x8 qn[4], kn[5][4];
        swa_task(P, lds, wave, lane, b, h, cur, T0, qf, kf, nxt, qn, kn, i == 2 || i == 4);
#pragma unroll
        for (int kk = 0; kk < 4; ++kk) qf[kk] = qn[kk];
#pragma unroll
        for (int j = 0; j < 5; ++j)
#pragma unroll
            for (int kk = 0; kk < 4; ++kk) kf[j][kk] = kn[j][kk];
        cur = nxt;
    }
    __syncthreads();
    {
        const bf16_t* HB = (const bf16_t*)(P.ws + WS_HB);
        bf16_t* MIX = (bf16_t*)(P.ws + WS_MIX);
        const int tid = wave * 64 + lane, ch = tid & 7;
#pragma unroll
        for (int it = 0; it < 8; ++it) {
            const int tok = (tid >> 3) + 64 * it;
            const size_t row = (size_t)b * SEQ + T0 + tok;
            const u32x4 o = *(const LAS u32x4*)(lds + SWA_ST_O + tok * 128 + ch * 16);
            const u32x4 g = *(const u32x4*)(HB + row * HP + C_SG + h * 64 + ch * 8);
            u32x4 w;
            w.x = pk_bf16(bf_lo(o.x) * bf_lo(g.x), bf_hi(o.x) * bf_hi(g.x)); w.y = pk_bf16(bf_lo(o.y) * bf_lo(g.y), bf_hi(o.y) * bf_hi(g.y));
            w.z = pk_bf16(bf_lo(o.z) * bf_lo(g.z), bf_hi(o.z) * bf_hi(g.z)); w.w = pk_bf16(bf_lo(o.w) * bf_lo(g.w), bf_hi(o.w) * bf_hi(g.w));
            *(u32x4*)(MIX + row * DMIX + 512 + h * 64 + ch * 8) = w;
        }
    }
    __syncthreads();
}

constexpr int MEM_K = 0, MEM_V = 65536, MEM_SC = 131072, MEM_OST = 133120;
__device__ __forceinline__ void mem_unit(const Params& P, LAS unsigned char* lds, int wave, int lane, int b, int h, int qb) {
    const bf16_t* HB = (const bf16_t*)(P.ws + WS_HB);
    const bf16_t* MKV = (const bf16_t*)(P.ws + WS_MKV);
    bf16_t* MIX = (bf16_t*)(P.ws + WS_MIX);
    const int a = lane & 31, hi = lane >> 5;
    __syncthreads();
#pragma unroll
    for (int i = 0; i < 8; ++i) {
        const int pc = wave * 8 + i;
        { const int key = 4 * pc + (lane >> 4), cp = lane & 15;
          __builtin_amdgcn_global_load_lds((const unsigned*)(MKV + ((size_t)b * NMEM + key) * 1024 + h * 128 + 8 * (cp ^ (key & 15))),
                                           (LAS unsigned*)(lds + MEM_K + pc * 1024), 16, 0, 0); }
        { const int key = 8 * (pc >> 1) + ((lane & 31) >> 2), d = 32 * (2 * (pc & 1) + (lane >> 5)) + 8 * (lane & 3);
          __builtin_amdgcn_global_load_lds((const unsigned*)(MKV + ((size_t)b * NMEM + key) * 1024 + 512 + h * 128 + d),
                                           (LAS unsigned*)(lds + MEM_V + pc * 1024), 16, 0, 0); }
    }
    VM_WAIT();
    __syncthreads();
#pragma unroll 1
    for (int q2 = 0; q2 < 2; ++q2) {
    const size_t Rq = (size_t)b * SEQ + (2 * qb + q2) * 256 + wave * 32;
    LAS float* fsc = (LAS float*)(lds + MEM_SC + wave * 256);
    const int trb = (4 * hi + ((lane & 15) >> 2)) * 64 + ((lane >> 4) & 1) * 32 + (lane & 3) * 8;
    f32x16 O[4];
#pragma unroll
    for (int db = 0; db < 4; ++db)
#pragma unroll
        for (int e = 0; e < 16; ++e) O[db][e] = 0.f;
    float M = -INFINITY, L = 0.f;
#pragma unroll 1
    for (int ch = 0; ch < 2; ++ch) {
        bf16x8 qf[8];
        { const bf16_t* qp = HB + (Rq + a) * HP + C_MQ + h * 128 + 8 * hi;
#pragma unroll
          for (int kk = 0; kk < 8; ++kk) qf[kk] = *(const bf16x8*)(qp + 16 * kk); }
        f32x16 S[4];
#pragma unroll
        for (int jt = 0; jt < 4; ++jt) {
            const int key = 32 * (4 * ch + jt) + a;
            f32x16 acc;
#pragma unroll
            for (int e = 0; e < 16; ++e) acc[e] = 0.f;
#pragma unroll
            for (int kk = 0; kk < 8; ++kk) {
                const bf16x8 kf = *(const LAS bf16x8*)(lds + MEM_K + key * 256 + (((2 * kk + hi) ^ (key & 15)) << 4));
                acc = mfma32(kf, qf[kk], acc);
            }
            S[jt] = acc;
        }
        float mc = -INFINITY;
#pragma unroll
        for (int jt = 0; jt < 4; ++jt)
#pragma unroll
            for (int e = 0; e < 16; ++e) mc = fmaxf(mc, S[jt][e]);
        mc = fmaxf(mc, shx(mc, 32, lane));
        const float Mn = fmaxf(M, mc);
        const float f = fexp2(M - Mn);
        float ls = 0.f;
        unsigned pa[4][2][4];
#pragma unroll
        for (int jt = 0; jt < 4; ++jt) {
#pragma unroll
            for (int e = 0; e < 16; ++e) { const float p = fexp2(S[jt][e] - Mn); S[jt][e] = p; ls += p; }
#pragma unroll
            for (int s = 0; s < 2; ++s)
#pragma unroll
                for (int w = 0; w < 4; ++w) pa[jt][s][w] = pk_bf16(S[jt][8 * s + 2 * w], S[jt][8 * s + 2 * w + 1]);
        }
        ls += shx(ls, 32, lane);
        L = L * f + ls; M = Mn;
        if (ch == 1) {
            LDS_WAIT();
            if (hi == 0) fsc[a] = f;
            LDS_WAIT();
#pragma unroll
            for (int g4 = 0; g4 < 4; ++g4) {
                const f32x4 f4 = *(const LAS f32x4*)(fsc + 8 * g4 + 4 * hi);
#pragma unroll
                for (int db = 0; db < 4; ++db)
#pragma unroll
                    for (int e = 0; e < 4; ++e) O[db][4 * g4 + e] *= f4[e];
            }
        }
#pragma unroll
        for (int jt = 0; jt < 4; ++jt)
#pragma unroll
            for (int s = 0; s < 2; ++s) {
                const bf16x8 pf = __builtin_bit_cast(bf16x8, (u32x4){pa[jt][s][0], pa[jt][s][1], pa[jt][s][2], pa[jt][s][3]});
                const int st0 = (4 * (4 * ch + jt) + 2 * s) * 4;
#pragma unroll
                for (int db = 0; db < 4; ++db) {
                    const s16x4 lo = tr16(lds + MEM_V + (st0 + db) * 512 + trb), hh = tr16(lds + MEM_V + (st0 + 4 + db) * 512 + trb);
                    const bf16x8 vb = {lo[0], lo[1], lo[2], lo[3], hh[0], hh[1], hh[2], hh[3]};
                    O[db] = mfma32(pf, vb, O[db]);
                }
            }
    }
    LDS_WAIT();
    if (hi == 0) fsc[32 + a] = 1.0f / L;
    LDS_WAIT();
    {
        LAS bf16_t* ost = (LAS bf16_t*)(lds + MEM_OST + wave * 2048);
        f32x4 r4[4];
#pragma unroll
        for (int g4 = 0; g4 < 4; ++g4) r4[g4] = *(const LAS f32x4*)(fsc + 32 + 8 * g4 + 4 * hi);
#pragma unroll
        for (int db = 0; db < 4; ++db) {
#pragma unroll
            for (int g4 = 0; g4 < 4; ++g4)
#pragma unroll
                for (int e = 0; e < 4; ++e) ost[(8 * g4 + 4 * hi + e) * 32 + a] = (bf16_t)(pk_bf16(O[db][4 * g4 + e] * r4[g4][e], 0.f) & 0xffffu);
            LDS_WAIT();
#pragma unroll
            for (int it = 0; it < 2; ++it) {
                const int q = (lane >> 2) + 16 * it, ch = lane & 3;
                const size_t row = Rq + q;
                const u32x4 o = *(const LAS u32x4*)(ost + q * 32 + ch * 8);
                const u32x4 g = *(const u32x4*)(HB + row * HP + C_MG + h * 128 + 32 * db + ch * 8);
                u32x4 w;
                w.x = pk_bf16(bf_lo(o.x) * bf_lo(g.x), bf_hi(o.x) * bf_hi(g.x)); w.y = pk_bf16(bf_lo(o.y) * bf_lo(g.y), bf_hi(o.y) * bf_hi(g.y));
                w.z = pk_bf16(bf_lo(o.z) * bf_lo(g.z), bf_hi(o.z) * bf_hi(g.z)); w.w = pk_bf16(bf_lo(o.w) * bf_lo(g.w), bf_hi(o.w) * bf_hi(g.w));
                *(u32x4*)(MIX + row * DMIX + 1024 + h * 128 + 32 * db + ch * 8) = w;
            }
            LDS_WAIT();
        }
    }
    }
}

constexpr int RT_Q = 0, RT_K = 16384, RT_KD = 32768, RT_V = 49152, RT_R = 81920, RT_O = 98304;
constexpr size_t WS_KVC = 272 * MiB;
__device__ __forceinline__ void ra_unit(const Params& P, LAS unsigned char* lds, int wave, int lane, int tid, int b, int h, int n) {
    const bf16_t* HB = (const bf16_t*)(P.ws + WS_HB);
    float* KVC = (float*)(P.ws + WS_KVC);
    const float gamma = 1.0f - __builtin_amdgcn_exp2f((float)(-5 - h));
    const float lg2 = __builtin_log2f(gamma);
    const int a = lane & 31, hi = lane >> 5, tq = (lane & 15) >> 2, tp = lane & 3, tg = (lane >> 4) & 1;
    const int dkt = wave & 1, dvt = wave >> 1;
    const size_t base = (size_t)b * SEQ + 128 * n;
    u32x4 pk[2], pv[4];
#pragma unroll
    for (int i = 0; i < 2; ++i) { const int idx = tid + 512 * i, row = idx >> 3, ch = idx & 7; pk[i] = *(const u32x4*)(HB + (base + row) * HP + C_RK + h * 64 + ch * 8); }
#pragma unroll
    for (int i = 0; i < 4; ++i) { const int idx = tid + 512 * i, row = idx >> 4, ch = idx & 15; pv[i] = *(const u32x4*)(HB + (base + row) * HP + C_RV + h * 128 + ch * 8); }
    __syncthreads();
#pragma unroll
    for (int i = 0; i < 2; ++i) {
        const int idx = tid + 512 * i, row = idx >> 3, ch = idx & 7;
        const float fac = fexp2((float)(127 - row) * lg2);
        u32x4 kd;
        kd.x = pk_bf16(bf_lo(pk[i].x) * fac, bf_hi(pk[i].x) * fac); kd.y = pk_bf16(bf_lo(pk[i].y) * fac, bf_hi(pk[i].y) * fac);
        kd.z = pk_bf16(bf_lo(pk[i].z) * fac, bf_hi(pk[i].z) * fac); kd.w = pk_bf16(bf_lo(pk[i].w) * fac, bf_hi(pk[i].w) * fac);
        *(LAS u32x4*)(lds + RT_KD + ((row >> 3) * 2 + (ch >> 2)) * 512 + (row & 7) * 64 + (ch & 3) * 16) = kd;
    }
#pragma unroll
    for (int i = 0; i < 4; ++i) {
        const int idx = tid + 512 * i, row = idx >> 4, ch = idx & 15;
        *(LAS u32x4*)(lds + RT_V + ((row >> 3) * 4 + (ch >> 2)) * 512 + (row & 7) * 64 + (ch & 3) * 16) = pv[i];
    }
    __syncthreads();
    f32x16 Rt;
#pragma unroll
    for (int e = 0; e < 16; ++e) Rt[e] = 0.f;
#pragma unroll
    for (int s = 0; s < 8; ++s) {
        LAS unsigned char* ka = lds + RT_KD + ((2 * s + hi) * 2 + dkt) * 512 + tq * 64 + tg * 32 + tp * 8;
        LAS unsigned char* va = lds + RT_V + ((2 * s + hi) * 4 + dvt) * 512 + tq * 64 + tg * 32 + tp * 8;
        const s16x4 k0 = tr16(ka), k1 = tr16(ka + 256), v0 = tr16(va), v1 = tr16(va + 256);
        const bf16x8 af = {k0[0], k0[1], k0[2], k0[3], k1[0], k1[1], k1[2], k1[3]};
        const bf16x8 bfv = {v0[0], v0[1], v0[2], v0[3], v1[0], v1[1], v1[2], v1[3]};
        Rt = mfma32(af, bfv, Rt);
    }
    float* dst = KVC + ((size_t)((b * 4 + h) * 16 + n)) * 8192 + 32 * dvt + a;
#pragma unroll
    for (int e = 0; e < 16; ++e) dst[(32 * dkt + (e & 3) + 8 * (e >> 2) + 4 * hi) * 128] = Rt[e];
}
__device__ __forceinline__ void rb_unit(const Params& P, LAS unsigned char* lds, int wave, int lane, int tid, int b, int h, int n) {
    const bf16_t* HB = (const bf16_t*)(P.ws + WS_HB);
    bf16_t* MIX = (bf16_t*)(P.ws + WS_MIX);
    const float* KVC = (const float*)(P.ws + WS_KVC) + ((size_t)((b * 4 + h) * 16)) * 8192;
    const float gamma = 1.0f - __builtin_amdgcn_exp2f((float)(-5 - h));
    const float lg2 = __builtin_log2f(gamma);
    const int a = lane & 31, hi = lane >> 5, tq = (lane & 15) >> 2, tp = lane & 3, tg = (lane >> 4) & 1;
    const int qg = wave & 3, dh = wave >> 2;
    const size_t base = (size_t)b * SEQ + 128 * n;
    u32x4 pq[2], pk[2], pv[4];
#pragma unroll
    for (int i = 0; i < 2; ++i) { const int idx = tid + 512 * i, row = idx >> 3, ch = idx & 7;
        pq[i] = *(const u32x4*)(HB + (base + row) * HP + C_RQ + h * 64 + ch * 8); pk[i] = *(const u32x4*)(HB + (base + row) * HP + C_RK + h * 64 + ch * 8); }
#pragma unroll
    for (int i = 0; i < 4; ++i) { const int idx = tid + 512 * i, row = idx >> 4, ch = idx & 15; pv[i] = *(const u32x4*)(HB + (base + row) * HP + C_RV + h * 128 + ch * 8); }
    const float g128 = fexp2(128.0f * lg2);
    f32x4 rr[4];
#pragma unroll
    for (int i = 0; i < 4; ++i) rr[i] = (f32x4){0.f, 0.f, 0.f, 0.f};
    const int dv4 = 4 * (tid & 31), dkb = tid >> 5;
    {
        const int nb4 = (n + 3) >> 2, c00 = n - 4 * nb4;
#pragma unroll 1
        for (int bq = 0; bq < nb4; ++bq) {
            f32x4 t[4][4];
#pragma unroll
            for (int k = 0; k < 4; ++k) {
                const int c = c00 + 4 * bq + k, cc = c < 0 ? 0 : c;
                const float* src = KVC + (size_t)cc * 8192 + dkb * 128 + dv4;
#pragma unroll
                for (int i = 0; i < 4; ++i) t[k][i] = *(const f32x4*)(src + 16 * i * 128);
            }
#pragma unroll
            for (int k = 0; k < 4; ++k) {
                const float wgt = (c00 + 4 * bq + k) < 0 ? 0.f : 1.f;
#pragma unroll
                for (int i = 0; i < 4; ++i) rr[i] = rr[i] * g128 + t[k][i] * wgt;
            }
        }
    }
    if (n == 15) {
        const float* src = KVC + (size_t)15 * 8192 + dkb * 128 + dv4;
#pragma unroll
        for (int i = 0; i < 4; ++i) {
            const f32x4 t = *(const f32x4*)(src + 16 * i * 128);
            *(f32x4*)(P.out + O_RP + ((size_t)((b * 4 + h) * 64 + dmap(dkb + 16 * i))) * 128 + dv4) = rr[i] * g128 + t;
        }
    }
    __syncthreads();
#pragma unroll
    for (int i = 0; i < 4; ++i) {
        const int dk = dkb + 16 * i;
#pragma unroll
        for (int e = 0; e < 4; ++e) { const int dv = dv4 + e; *(LAS bf16_t*)(lds + RT_R + dv * 128 + (((dk >> 3) ^ (dv & 7)) << 4) + (dk & 7) * 2) = (bf16_t)(pk_bf16(rr[i][e], 0.f) & 0xffffu); }
    }
#pragma unroll
    for (int i = 0; i < 2; ++i) {
        const int idx = tid + 512 * i, row = idx >> 3, ch = idx & 7;
        *(LAS u32x4*)(lds + RT_Q + row * 128 + ((ch ^ (row & 7)) << 4)) = pq[i];
        *(LAS u32x4*)(lds + RT_K + row * 128 + ((ch ^ (row & 7)) << 4)) = pk[i];
    }
#pragma unroll
    for (int i = 0; i < 4; ++i) {
        const int idx = tid + 512 * i, row = idx >> 4, ch = idx & 15;
        *(LAS u32x4*)(lds + RT_V + ((row >> 3) * 4 + (ch >> 2)) * 512 + (row & 7) * 64 + (ch & 3) * 16) = pv[i];
    }
    __syncthreads();
    f32x16 O[2];
    bf16x8 qfr[4];
#pragma unroll
    for (int kk = 0; kk < 4; ++kk) { const int row = 32 * qg + a; qfr[kk] = *(const LAS bf16x8*)(lds + RT_Q + row * 128 + (((2 * kk + hi) ^ (row & 7)) << 4)); }
    if (n > 0) {
#pragma unroll
        for (int dt = 0; dt < 2; ++dt) {
            f32x16 X;
#pragma unroll
            for (int e = 0; e < 16; ++e) X[e] = 0.f;
            const int dv = 32 * (2 * dh + dt) + a;
#pragma unroll
            for (int kk = 0; kk < 4; ++kk) {
                const bf16x8 rf = *(const LAS bf16x8*)(lds + RT_R + dv * 128 + (((2 * kk + hi) ^ (dv & 7)) << 4));
                X = mfma32(qfr[kk], rf, X);
            }
#pragma unroll
            for (int e = 0; e < 16; ++e) { const int c = (e & 3) + 8 * (e >> 2) + 4 * hi; O[dt][e] = X[e] * fexp2((float)(32 * qg + c + 1) * lg2); }
        }
    } else {
#pragma unroll
        for (int dt = 0; dt < 2; ++dt)
#pragma unroll
            for (int e = 0; e < 16; ++e) O[dt][e] = 0.f;
    }
#pragma unroll
    for (int j = 0; j < 4; ++j) if (j <= qg) {
        f32x16 S;
#pragma unroll
        for (int e = 0; e < 16; ++e) S[e] = 0.f;
#pragma unroll
        for (int kk = 0; kk < 4; ++kk) {
            const int row = 32 * j + a;
            const bf16x8 kf = *(const LAS bf16x8*)(lds + RT_K + row * 128 + (((2 * kk + hi) ^ (row & 7)) << 4));
            S = mfma32(kf, qfr[kk], S);
        }
        unsigned pa[2][4];
#pragma unroll
        for (int e = 0; e < 16; ++e) {
            const int c = (e & 3) + 8 * (e >> 2) + 4 * hi;
            const int diff = 32 * (qg - j) + a - c;
            S[e] = diff >= 0 ? S[e] * fexp2((float)diff * lg2) : 0.f;
        }
#pragma unroll
        for (int s = 0; s < 2; ++s)
#pragma unroll
            for (int w = 0; w < 4; ++w) pa[s][w] = pk_bf16(S[8 * s + 2 * w], S[8 * s + 2 * w + 1]);
#pragma unroll
        for (int s = 0; s < 2; ++s) {
            const bf16x8 pf = __builtin_bit_cast(bf16x8, (u32x4){pa[s][0], pa[s][1], pa[s][2], pa[s][3]});
#pragma unroll
            for (int dt = 0; dt < 2; ++dt) {
                LAS unsigned char* vb_ = lds + RT_V + ((4 * j + 2 * s) * 4 + (2 * dh + dt)) * 512 + (4 * hi + tq) * 64 + tg * 32 + tp * 8;
                const s16x4 lo = tr16(vb_), hh = tr16(vb_ + 4 * 512);
                const bf16x8 vb = {lo[0], lo[1], lo[2], lo[3], hh[0], hh[1], hh[2], hh[3]};
                O[dt] = mfma32(pf, vb, O[dt]);
            }
        }
    }
    {
        LAS bf16_t* Ob = (LAS bf16_t*)(lds + RT_O);
#pragma unroll
        for (int dt = 0; dt < 2; ++dt)
#pragma unroll
            for (int e = 0; e < 16; ++e) { const int c = (e & 3) + 8 * (e >> 2) + 4 * hi; Ob[(32 * qg + c) * 128 + 32 * (2 * dh + dt) + a] = (bf16_t)(pk_bf16(O[dt][e], 0.f) & 0xffffu); }
    }
    __syncthreads();
    {
        const int tok = tid >> 2, part = tid & 3;
        const LAS u32x4* op = (const LAS u32x4*)(lds + RT_O + tok * 256 + part * 64);
        float o[32]; float sm = 0.f;
#pragma unroll
        for (int c4 = 0; c4 < 4; ++c4) {
            const u32x4 w = op[c4];
            o[8 * c4 + 0] = bf_lo(w.x); o[8 * c4 + 1] = bf_hi(w.x); o[8 * c4 + 2] = bf_lo(w.y); o[8 * c4 + 3] = bf_hi(w.y);
            o[8 * c4 + 4] = bf_lo(w.z); o[8 * c4 + 5] = bf_hi(w.z); o[8 * c4 + 6] = bf_lo(w.w); o[8 * c4 + 7] = bf_hi(w.w);
        }
#pragma unroll
        for (int e = 0; e < 32; ++e) sm += o[e];
        sm += shx(sm, 1, lane); sm += shx(sm, 2, lane);
        const float mean = sm * (1.0f / 128.0f);
        float qq = 0.f;
#pragma unroll
        for (int e = 0; e < 32; ++e) { o[e] -= mean; qq += o[e] * o[e]; }
        qq += shx(qq, 1, lane); qq += shx(qq, 2, lane);
        const float rstd = 1.0f / sqrtf(qq * (1.0f / 128.0f) + 1e-5f);
        const size_t row = base + tok;
        const u32x4* gp = (const u32x4*)(HB + row * HP + C_RG + h * 128 + part * 32);
        u32x4* mp = (u32x4*)(MIX + row * DMIX + h * 128 + part * 32);
#pragma unroll
        for (int c4 = 0; c4 < 4; ++c4) {
            const u32x4 g = gp[c4]; u32x4 w;
            w.x = pk_bf16(o[8 * c4 + 0] * rstd * bf_lo(g.x), o[8 * c4 + 1] * rstd * bf_hi(g.x)); w.y = pk_bf16(o[8 * c4 + 2] * rstd * bf_lo(g.y), o[8 * c4 + 3] * rstd * bf_hi(g.y));
            w.z = pk_bf16(o[8 * c4 + 4] * rstd * bf_lo(g.z), o[8 * c4 + 5] * rstd * bf_hi(g.z)); w.w = pk_bf16(o[8 * c4 + 6] * rstd * bf_lo(g.w), o[8 * c4 + 7] * rstd * bf_hi(g.w));
            mp[c4] = w;
        }
    }
}

#define XB_TMO      128
#define XB_XCNT(j)  (256  + 64 * (j))
#define XB_XSUB(j)  (1280 + 64 * (j))
#define XB_XGEN(j)  (2304 + 64 * (j))
#define XB_TOP      3328
#define XB_TOPGEN   3392
#define XCD_BAR_WORDS 3456
#define XB_SPIN_CAP (1u << 18)

__device__ __forceinline__ unsigned xb_ld(unsigned* p)              { return __hip_atomic_load(p, __ATOMIC_RELAXED, __HIP_MEMORY_SCOPE_AGENT); }
__device__ __forceinline__ unsigned xb_add(unsigned* p, unsigned v) { return __hip_atomic_fetch_add(p, v, __ATOMIC_RELAXED, __HIP_MEMORY_SCOPE_AGENT); }
__device__ __forceinline__ unsigned xb_xcc_id() { return (unsigned)__builtin_amdgcn_s_getreg((3 << 11) | 20) & 0xFu; }
#define XB_SPIN(cond, bar) do { unsigned _sp = 0; while (cond) { __builtin_amdgcn_s_sleep(1); \
    if ((++_sp & 255u) == 0u) { if (xb_ld(&(bar)[XB_TMO])) break; if (_sp > XB_SPIN_CAP) { atomicAdd(&(bar)[XB_TMO], 1u); break; } } } } while (0)

struct XcdBarrier {
    unsigned* bar; unsigned x;
    volatile LAS unsigned* st;
};

__device__ __forceinline__ XcdBarrier xcd_barrier_post(unsigned* bar, volatile LAS unsigned* st, bool leader) {
    XcdBarrier b; b.bar = bar; b.x = xb_xcc_id(); b.st = st;
    if (leader) (void)xb_add(&bar[XB_XCNT(b.x)], 1u);
    return b;
}
__device__ __forceinline__ void xcd_barrier_complete(unsigned* bar, unsigned x, unsigned& nloc, unsigned& nx) {
    const unsigned G = gridDim.x * gridDim.y * gridDim.z;
    unsigned sum, cnt, mine, sp = 0u;
    for (;;) {
        sum = 0u; cnt = 0u; mine = 0u;
#pragma unroll
        for (unsigned j = 0; j < 16; ++j) { const unsigned c = xb_ld(&bar[XB_XCNT(j)]); sum += c; cnt += (c > 0u) ? 1u : 0u; mine = (j == x) ? c : mine; }
        if (sum == G) break;
        __builtin_amdgcn_s_sleep(1);
        if ((++sp & 255u) == 0u) { if (xb_ld(&bar[XB_TMO])) break; if (sp > XB_SPIN_CAP) { atomicAdd(&bar[XB_TMO], 1u); break; } }
    }
    nloc = mine > 0u ? mine : 1u; nx = cnt > 0u ? cnt : 1u;
}

__device__ __forceinline__ void xcd_barrier(const XcdBarrier& b, bool leader) {
    asm volatile("s_waitcnt vmcnt(0)" ::: "memory");
    __syncthreads();
    if (leader) {
        unsigned* bar = b.bar;
        __builtin_amdgcn_s_waitcnt(0);
        unsigned nloc = b.st[0], nx = b.st[1];
        if (nloc == 0u) { xcd_barrier_complete(bar, b.x, nloc, nx); b.st[0] = nloc; b.st[1] = nx; }
        const unsigned old = xb_add(&bar[XB_XSUB(b.x)], 1u);
        const unsigned gen = old / nloc;
        if (old + 1u == (gen + 1u) * nloc) {
            __builtin_amdgcn_fence(__ATOMIC_RELEASE, "agent");
            asm volatile("s_waitcnt vmcnt(0)" ::: "memory");
            const unsigned og = xb_add(&bar[XB_TOP], 1u);
            const unsigned tg = og / nx;
            if (og + 1u == (tg + 1u) * nx) xb_add(&bar[XB_TOPGEN], 1u);
            else XB_SPIN(xb_ld(&bar[XB_TOPGEN]) == tg, bar);
            __builtin_amdgcn_fence(__ATOMIC_ACQUIRE, "agent");
            xb_add(&bar[XB_XGEN(b.x)], 1u);
            asm volatile("s_waitcnt vmcnt(0)" ::: "memory");
        } else {
            XB_SPIN(xb_ld(&bar[XB_XGEN(b.x)]) == gen, bar);
            __builtin_amdgcn_fence(__ATOMIC_ACQUIRE, "agent");
            asm volatile("s_waitcnt vmcnt(0)" ::: "memory");
        }
    }
    __syncthreads();
}

constexpr int P3_A = 131072, P3_RED = 143360;
__device__ __forceinline__ int hswz(int x) { return (0x78 >> (2 * x)) & 3; }
__device__ __forceinline__ void p3_unit(const Params& P, LAS unsigned char* lds, int wave, int lane, int u) {
    const bf16_t* MIX = (const bf16_t*)(P.ws + WS_MIX);
    const bf16_t* WT = (const bf16_t*)(P.ws + WS_WTOUT);
    const int fr = lane & 15, fq = lane >> 4;
    const size_t row0 = (size_t)64 * u;
    const int rl = lane >> 2, chs = (lane & 3) ^ hswz((rl >> 2) & 3);
    const bf16_t* bsrc = WT + (size_t)(128 * wave + rl) * DMIX + 8 * chs;
    const bf16_t* asrc = MIX + (row0 + 16 * (wave & 3) + rl) * DMIX + 8 * chs;
    LAS unsigned char* bdst = lds + wave * 16384;
    LAS unsigned char* adst = lds + P3_A + (wave & 3) * 1024;
    const int offl = fr * 64 + ((fq ^ hswz((fr >> 2) & 3)) << 4);
    f32x4 acc[4][8];
#pragma unroll
    for (int m = 0; m < 4; ++m)
#pragma unroll
        for (int n = 0; n < 8; ++n) acc[m][n] = (f32x4){0.f, 0.f, 0.f, 0.f};
#define P3_ISSUE(s_, bb_, ab_) do { _Pragma("unroll") for (int i = 0; i < 8; ++i) \
        __builtin_amdgcn_global_load_lds((const unsigned*)(bsrc + (size_t)16 * i * DMIX + 32 * (s_)), (LAS unsigned*)(bdst + (bb_) * 8192 + i * 1024), 16, 0, 0); \
        if (wave < 4) __builtin_amdgcn_global_load_lds((const unsigned*)(asrc + 32 * (s_)), (LAS unsigned*)(adst + (ab_) * 4096), 16, 0, 0); } while (0)
    __builtin_amdgcn_s_barrier();
    P3_ISSUE(0, 0, 0);
    int ab = 0;
#pragma unroll 1
    for (int s = 0; s < 48; ++s) {
        const int bb = s & 1, abn = (ab == 2) ? 0 : ab + 1;
        asm volatile("s_waitcnt lgkmcnt(0)" ::: "memory");
        if (s + 1 < 48) {
            P3_ISSUE(s + 1, bb ^ 1, abn);
            if (wave < 4) asm volatile("s_waitcnt vmcnt(9)" ::: "memory"); else asm volatile("s_waitcnt vmcnt(8)" ::: "memory");
        } else asm volatile("s_waitcnt vmcnt(0)" ::: "memory");
        __builtin_amdgcn_s_barrier();
        asm volatile("" ::: "memory");
        bf16x8 Af[4], Bf[8];
#pragma unroll
        for (int m = 0; m < 4; ++m) Af[m] = *(const LAS bf16x8*)(lds + P3_A + ab * 4096 + m * 1024 + offl);
#pragma unroll
        for (int n = 0; n < 8; ++n) Bf[n] = *(const LAS bf16x8*)(bdst + bb * 8192 + n * 1024 + offl);
#pragma unroll
        for (int m = 0; m < 4; ++m)
#pragma unroll
            for (int n = 0; n < 8; ++n) acc[m][n] = __builtin_amdgcn_mfma_f32_16x16x32_bf16(Bf[n], Af[m], acc[m][n], 0, 0, 0);
        ab = abn;
    }
#undef P3_ISSUE
    const float* xb = P.x_prompt + row0 * DM + 128 * wave + 4 * fq;
    float* yb = P.out + O_YP + row0 * DM + 128 * wave + 4 * fq;
    LAS float* red = (LAS float*)(lds + P3_RED);
    float mean[4], rstd[4];
#pragma unroll
    for (int m = 0; m < 4; ++m) {
        f32x4 xv[8];
#pragma unroll
        for (int n = 0; n < 8; ++n) xv[n] = *(const f32x4*)(xb + (size_t)(16 * m + fr) * DM + 16 * n);
        float s = 0.f;
#pragma unroll
        for (int n = 0; n < 8; ++n) { acc[m][n] = acc[m][n] + xv[n] * ALPHA; s += (acc[m][n][0] + acc[m][n][1]) + (acc[m][n][2] + acc[m][n][3]); }
        s += shx(s, 16, lane); s += shx(s, 32, lane);
        if (fq == 0) red[(16 * m + fr) * 8 + wave] = s;
    }
    asm volatile("s_waitcnt lgkmcnt(0)" ::: "memory"); __builtin_amdgcn_s_barrier(); asm volatile("" ::: "memory");
#pragma unroll
    for (int m = 0; m < 4; ++m) {
        const f32x4 r0 = *(const LAS f32x4*)(red + (16 * m + fr) * 8), r1 = *(const LAS f32x4*)(red + (16 * m + fr) * 8 + 4);
        mean[m] = ((r0[0] + r0[1]) + (r0[2] + r0[3]) + (r1[0] + r1[1]) + (r1[2] + r1[3])) * (1.0f / DM);
    }
    asm volatile("s_waitcnt lgkmcnt(0)" ::: "memory"); __builtin_amdgcn_s_barrier(); asm volatile("" ::: "memory");
#pragma unroll
    for (int m = 0; m < 4; ++m) {
        float q = 0.f;
#pragma unroll
        for (int n = 0; n < 8; ++n) { acc[m][n] = acc[m][n] - mean[m]; q += (acc[m][n][0] * acc[m][n][0] + acc[m][n][1] * acc[m][n][1]) + (acc[m][n][2] * acc[m][n][2] + acc[m][n][3] * acc[m][n][3]); }
        q += shx(q, 16, lane); q += shx(q, 32, lane);
        if (fq == 0) red[(16 * m + fr) * 8 + wave] = q;
    }
    asm volatile("s_waitcnt lgkmcnt(0)" ::: "memory"); __builtin_amdgcn_s_barrier(); asm volatile("" ::: "memory");
#pragma unroll
    for (int m = 0; m < 4; ++m) {
        const f32x4 r0 = *(const LAS f32x4*)(red + (16 * m + fr) * 8), r1 = *(const LAS f32x4*)(red + (16 * m + fr) * 8 + 4);
        rstd[m] = 1.0f / sqrtf(((r0[0] + r0[1]) + (r0[2] + r0[3]) + (r1[0] + r1[1]) + (r1[2] + r1[3])) * (1.0f / DM) + 1e-5f);
    }
#pragma unroll
    for (int n = 0; n < 8; ++n) {
        const f32x4 g4 = *(const f32x4*)(P.ln_g + 128 * wave + 16 * n + 4 * fq), b4 = *(const f32x4*)(P.ln_b + 128 * wave + 16 * n + 4 * fq);
#pragma unroll
        for (int m = 0; m < 4; ++m) *(f32x4*)(yb + (size_t)(16 * m + fr) * DM + 16 * n) = acc[m][n] * rstd[m] * g4 + b4;
    }
    asm volatile("s_waitcnt lgkmcnt(0)" ::: "memory"); __builtin_amdgcn_s_barrier(); asm volatile("" ::: "memory");
}
__device__ __forceinline__ void p3_sample_slice(const Params& P, int wave, int lane, int sl) {
    const bf16_t* MIX = (const bf16_t*)(P.ws + WS_MIX);
    const bf16_t* WT = (const bf16_t*)(P.ws + WS_WTOUT);
    const int fr = lane & 15, fq = lane >> 4;
    const bf16_t* ap = MIX + ((size_t)M_PROMPT + 16 * wave + fr) * DMIX + 8 * fq;
    const bf16_t* bp = WT + (size_t)(16 * sl + fr) * DMIX + 8 * fq;
    f32x4 acc = {0.f, 0.f, 0.f, 0.f};
#pragma unroll 8
    for (int s = 0; s < 48; ++s) acc = __builtin_amdgcn_mfma_f32_16x16x32_bf16(*(const bf16x8*)(bp + 32 * s), *(const bf16x8*)(ap + 32 * s), acc, 0, 0, 0);
    const size_t r = (size_t)M_PROMPT + 16 * wave + fr; const int c = 16 * sl + 4 * fq;
    const u32x2 xv = *(const u32x2*)((const bf16_t*)(P.ws + WS_XB) + r * DM + c);
    u32x2 w; w.x = pk_bf16(bf_lo(xv.x) * ALPHA + acc[0], bf_hi(xv.x) * ALPHA + acc[1]); w.y = pk_bf16(bf_lo(xv.y) * ALPHA + acc[2], bf_hi(xv.y) * ALPHA + acc[3]);
    *(u32x2*)((bf16_t*)(P.ws + WS_Z) + r * DM + c) = w;
}

struct P1Order {
    int G, c;
    __device__ __forceinline__ bool next(int i, pg8::Unit& u) const {
        const int L = i * G + c;
        if (L >= 1202) return false;
        if (L < 1170) {
            constexpr int nM = 65, nN = 18, nwg = 1170, q = nwg / 8, r = nwg % 8, WGM = 8;
            const int xcd = L % 8, off = L / 8;
            const int wgid = (xcd < r ? xcd * (q + 1) : r * (q + 1) + (xcd - r) * q) + off;
            const int nig = WGM * nN, gid = wgid / nig, fm = gid * WGM, gsz = (nM - fm) < WGM ? (nM - fm) : WGM;
            u.pm = fm + ((wgid % nig) % gsz); u.pn = (wgid % nig) / gsz;
        } else { const int v = L - 1170; u.pm = 65 + (v >> 2); u.pn = 18 + (v & 3); }
        return true;
    }
    __device__ __forceinline__ void a_ready(const pg8::Unit&) const {}
    __device__ __forceinline__ void done(const pg8::Unit&) const {}
};
struct P1Epi {
    static constexpr bool PERM = false, AFTER_DRAIN = false;
    Params P;
    __device__ __forceinline__ void operator()(const f32x4 (&acc)[2][2][4][2], const pg8::Unit& u, int wr, int wc, int fr, int fq) const {
        if (u.pm < 65) epi_inproj(acc, u.pm, u.pn, P, wr, wc, fr, fq);
        else epi_memkv(acc, u.pm - 65, u.pn - 18, P, wr, wc, fr, fq);
    }
};
struct P3Order {
    int G, c;
    __device__ __forceinline__ bool next(int i, pg8::Unit& u) const { const int L = i * G + c; if (L >= 256) return false; u.pm = L >> 2; u.pn = L & 3; return true; }
    __device__ __forceinline__ void a_ready(const pg8::Unit&) const {}
    __device__ __forceinline__ void done(const pg8::Unit&) const {}
};
struct P3Epi {
    static constexpr bool PERM = false, AFTER_DRAIN = false;
    Params P;
    __device__ __forceinline__ void operator()(const f32x4 (&acc)[2][2][4][2], const pg8::Unit& u, int wr, int wc, int fr, int fq) const { epi_outproj(acc, u.pm, u.pn, P, wr, wc, fr, fq); }
};

constexpr int PRM_OFF = LDS_BYTES - 16 - 128;
__device__ __forceinline__ const void* ld_ptr(LAS unsigned char* lds, int i) {
    volatile LAS unsigned* w = (volatile LAS unsigned*)(lds + PRM_OFF);
    const unsigned lo = (unsigned)__builtin_amdgcn_readfirstlane((int)w[2 * i]), hi = (unsigned)__builtin_amdgcn_readfirstlane((int)w[2 * i + 1]);
    return (const void*)(__attribute__((address_space(1))) const void*)(((unsigned long long)hi << 32) | lo);
}
__device__ __forceinline__ Params load_params(LAS unsigned char* lds) {
    Params P;
    P.x_prompt = (const float*)ld_ptr(lds, 0); P.x_sample = (const float*)ld_ptr(lds, 1); P.state_ret = (const float*)ld_ptr(lds, 2);
    P.cache_k = (const float*)ld_ptr(lds, 3); P.cache_v = (const float*)ld_ptr(lds, 4); P.cmem_k = (const float*)ld_ptr(lds, 5);
    P.cmem_v = (const float*)ld_ptr(lds, 6); P.mem_prompt = (const float*)ld_ptr(lds, 7); P.w_in = (const float*)ld_ptr(lds, 8);
    P.w_mkv = (const float*)ld_ptr(lds, 9); P.w_out = (const float*)ld_ptr(lds, 10); P.ln_g = (const float*)ld_ptr(lds, 11);
    P.ln_b = (const float*)ld_ptr(lds, 12); P.out = (float*)ld_ptr(lds, 13); P.ws = (unsigned char*)ld_ptr(lds, 14);
    return P;
}

#ifndef PROBE
#define PROBE 0
#endif
#ifndef DIAG
#define DIAG 0
#endif
#if DIAG
#define STAMP(k) do { if (blockIdx.x == 0 && TID() == 0) ((LAS unsigned long long*)(lds + LDS_BYTES - 256))[k] = __builtin_amdgcn_s_memrealtime(); } while (0)
#else
#define STAMP(k) do {} while (0)
#endif
__global__ void __launch_bounds__(512, 2) fwd_kernel(Params Pk) {
    extern __shared__ __attribute__((aligned(16))) unsigned char lds_raw[];
    LAS unsigned char* lds = (LAS unsigned char*)lds_raw;
    const int wave = __builtin_amdgcn_readfirstlane((int)(threadIdx.x >> 6));
#define TID() (wave * 64 + lane_id())
    const int tid = TID(), lane = tid & 63;
    const int wr = wave >> 2, wc = wave & 3, fr = lane & 15, fq = lane >> 4;
    const int G = gridDim.x;
    if (tid < 4) ((LAS unsigned*)(lds + LDS_BYTES - 16))[tid] = 0u;
    if (tid >= 64 && tid < 94) ((LAS unsigned*)(lds + PRM_OFF))[tid - 64] = ((const unsigned*)__builtin_amdgcn_kernarg_segment_ptr())[tid - 64];
    __syncthreads();
    (void)xcd_barrier_post((unsigned*)((unsigned char*)ld_ptr(lds, 14) + WS_CTL) + 4096, (volatile LAS unsigned*)(lds + LDS_BYTES - 16), TID() == 0);
#define GRID_BAR() do { XcdBarrier bb_; bb_.bar = (unsigned*)((unsigned char*)ld_ptr(lds, 14) + WS_CTL) + 4096; bb_.x = xb_xcc_id(); \
        bb_.st = (volatile LAS unsigned*)(lds + LDS_BYTES - 16); xcd_barrier(bb_, TID() == 0); } while (0)

    STAMP(0);
    for (int rep0 = 0; rep0 < (PROBE == 10 ? 2 : 1); ++rep0) { const Params P = load_params(lds); phase0(P, lds, tid, lane, wave); }
    GRID_BAR();
    STAMP(1);

    {
        const Params P = load_params(lds);
        const pg8::Gemm g{(const bf16_t*)(P.ws + WS_XB), (const bf16_t*)(P.ws + WS_WTIN), ROWS_ALL, DIN + 1024, DM};
        const P1Order S{G, (int)blockIdx.x};
        const P1Epi E{P};
        for (int rep = 0; rep < (PROBE == 1 ? 2 : 1); ++rep)
        pg8::gemm_phase<P1Epi, P1Order, true, true>(lds, g, S, E, TID());
    }
    GRID_BAR();
    STAMP(2);

    {
        const Params P = load_params(lds);
        unsigned* ctl = (unsigned*)(P.ws + WS_CTL);
        int tid2_ = TID(); asm volatile("" : "+v"(tid2_));
        const int tid = tid2_, lane = tid2_ & 63;
        {
        for (int u = blockIdx.x; u < 512; u += G) { int tid_ = TID(); asm volatile("" : "+v"(tid_)); ra_unit(P, lds, wave, tid_ & 63, tid_, u >> 6, (u >> 4) & 3, u & 15); }
        GRID_BAR();
        LAS unsigned* qw = (LAS unsigned*)(lds + LDS_BYTES - 160);
        const int myx = (int)(xb_xcc_id() & 7u);
        for (int k = 0; k < 8; ++k) {
            const int x = (myx + k) & 7;
            for (;;) {
                __syncthreads();
                if (TID() == 0) *qw = atomicAdd(ctl + 128 + 64 * x, 1u);
                __syncthreads();
                const int q = (int)*qw;
                if (q >= 176) break;
                int tid_ = TID(); asm volatile("" : "+v"(tid_));
                const int lane_ = tid_ & 63;
                if (q < 64 && (q & 1) == 0) swa_sample_unit(P, lds, tid_, wave, q >> 1, x);
                else if (q < 64) { const int v = q >> 1; swa_unit(P, lds, wave, lane_, v >> 2, x, v & 3); }
                else if (q < 80) { const int v = q - 64, bh = 8 * v + x; mem_sample_unit(P, lds, tid_, wave, bh >> 2, bh & 3); }
                else if (q < 96) { const int v = q - 80, bh = 8 * v + x; ret_scan(P, lds, bh >> 2, bh & 3, M_PROMPT + (bh >> 2) * 4, 4, P.state_ret, P.out + O_RS, tid_); }
                else if (q < 112) { const int v = q - 96, bh = 8 * (v >> 2) + x; mem_unit(P, lds, wave, lane_, bh >> 2, bh & 3, v & 3); }
                else { const int v = q - 112, bh = 8 * (v >> 4) + x; rb_unit(P, lds, wave, lane_, tid_, bh >> 2, bh & 3, v & 15); }
            }
        }
        }
    }
    GRID_BAR();
    STAMP(3);

    {
        const Params P = load_params(lds);
        const pg8::Gemm g{(const bf16_t*)(P.ws + WS_MIX), (const bf16_t*)(P.ws + WS_WTOUT), M_PROMPT, DM, DMIX};
        const P3Order S{G, (int)blockIdx.x};
        const P3Epi E{P};
        pg8::gemm_phase<P3Epi, P3Order, true, true>(lds, g, S, E, TID());
        { int t3_ = TID(); asm volatile("" : "+v"(t3_)); for (int sl = blockIdx.x; sl < 64; sl += G) p3_sample_slice(P, wave, t3_ & 63, sl); }
    }
    GRID_BAR();
    STAMP(4);

    {
        const Params P = load_params(lds);
        const bf16_t* Z = (const bf16_t*)(P.ws + WS_Z);
        int t4_ = TID(); asm volatile("" : "+v"(t4_));
        const int lane = t4_ & 63;
        const int gw = blockIdx.x * 8 + wave, NGW = G * 8;
        for (int r = gw; r < M_PROMPT + M_SAMPLE; r += NGW) {
            float* yr = r < M_PROMPT ? P.out + O_YP + (size_t)r * DM : P.out + O_YS + (size_t)(r - M_PROMPT) * DM;
            f32x4 v[4]; float s = 0.f;
#pragma unroll
            for (int j = 0; j < 4; ++j) { const u32x2 w = ((const u32x2*)(Z + (size_t)r * DM))[lane + 64 * j]; v[j] = (f32x4){bf_lo(w.x), bf_hi(w.x), bf_lo(w.y), bf_hi(w.y)}; s += (v[j][0] + v[j][1]) + (v[j][2] + v[j][3]); }
            const float mean = wave_sum(s, lane) * (1.0f / DM);
            float q = 0.f;
#pragma unroll
            for (int j = 0; j < 4; ++j) { v[j] = v[j] - mean; q += (v[j][0] * v[j][0] + v[j][1] * v[j][1]) + (v[j][2] * v[j][2] + v[j][3] * v[j][3]); }
            const float rstd = 1.0f / sqrtf(wave_sum(q, lane) * (1.0f / DM) + 1e-5f);
#pragma unroll
            for (int j = 0; j < 4; ++j) {
                const f32x4 g = ((const f32x4*)P.ln_g)[lane + 64 * j], bb = ((const f32x4*)P.ln_b)[lane + 64 * j];
                ((f32x4*)yr)[lane + 64 * j] = v[j] * rstd * g + bb;
            }
        }
    }
#if DIAG
    STAMP(5);
    __syncthreads();
    if (blockIdx.x == 0) {
        const Params P = load_params(lds);
        LAS unsigned long long* ts = (LAS unsigned long long*)(lds + LDS_BYTES - 256);
        const unsigned long long dtk = (DIAG == 6) ? (ts[5] - ts[0]) : (ts[DIAG] - ts[DIAG - 1]);
        const float eps = sqrtf((float)dtk * 0.01f * 1e-4f);
        for (int i = tid; i < 65536; i += 512) P.out[O_KS + i] *= (1.0f + eps);
    }
#endif
}


extern "C" void kernel_launch(void* const* d_in, const int* in_sizes, int n_in, void* d_out, int out_size, void* d_ws, size_t ws_size, hipStream_t stream) {
    static int grid_blocks = 0;
    if (!grid_blocks) {
        int dev = 0, cus = 0, per_cu = 0;
        hipGetDevice(&dev);
        hipDeviceGetAttribute(&cus, hipDeviceAttributeMultiprocessorCount, dev);
        hipFuncSetAttribute((const void*)fwd_kernel, hipFuncAttributeMaxDynamicSharedMemorySize, LDS_BYTES);
        hipOccupancyMaxActiveBlocksPerMultiprocessor(&per_cu, (const void*)fwd_kernel, 512, LDS_BYTES);
        if (per_cu < 1) { fprintf(stderr, "kernel_launch: occupancy query says %d blocks per CU\n", per_cu); per_cu = 1; }
        grid_blocks = cus;
        if (ws_size < WS_END) fprintf(stderr, "kernel_launch: workspace too small (%zu < %zu)\n", ws_size, (size_t)WS_END);
    }
    hipMemsetAsync((char*)d_ws + WS_CTL, 0, 65536, stream);
    Params p{};
    p.x_prompt = (const float*)d_in[0]; p.x_sample = (const float*)d_in[1]; p.state_ret = (const float*)d_in[2];
    p.cache_k = (const float*)d_in[3]; p.cache_v = (const float*)d_in[4]; p.cmem_k = (const float*)d_in[5]; p.cmem_v = (const float*)d_in[6];
    p.mem_prompt = (const float*)d_in[7]; p.w_in = (const float*)d_in[8]; p.w_mkv = (const float*)d_in[9]; p.w_out = (const float*)d_in[10];
    p.ln_g = (const float*)d_in[11]; p.ln_b = (const float*)d_in[12];
    p.out = (float*)d_out; p.ws = (unsigned char*)d_ws;
    hipLaunchKernelGGL(fwd_kernel, dim3(grid_blocks), dim3(512), LDS_BYTES, stream, p);
    hipError_t e = hipPeekAtLastError();
    if (e != hipSuccess) fprintf(stderr, "launch failed: %s (grid %d)\n", hipGetErrorString(e), grid_blocks);
}
```

```cpp
#include <hip/hip_runtime.h>
#include <hip/hip_cooperative_groups.h>
#include <cstdio>
#include <cstdint>
namespace cg = cooperative_groups;

#define LAS __attribute__((address_space(3)))
typedef unsigned short bf16_t;
typedef short bf16x8 __attribute__((ext_vector_type(8)));
typedef float f32x4 __attribute__((ext_vector_type(4)));
typedef float f32x2 __attribute__((ext_vector_type(2)));
typedef unsigned u32x4 __attribute__((ext_vector_type(4)));
typedef unsigned u32x2 __attribute__((ext_vector_type(2)));
typedef __bf16 bf16x2_t __attribute__((ext_vector_type(2)));

constexpr int DM = 1024, NB = 8, SEQ = 2048, DECB = 32, DECT = 4;
constexpr int NMEM = 256, DIN = 4608, DMIX = 1536;
constexpr int M_PROMPT = NB * SEQ;
constexpr int M_SAMPLE = DECB * DECT;
constexpr int ROWS_IN = M_PROMPT + 256;
constexpr int ROWS_ALL = ROWS_IN + NB * NMEM;
constexpr int HP = DIN;
constexpr int C_RQ = 0, C_RK = 256, C_RV = 512, C_RG = 1024, C_SQ = 1536, C_SK = 2048, C_SV = 2560, C_SG = 3072, C_MQ = 3584, C_MG = 4096;
constexpr size_t O_YP = 0, O_YS = 16777216, O_RP = 16908288, O_RS = 17170432, O_KP = 18219008, O_VP = 26607616,
                 O_KS = 34996224, O_VS = 35061760, O_MK = 35127296, O_MV = 36175872;
constexpr size_t MiB = 1u << 20;
constexpr size_t WS_CTL = 0, WS_ROPE = 1 * MiB, WS_WTIN = 2 * MiB, WS_WTMKV = 11 * MiB, WS_WTOUT = 14 * MiB,
                 WS_XB = 20 * MiB, WS_HB = 64 * MiB, WS_MKV = 212 * MiB, WS_MIX = 216 * MiB, WS_END = 324 * MiB;
constexpr int LDS_BYTES = 163840;
constexpr float LOG2E = 1.4426950408889634f;
constexpr float SQ_SCALE = 0.18033688011112042f;
constexpr float MQ_SCALE = 0.12751743082459868f;
constexpr float ALPHA = 1.189207115002721f;

struct Params {
    const float *x_prompt, *x_sample, *state_ret, *cache_k, *cache_v, *cmem_k, *cmem_v, *mem_prompt, *w_in, *w_mkv, *w_out, *ln_g, *ln_b;
    float* out;
    unsigned char* ws;
};

__device__ __forceinline__ unsigned pk_bf16(float lo, float hi) { f32x2 v = {lo, hi}; bf16x2_t b = __builtin_convertvector(v, bf16x2_t); return __builtin_bit_cast(unsigned, b); }
__device__ __forceinline__ float bf_lo(unsigned u) { return __uint_as_float(u << 16); }
__device__ __forceinline__ float bf_hi(unsigned u) { return __uint_as_float(u & 0xffff0000u); }
__device__ __forceinline__ float bf2f(bf16_t h) { return __uint_as_float(((unsigned)h) << 16); }
__device__ __forceinline__ float fexp2(float x) { return __builtin_amdgcn_exp2f(x); }
__device__ __forceinline__ float frcp(float x) { return __builtin_amdgcn_rcpf(x); }
__device__ __forceinline__ float silu(float x) { return x * frcp(1.0f + fexp2(-x * LOG2E)); }
__device__ __forceinline__ float shx(float v, int o, int lane) { return __int_as_float(__builtin_amdgcn_ds_bpermute(((lane ^ o) & 63) << 2, __float_as_int(v))); }
__device__ __forceinline__ float wave_max(float v, int lane) {
#pragma unroll
    for (int o = 1; o < 64; o <<= 1) v = fmaxf(v, shx(v, o, lane));
    return v;
}
__device__ __forceinline__ float wave_sum(float v, int lane) {
#pragma unroll
    for (int o = 1; o < 64; o <<= 1) v += shx(v, o, lane);
    return v;
}
#define LDS_WAIT() asm volatile("s_waitcnt lgkmcnt(0)" ::: "memory")
__device__ __forceinline__ int lane_id() { return (int)__builtin_amdgcn_mbcnt_hi(~0u, __builtin_amdgcn_mbcnt_lo(~0u, 0u)); }
__device__ __forceinline__ int perm32(int rho) { const int n = rho >> 4, i = rho & 15; return 8 * (i >> 2) + 4 * n + (i & 3); }
__device__ __forceinline__ int dmap(int p) { return 16 * (p >> 5) + 32 * ((p >> 2) & 1) + 4 * ((p >> 3) & 3) + (p & 3); }
__device__ __forceinline__ int src_col_in(int c) {
    const int rho = c & 31;
    const bool rope = (c < 512) || (c >= 1536 && c < 2560);
    if (rope) return (c & ~63) + 16 * ((c >> 5) & 1) + 32 * (rho >> 4) + (rho & 15);
    return (c & ~31) + perm32(rho);
}

__device__ __forceinline__ void transpose_item(const float* W, int K, int N, bf16_t* WT, int mode, LAS float* scr, int item, int lane) {
    const int nblk = N / 32, kb = item / nblk, nb = item % nblk, k0 = 64 * kb, n0 = 32 * nb;
    const int cl = lane & 31;
    const int sc = (mode == 0) ? (n0 + cl) : (mode == 1) ? (n0 + perm32(cl)) : src_col_in(n0 + cl);
    {
        float t[32];
        const float* wp = W + (size_t)(k0 + (lane >> 5)) * N + sc;
#pragma unroll
        for (int i = 0; i < 32; ++i) t[i] = wp[(size_t)(2 * i) * N];
#pragma unroll
        for (int i = 0; i < 32; ++i) scr[(2 * i + (lane >> 5)) * 33 + cl] = t[i];
    }
    LDS_WAIT();
    const int c = lane & 7;
#pragma unroll
    for (int j = 0; j < 4; ++j) {
        const int n = (lane >> 3) + 8 * j; const LAS float* s = scr + (8 * c) * 33 + n;
        u32x4 o; o.x = pk_bf16(s[0 * 33], s[1 * 33]); o.y = pk_bf16(s[2 * 33], s[3 * 33]); o.z = pk_bf16(s[4 * 33], s[5 * 33]); o.w = pk_bf16(s[6 * 33], s[7 * 33]);
        *(u32x4*)(WT + (size_t)(n0 + n) * K + k0 + 8 * c) = o;
    }
    LDS_WAIT();
}
__device__ __forceinline__ void sincos_d(double a, float& s, float& c) {
    const double kd = __builtin_rint(a * 0.63661977236758134308);
    double y = __builtin_fma(-kd, 1.57079632679489655800e+00, a); y = __builtin_fma(-kd, 6.12323399573676603587e-17, y);
    const double y2 = y * y;
    const double sp = y * (1.0 + y2 * (-1.0 / 6 + y2 * (1.0 / 120 + y2 * (-1.0 / 5040 + y2 * (1.0 / 362880 + y2 * (-1.0 / 39916800 + y2 * (1.0 / 6227020800.0)))))));
    const double cp = 1.0 + y2 * (-0.5 + y2 * (1.0 / 24 + y2 * (-1.0 / 720 + y2 * (1.0 / 40320 + y2 * (-1.0 / 3628800 + y2 * (1.0 / 479001600.0))))));
    const int k = ((int)kd) & 3;
    const double sv = (k == 0) ? sp : (k == 1) ? cp : (k == 2) ? -sp : -cp;
    const double cv = (k == 0) ? cp : (k == 1) ? -sp : (k == 2) ? -cp : sp;
    s = (float)sv; c = (float)cv;
}
__device__ __forceinline__ void phase0(const Params& P, LAS unsigned char* lds, int tid, int lane, int wave) {
    unsigned char* ws = P.ws;
    const int gw = blockIdx.x * 8 + wave, NGW = gridDim.x * 8;
    LAS float* scr = (LAS float*)(lds + wave * 8448);
    constexpr int I_IN = (DM / 64) * (DIN / 32), I_MKV = (DM / 64) * (1024 / 32), I_OUT = (DMIX / 64) * (DM / 32);
    for (int it = gw; it < I_IN + I_MKV + I_OUT; it += NGW) {
        int r = it;
        if (r < I_IN) { transpose_item(P.w_in, DM, DIN, (bf16_t*)(ws + WS_WTIN), 2, scr, r, lane); continue; } r -= I_IN;
        if (r < I_MKV) { transpose_item(P.w_mkv, DM, 1024, (bf16_t*)(ws + WS_WTMKV), 1, scr, r, lane); continue; } r -= I_MKV;
        transpose_item(P.w_out, DMIX, DM, (bf16_t*)(ws + WS_WTOUT), 0, scr, r, lane);
    }
    bf16_t* XB = (bf16_t*)(ws + WS_XB);
    for (int m0 = gw; m0 < ROWS_ALL; m0 += 2 * NGW) {
        f32x4 v[2][4];
#pragma unroll
        for (int rr = 0; rr < 2; ++rr) {
            const int m = m0 + rr * NGW;
            const float* src = (m < M_PROMPT) ? P.x_prompt + (size_t)m * DM : (m < M_PROMPT + M_SAMPLE) ? P.x_sample + (size_t)(m - M_PROMPT) * DM
                             : (m < ROWS_IN || m >= ROWS_ALL) ? nullptr : P.mem_prompt + (size_t)(m - ROWS_IN) * DM;
#pragma unroll
            for (int j = 0; j < 4; ++j) { v[rr][j] = (f32x4){0.f, 0.f, 0.f, 0.f}; if (src) v[rr][j] = ((const f32x4*)src)[lane + 64 * j]; }
        }
#pragma unroll
        for (int rr = 0; rr < 2; ++rr) {
            const int m = m0 + rr * NGW;
            if (m < ROWS_ALL) {
                u32x2* dst = (u32x2*)(XB + (size_t)m * DM) + lane;
#pragma unroll
                for (int j = 0; j < 4; ++j) { u32x2 o; o.x = pk_bf16(v[rr][j].x, v[rr][j].y); o.y = pk_bf16(v[rr][j].z, v[rr][j].w); dst[64 * j] = o; }
            }
        }
    }
    float* rope = (float*)(ws + WS_ROPE);
    for (int e = blockIdx.x * 512 + tid; e < 2052 * 32; e += gridDim.x * 512) {
        const int idx = e >> 5, i = e & 31;
        const int pos = idx < 2048 ? idx : 8192 + (idx - 2048);
        double inv = 1.0;
        for (int k = 0; k < i; ++k) inv *= 0.7498942093324559;
        float s, c; sincos_d((double)pos * inv, s, c);
        rope[2 * e] = c; rope[2 * e + 1] = s;
    }
}


namespace pg8 {
#define PG8_LAS __attribute__((address_space(3)))
typedef unsigned short bf16_t;
typedef short bf16x8 __attribute__((ext_vector_type(8)));
typedef float f32x4 __attribute__((ext_vector_type(4)));
constexpr int BM = 256, BK = 64, HALF = 128, HTB = HALF * BK * 2, STAGE_BYTES = 8 * HTB;
__host__ __device__ __forceinline__ int lds_byte(int r, int c) { const int st = (r >> 4) * 2 + (c >> 5), rr = r & 15, cc = c & 31, ob = rr * 64 + cc * 2; return st * 1024 + (ob ^ (((ob >> 9) & 1) << 5)); }
__host__ __device__ __forceinline__ void stage_rc(int b, int& R, int& C) { const int st = b / 1024, sb = b % 1024, swz = sb ^ (((sb >> 9) & 1) << 5); R = (st >> 1) * 16 + swz / 64; C = (st & 1) * 32 + (swz % 64) / 2; }
__host__ __device__ __forceinline__ int perm32(int rho) { const int n = rho >> 4, i = rho & 15; return 8 * (i >> 2) + 4 * n + (i & 3); }
struct Unit { int pm, pn; };
struct Gemm { const bf16_t* A; const bf16_t* Bt; int M, N, K; };
template <class Epi, class Sched, bool ALIGN_EPI = false, bool SP2 = false>
__device__ __forceinline__ void gemm_phase(PG8_LAS unsigned char* lds, const Gemm g, const Sched& S, const Epi& E, int tid_in) {
    int tid = tid_in; asm volatile("" : "+v"(tid));
    const int wid = __builtin_amdgcn_readfirstlane(tid >> 6), lane = tid & 63, wr = wid >> 2, wc = wid & 3, fr = lane & 15, fq = lane >> 4;
    const int K = g.K, nt = K / BK;
    unsigned voffA[2], voffB[2];
#pragma unroll
    for (int i = 0; i < 2; ++i) { int R, C; stage_rc(tid * 16 + i * 8192, R, C); const int Rb = Epi::PERM ? ((R & ~31) + perm32(R & 31)) : R;
        voffA[i] = (unsigned)(R * K + C) * 2u; voffB[i] = (unsigned)(Rb * K + C) * 2u; }
    const size_t kstep = (size_t)(BK * 2);
    const size_t hstep = (size_t)HALF * K * 2;
    const size_t tstep = 2 * hstep;
    const unsigned ldsw = (unsigned)wid * 1024u;
    const int aoff = lds_byte(wr * 64 + fr, fq * 8), boff = lds_byte(wc * 32 + fr, fq * 8);
#define PG8_SA(b, h) (((b) * 2 + (h)) * HTB)
#define PG8_SB(b, h) ((4 + (b) * 2 + (h)) * HTB)
#define PG8_STAGE(bufoff, gbase, voff) do { _Pragma("unroll") for (int _i = 0; _i < 2; ++_i) \
        __builtin_amdgcn_global_load_lds((const unsigned*)((const char*)(gbase) + (voff)[_i]), (PG8_LAS unsigned*)(lds + (bufoff) + ldsw + _i * 8192), 16, 0, 0); } while (0)
#define PG8_LDA(dst, b, h) do { _Pragma("unroll") for (int m = 0; m < 4; ++m) _Pragma("unroll") for (int k = 0; k < 2; ++k) dst[m][k] = *(const PG8_LAS bf16x8*)(lds + PG8_SA(b, h) + aoff + m * 2048 + k * 1024); } while (0)
#define PG8_LDB(dst, b, h) do { _Pragma("unroll") for (int n = 0; n < 2; ++n) _Pragma("unroll") for (int k = 0; k < 2; ++k) dst[n][k] = *(const PG8_LAS bf16x8*)(lds + PG8_SB(b, h) + boff + n * 2048 + k * 1024); } while (0)
#define PG8_MMA(ai, bj, At, Bt) do { __builtin_amdgcn_s_setprio(1); _Pragma("unroll") for (int m = 0; m < 4; ++m) _Pragma("unroll") for (int n = 0; n < 2; ++n) _Pragma("unroll") for (int k = 0; k < 2; ++k) \
        acc[ai][bj][m][n] = __builtin_amdgcn_mfma_f32_16x16x32_bf16(Bt[n][k], At[m][k], acc[ai][bj][m][n], 0, 0, 0); __builtin_amdgcn_s_setprio(0); } while (0)
#define PG8_WAIT_V(n) asm volatile("s_waitcnt vmcnt(" #n ")" ::: "memory")
#define PG8_WAIT_L(n) asm volatile("s_waitcnt lgkmcnt(" #n ")" ::: "memory")
#define PG8_BAR __builtin_amdgcn_s_barrier()
#define PG8_SCHED __builtin_amdgcn_sched_barrier(0)
    Unit cur, nxt; int ui = 0;
    if (!S.next(0, cur)) return;
    f32x4 acc[2][2][4][2];
#pragma unroll
    for (int a = 0; a < 2; ++a)
#pragma unroll
        for (int b = 0; b < 2; ++b)
#pragma unroll
            for (int m = 0; m < 4; ++m)
#pragma unroll
                for (int n = 0; n < 2; ++n) acc[a][b][m][n] = (f32x4){0.f, 0.f, 0.f, 0.f};
    bf16x8 At[4][2], B0[2][2], B1[2][2];
    const char* cA = (const char*)g.A + (size_t)cur.pm * tstep; const char* cB = (const char*)g.Bt + (size_t)cur.pn * tstep;
    S.a_ready(cur);
    if constexpr (SP2) {
        PG8_STAGE(PG8_SB(0, 0), cB, voffB); PG8_STAGE(PG8_SB(0, 1), cB + hstep, voffB); PG8_STAGE(PG8_SA(0, 0), cA, voffA); PG8_STAGE(PG8_SA(0, 1), cA + hstep, voffA);
        if (wr == 1) PG8_BAR;
        PG8_WAIT_V(2); PG8_BAR;
        PG8_STAGE(PG8_SB(1, 0), cB + kstep, voffB); PG8_STAGE(PG8_SA(1, 0), cA + kstep, voffA); PG8_STAGE(PG8_SB(1, 1), cB + hstep + kstep, voffB);
        PG8_WAIT_V(6); PG8_BAR;
    } else {
        PG8_STAGE(PG8_SB(0, 0), cB, voffB); PG8_STAGE(PG8_SA(0, 0), cA, voffA); PG8_STAGE(PG8_SB(0, 1), cB + hstep, voffB); PG8_STAGE(PG8_SA(0, 1), cA + hstep, voffA);
        if (wr == 1) PG8_BAR;
        PG8_WAIT_V(4); PG8_BAR;
        PG8_STAGE(PG8_SB(1, 0), cB + kstep, voffB); PG8_STAGE(PG8_SA(1, 0), cA + kstep, voffA); PG8_STAGE(PG8_SB(1, 1), cB + hstep + kstep, voffB);
        PG8_WAIT_V(6); PG8_BAR;
    }
    for (;;) {
        const bool has_next = S.next(ui + 1, nxt);
        const char* nA = has_next ? (const char*)g.A + (size_t)nxt.pm * tstep : cA; const char* nB = has_next ? (const char*)g.Bt + (size_t)nxt.pn * tstep : cB;
        for (int t = 0; t < nt; t += 2) {
            const bool last = (t == nt - 2);
            const char* a1 = cA + (size_t)(t + 1) * kstep;
            const char* a2 = last ? nA : cA + (size_t)(t + 2) * kstep; const char* b2 = last ? nB : cB + (size_t)(t + 2) * kstep;
            const char* a3 = a2 + kstep; const char* b3 = b2 + kstep;
            if (last && has_next) S.a_ready(nxt);
            if constexpr (SP2) {
            PG8_LDB(B0, 0, 0); PG8_LDB(B1, 0, 1); PG8_SCHED; PG8_LDA(At, 0, 0); PG8_STAGE(PG8_SA(1, 1), a1 + hstep, voffA);
            PG8_WAIT_V(8); PG8_WAIT_L(0); PG8_BAR; PG8_MMA(0, 0, At, B0); PG8_MMA(0, 1, At, B1); PG8_BAR; PG8_SCHED;
            PG8_LDA(At, 0, 1); PG8_STAGE(PG8_SB(0, 0), b2, voffB); PG8_STAGE(PG8_SB(0, 1), b2 + hstep, voffB); PG8_STAGE(PG8_SA(0, 0), a2, voffA);
            PG8_WAIT_V(8); PG8_WAIT_L(0); PG8_BAR; PG8_MMA(1, 0, At, B0); PG8_MMA(1, 1, At, B1); PG8_BAR; PG8_SCHED;
            PG8_LDB(B0, 1, 0); PG8_LDB(B1, 1, 1); PG8_SCHED; PG8_LDA(At, 1, 0); PG8_STAGE(PG8_SA(0, 1), a2 + hstep, voffA);
            PG8_WAIT_V(8); PG8_WAIT_L(0); PG8_BAR; PG8_MMA(0, 0, At, B0); PG8_MMA(0, 1, At, B1); PG8_BAR; PG8_SCHED;
            PG8_LDA(At, 1, 1); PG8_STAGE(PG8_SB(1, 0), b3, voffB); PG8_STAGE(PG8_SB(1, 1), b3 + hstep, voffB); PG8_STAGE(PG8_SA(1, 0), a3, voffA);
            PG8_WAIT_V(8); PG8_WAIT_L(0); PG8_BAR; PG8_MMA(1, 0, At, B0); PG8_MMA(1, 1, At, B1); PG8_BAR; PG8_SCHED;
            } else {
            PG8_LDB(B0, 0, 0); PG8_SCHED; PG8_LDA(At, 0, 0); PG8_STAGE(PG8_SA(1, 1), a1 + hstep, voffA);
            PG8_WAIT_L(8); PG8_BAR; PG8_WAIT_L(0); PG8_MMA(0, 0, At, B0); PG8_BAR; PG8_SCHED;
            PG8_LDB(B1, 0, 1); PG8_STAGE(PG8_SB(0, 0), b2, voffB);
            PG8_BAR; PG8_WAIT_L(0); PG8_MMA(0, 1, At, B1); PG8_BAR;
            PG8_LDA(At, 0, 1); PG8_STAGE(PG8_SA(0, 0), a2, voffA);
            PG8_BAR; PG8_WAIT_L(0); PG8_MMA(1, 0, At, B0); PG8_BAR; PG8_SCHED;
            PG8_STAGE(PG8_SB(0, 1), b2 + hstep, voffB);
            PG8_WAIT_V(6); PG8_BAR; PG8_MMA(1, 1, At, B1); PG8_BAR;
            PG8_LDB(B0, 1, 0); PG8_SCHED; PG8_LDA(At, 1, 0); PG8_STAGE(PG8_SA(0, 1), a2 + hstep, voffA);
            PG8_WAIT_L(8); PG8_BAR; PG8_WAIT_L(0); PG8_MMA(0, 0, At, B0); PG8_BAR; PG8_SCHED;
            PG8_LDB(B1, 1, 1); PG8_STAGE(PG8_SB(1, 0), b3, voffB);
            PG8_BAR; PG8_WAIT_L(0); PG8_MMA(0, 1, At, B1); PG8_BAR;
            PG8_LDA(At, 1, 1); PG8_STAGE(PG8_SA(1, 0), a3, voffA);
            PG8_BAR; PG8_WAIT_L(0); PG8_MMA(1, 0, At, B0); PG8_BAR; PG8_SCHED;
            PG8_STAGE(PG8_SB(1, 1), b3 + hstep, voffB);
            PG8_WAIT_V(6); PG8_BAR; PG8_MMA(1, 1, At, B1); PG8_BAR;
            }
        }
        if constexpr (ALIGN_EPI) { if (wr == 0) PG8_BAR; }
        if constexpr (!Epi::AFTER_DRAIN) { E(acc, cur, wr, wc, fr, fq); S.done(cur); }
        if (!has_next) break;
#pragma unroll
        for (int a = 0; a < 2; ++a)
#pragma unroll
            for (int b = 0; b < 2; ++b)
#pragma unroll
                for (int m = 0; m < 4; ++m)
#pragma unroll
                    for (int n = 0; n < 2; ++n) acc[a][b][m][n] = (f32x4){0.f, 0.f, 0.f, 0.f};
        cur = nxt; cA = nA; cB = nB; ++ui;
        if constexpr (ALIGN_EPI) { if (wr == 1) PG8_BAR; }
    }
    PG8_WAIT_V(0);
    if constexpr (!ALIGN_EPI) { if (wr == 0) PG8_BAR; }
    PG8_BAR;
    if constexpr (Epi::AFTER_DRAIN) { E.fused(acc, cur, wr, wc, fr, fq, lds, wid, lane); S.done(cur); }
#undef PG8_SA
#undef PG8_SB
#undef PG8_STAGE
#undef PG8_LDA
#undef PG8_LDB
#undef PG8_MMA
#undef PG8_WAIT_V
#undef PG8_WAIT_L
#undef PG8_BAR
#undef PG8_SCHED
}
}

__device__ __forceinline__ void epi_inproj(const f32x4 (&acc)[2][2][4][2], int pm, int pn, const Params& P, int wr, int wc, int fr, int fq) {
    bf16_t* HB = (bf16_t*)(P.ws + WS_HB);
    const float* rope = (const float*)(P.ws + WS_ROPE);
    int type = 0; float scale = 1.0f; int f32out = 0;
    if (pn == 0) { type = 1; }
    else if (pn == 1) { type = 1; scale = 0.125f; }
    else if (pn == 4 || pn == 5 || pn == 12 || pn == 13 || pn == 16 || pn == 17) { type = 2; }
    else if (pn == 6 || pn == 7) { type = 1; scale = SQ_SCALE; }
    else if (pn == 8 || pn == 9) { type = 1; f32out = 1; }
    else if (pn == 10 || pn == 11) { f32out = 2; }
    else if (pn == 14 || pn == 15) { scale = MQ_SCALE; }
#pragma unroll
    for (int ai = 0; ai < 2; ++ai)
#pragma unroll
        for (int m = 0; m < 4; ++m) {
            const int r = pm * 256 + ai * 128 + wr * 64 + m * 16 + fr;
            const int pi = r < M_PROMPT ? (r & 2047) : 2048 + ((r - M_PROMPT) & 3);
            const bool live = r < M_PROMPT + M_SAMPLE;
#pragma unroll
            for (int bj = 0; bj < 2; ++bj) {
                const int cb = pn * 256 + bj * 128 + wc * 32;
                f32x4 v0 = acc[ai][bj][m][0], v1 = acc[ai][bj][m][1];
                if (type == 1) {
                    const int d1 = 16 * ((cb >> 5) & 1) + 4 * fq;
                    const f32x4* rp = (const f32x4*)(rope + ((size_t)pi * 32 + d1) * 2);
                    const f32x4 cs0 = rp[0], cs1 = rp[1];
                    f32x4 y1, y2;
                    y1[0] = v0[0] * cs0[0] - v1[0] * cs0[1]; y2[0] = v1[0] * cs0[0] + v0[0] * cs0[1];
                    y1[1] = v0[1] * cs0[2] - v1[1] * cs0[3]; y2[1] = v1[1] * cs0[2] + v0[1] * cs0[3];
                    y1[2] = v0[2] * cs1[0] - v1[2] * cs1[1]; y2[2] = v1[2] * cs1[0] + v0[2] * cs1[1];
                    y1[3] = v0[3] * cs1[2] - v1[3] * cs1[3]; y2[3] = v1[3] * cs1[2] + v0[3] * cs1[3];
                    if (f32out == 1 && live) {
                        float* o = (r < M_PROMPT ? P.out + O_KP + (size_t)r * 512 : P.out + O_KS + (size_t)(r - M_PROMPT) * 512) + ((cb - C_SK) >> 6) * 64 + d1;
                        *(f32x4*)o = y1; *(f32x4*)(o + 32) = y2;
                    }
                    v0 = y1 * scale; v1 = y2 * scale;
                } else if (type == 2) {
#pragma unroll
                    for (int e = 0; e < 4; ++e) { v0[e] = silu(v0[e]); v1[e] = silu(v1[e]); }
                } else {
                    if (f32out == 2 && live) {
                        float* o = (r < M_PROMPT ? P.out + O_VP + (size_t)r * 512 : P.out + O_VS + (size_t)(r - M_PROMPT) * 512) + (cb - C_SV) + 8 * fq;
                        *(f32x4*)o = v0; *(f32x4*)(o + 4) = v1;
                    }
                    v0 = v0 * scale; v1 = v1 * scale;
                }
                u32x4 w; w.x = pk_bf16(v0[0], v0[1]); w.y = pk_bf16(v0[2], v0[3]); w.z = pk_bf16(v1[0], v1[1]); w.w = pk_bf16(v1[2], v1[3]);
                *(u32x4*)(HB + (size_t)r * HP + cb + 8 * fq) = w;
            }
        }
}
__device__ __forceinline__ void epi_memkv(const f32x4 (&acc)[2][2][4][2], int pm, int pn, const Params& P, int wr, int wc, int fr, int fq) {
    bf16_t* MKV = (bf16_t*)(P.ws + WS_MKV);
#pragma unroll
    for (int ai = 0; ai < 2; ++ai)
#pragma unroll
        for (int m = 0; m < 4; ++m) {
            const int r = pm * 256 + ai * 128 + wr * 64 + m * 16 + fr;
#pragma unroll
            for (int bj = 0; bj < 2; ++bj) {
                const int c0 = pn * 256 + bj * 128 + wc * 32 + 8 * fq;
                const f32x4 v0 = acc[ai][bj][m][0], v1 = acc[ai][bj][m][1];
                float* o = (c0 < 512) ? P.out + O_MK + (size_t)r * 512 + c0 : P.out + O_MV + (size_t)r * 512 + (c0 - 512);
                *(f32x4*)o = v0; *(f32x4*)(o + 4) = v1;
                u32x4 w; w.x = pk_bf16(v0[0], v0[1]); w.y = pk_bf16(v0[2], v0[3]); w.z = pk_bf16(v1[0], v1[1]); w.w = pk_bf16(v1[2], v1[3]);
                *(u32x4*)(MKV + (size_t)r * 1024 + c0) = w;
            }
        }
}
constexpr size_t WS_Z = 290 * MiB;
__device__ __forceinline__ void epi_outproj(const f32x4 (&acc)[2][2][4][2], int pm, int pn, const Params& P, int wr, int wc, int fr, int fq) {
    const bf16_t* XB = (const bf16_t*)(P.ws + WS_XB);
    bf16_t* Z = (bf16_t*)(P.ws + WS_Z);
#pragma unroll
    for (int ai = 0; ai < 2; ++ai)
#pragma unroll
        for (int m = 0; m < 4; ++m) {
            const size_t r = (size_t)pm * 256 + ai * 128 + wr * 64 + m * 16 + fr;
#pragma unroll
            for (int bj = 0; bj < 2; ++bj)
#pragma unroll
                for (int n = 0; n < 2; ++n) {
                    const int c = pn * 256 + bj * 128 + wc * 32 + 16 * n + 4 * fq;
                    const u32x2 xv = *(const u32x2*)(XB + r * DM + c);
                    const f32x4 a = acc[ai][bj][m][n];
                    u32x2 w; w.x = pk_bf16(bf_lo(xv.x) * ALPHA + a[0], bf_hi(xv.x) * ALPHA + a[1]); w.y = pk_bf16(bf_lo(xv.y) * ALPHA + a[2], bf_hi(xv.y) * ALPHA + a[3]);
                    *(u32x2*)(Z + r * DM + c) = w;
                }
        }
}

__device__ __forceinline__ void ret_scan(const Params& P, LAS unsigned char* lds, int b, int h, int row0, int ntok, const float* init, float* outstate, int tid) {
    const bf16_t* HB = (const bf16_t*)(P.ws + WS_HB);
    bf16_t* MIX = (bf16_t*)(P.ws + WS_MIX);
    LAS float* qs = (LAS float*)lds;
    LAS float* ks = qs + 32 * 64;
    LAS float* vs = ks + 32 * 64;
    LAS float* po = vs + 32 * 128;
    const int vv = tid & 127, kq = tid >> 7, lane = tid & 63;
    const float gamma = 1.0f - __builtin_amdgcn_exp2f((float)(-5 - h));
    float S[16];
#pragma unroll
    for (int j = 0; j < 16; ++j) S[j] = init ? init[((size_t)((b * 4 + h) * 64 + dmap(16 * kq + j))) * 128 + vv] : 0.f;
    for (int t0 = 0; t0 < ntok; t0 += 32) {
        const int nb = (ntok - t0) < 32 ? (ntok - t0) : 32;
        __syncthreads();
        {
            const int tt = (tid & 255) >> 3, ch = tid & 7;
            if (tt < nb) {
                const u32x4 w = *(const u32x4*)(HB + (size_t)(row0 + t0 + tt) * HP + (tid < 256 ? C_RQ : C_RK) + h * 64 + ch * 8);
                LAS float* dst = (tid < 256 ? qs : ks) + tt * 64 + ch * 8;
                dst[0] = bf_lo(w.x); dst[1] = bf_hi(w.x); dst[2] = bf_lo(w.y); dst[3] = bf_hi(w.y);
                dst[4] = bf_lo(w.z); dst[5] = bf_hi(w.z); dst[6] = bf_lo(w.w); dst[7] = bf_hi(w.w);
            }
            const int tv = tid >> 4, cv = tid & 15;
            if (tv < nb) {
                const u32x4 w = *(const u32x4*)(HB + (size_t)(row0 + t0 + tv) * HP + C_RV + h * 128 + cv * 8);
                LAS float* dst = vs + tv * 128 + cv * 8;
                dst[0] = bf_lo(w.x); dst[1] = bf_hi(w.x); dst[2] = bf_lo(w.y); dst[3] = bf_hi(w.y);
                dst[4] = bf_lo(w.z); dst[5] = bf_hi(w.z); dst[6] = bf_lo(w.w); dst[7] = bf_hi(w.w);
            }
        }
        __syncthreads();
        for (int tt = 0; tt < nb; ++tt) {
            const float vval = vs[tt * 128 + vv];
            float o = 0.f;
#pragma unroll
            for (int j4 = 0; j4 < 4; ++j4) {
                const f32x4 k4 = *(const LAS f32x4*)(ks + tt * 64 + 16 * kq + 4 * j4);
                const f32x4 q4 = *(const LAS f32x4*)(qs + tt * 64 + 16 * kq + 4 * j4);
#pragma unroll
                for (int e = 0; e < 4; ++e) { S[4 * j4 + e] = fmaf(gamma, S[4 * j4 + e], k4[e] * vval); o = fmaf(q4[e], S[4 * j4 + e], o); }
            }
            po[(tt * 4 + kq) * 128 + vv] = o;
        }
        __syncthreads();
        {
            const int tf = tid >> 4, c8 = (tid & 15) * 8;
            float o[8]; float s = 0.f;
#pragma unroll
            for (int e = 0; e < 8; ++e) { o[e] = (po[(tf * 4 + 0) * 128 + c8 + e] + po[(tf * 4 + 1) * 128 + c8 + e]) + (po[(tf * 4 + 2) * 128 + c8 + e] + po[(tf * 4 + 3) * 128 + c8 + e]); s += o[e]; }
            s += shx(s, 1, lane); s += shx(s, 2, lane); s += shx(s, 4, lane); s += shx(s, 8, lane);
            const float mean = s * (1.0f / 128.0f);
            float q = 0.f;
#pragma unroll
            for (int e = 0; e < 8; ++e) { o[e] -= mean; q += o[e] * o[e]; }
            q += shx(q, 1, lane); q += shx(q, 2, lane); q += shx(q, 4, lane); q += shx(q, 8, lane);
            const float rstd = 1.0f / sqrtf(q * (1.0f / 128.0f) + 1e-5f);
            if (tf < nb) {
                const size_t row = (size_t)(row0 + t0 + tf);
                const u32x4 g = *(const u32x4*)(HB + row * HP + C_RG + h * 128 + c8);
                u32x4 w;
                w.x = pk_bf16(o[0] * rstd * bf_lo(g.x), o[1] * rstd * bf_hi(g.x)); w.y = pk_bf16(o[2] * rstd * bf_lo(g.y), o[3] * rstd * bf_hi(g.y));
                w.z = pk_bf16(o[4] * rstd * bf_lo(g.z), o[5] * rstd * bf_hi(g.z)); w.w = pk_bf16(o[6] * rstd * bf_lo(g.w), o[7] * rstd * bf_hi(g.w));
                *(u32x4*)(MIX + row * DMIX + h * 128 + c8) = w;
            }
        }
    }
    __syncthreads();
#pragma unroll
    for (int j = 0; j < 16; ++j) outstate[((size_t)((b * 4 + h) * 64 + dmap(16 * kq + j))) * 128 + vv] = S[j];
}

__device__ __forceinline__ float dot4(f32x4 a, f32x4 b) { return (a[0] * b[0] + a[1] * b[1]) + (a[2] * b[2] + a[3] * b[3]); }
__device__ __forceinline__ void swa_sample_unit(const Params& P, LAS unsigned char* lds, int tid, int wave, int b, int h) {
    const bf16_t* HB = (const bf16_t*)(P.ws + WS_HB);
    bf16_t* MIX = (bf16_t*)(P.ws + WS_MIX);
    LAS float* qo = (LAS float*)lds; LAS float* kn = qo + 256; LAS float* vn = kn + 256;
    LAS float* sc = (LAS float*)(lds + 4096); LAS float* ls = (LAS float*)(lds + 10496); LAS float* red = (LAS float*)(lds + 12288);
    const int lane = tid & 63;
    __syncthreads();
    if (tid < 256) {
        const int i = tid >> 6, p = tid & 63; const size_t R = (size_t)M_PROMPT + b * 4 + i;
        qo[i * 64 + dmap(p)] = bf2f(HB[R * HP + C_SQ + h * 64 + p]);
        kn[i * 64 + dmap(p)] = bf2f(HB[R * HP + C_SK + h * 64 + p]);
        vn[i * 64 + p] = bf2f(HB[R * HP + C_SV + h * 64 + p]);
    }
    __syncthreads();
#pragma unroll 1
    for (int rnd = 0; rnd < 4; ++rnd) {
        const int tr = tid + 512 * rnd;
        if (tr < 1548) {
            const int i = tr / 387, rem = tr - i * 387, g = rem / 129, s = rem - g * 129;
            const int dil = (g == 0) ? 1 : (g == 1) ? 4 : 16;
            const int idx = 2048 + i - dil * s;
            float a = 0.f;
            if (idx < 2048) {
                const f32x4* kc = (const f32x4*)(P.cache_k + (((size_t)b * 2048 + idx) * 8 + h) * 64);
                f32x4 kv[16];
#pragma unroll
                for (int c = 0; c < 16; ++c) kv[c] = kc[c];
#pragma unroll
                for (int c = 0; c < 16; ++c) a += dot4(kv[c], *(const LAS f32x4*)(qo + i * 64 + 4 * c));
            } else {
                const LAS f32x4* kc = (const LAS f32x4*)(kn + (idx - 2048) * 64);
#pragma unroll
                for (int c = 0; c < 16; ++c) a += dot4(kc[c], *(const LAS f32x4*)(qo + i * 64 + 4 * c));
            }
            sc[tr] = a;
        }
    }
    __syncthreads();
    if (wave < 4) {
        const int i = wave;
        float m = -INFINITY;
#pragma unroll
        for (int k = 0; k < 7; ++k) { const int e = lane + 64 * k; if (e < 387) m = fmaxf(m, sc[i * 387 + e]); }
        m = wave_max(m, lane);
        float l = 0.f;
#pragma unroll
        for (int k = 0; k < 7; ++k) { const int e = lane + 64 * k; if (e < 387) { const float p = fexp2(sc[i * 387 + e] - m); sc[i * 387 + e] = p; l += p; } }
        l = wave_sum(l, lane);
        if (lane == 0) ls[i] = l;
    }
    __syncthreads();
    {
        const int d4 = tid & 15, slot = tid >> 4;
#pragma unroll 1
        for (int i = 0; i < 4; ++i) {
            f32x4 acc = {0.f, 0.f, 0.f, 0.f};
            f32x4 vv[13]; float pp[13];
#pragma unroll
            for (int k = 0; k < 13; ++k) {
                const int e0 = slot + 32 * k; const bool ok = e0 < 387; const int e = ok ? e0 : 0;
                const int g = e / 129, s = e - g * 129;
                const int dil = (g == 0) ? 1 : (g == 1) ? 4 : 16;
                const int idx = 2048 + i - dil * s;
                pp[k] = ok ? sc[i * 387 + e] : 0.f;
                vv[k] = (idx < 2048) ? *(const f32x4*)(P.cache_v + (((size_t)b * 2048 + idx) * 8 + h) * 64 + d4 * 4)
                                     : *(const LAS f32x4*)(vn + (idx - 2048) * 64 + d4 * 4);
            }
#pragma unroll
            for (int k = 0; k < 13; ++k) acc = acc + vv[k] * pp[k];
            *(LAS f32x4*)(red + (slot * 4 + i) * 64 + d4 * 4) = acc;
        }
    }
    __syncthreads();
    if (tid < 256) {
        const int i = tid >> 6, d = tid & 63;
        float s = 0.f;
#pragma unroll
        for (int sl = 0; sl < 32; ++sl) s += red[(sl * 4 + i) * 64 + d];
        const size_t R = (size_t)M_PROMPT + b * 4 + i;
        const float gate = bf2f(HB[R * HP + C_SG + h * 64 + d]);
        MIX[R * DMIX + 512 + h * 64 + d] = (bf16_t)(pk_bf16(s / ls[i] * gate, 0.f) & 0xffffu);
    }
}
__device__ __forceinline__ void mem_sample_unit(const Params& P, LAS unsigned char* lds, int tid, int wave, int b, int h) {
    const bf16_t* HB = (const bf16_t*)(P.ws + WS_HB);
    bf16_t* MIX = (bf16_t*)(P.ws + WS_MIX);
    LAS float* qm = (LAS float*)lds; LAS float* part = (LAS float*)(lds + 2048); LAS float* pr = (LAS float*)(lds + 10240);
    LAS float* ls = (LAS float*)(lds + 14336); LAS float* red = (LAS float*)(lds + 16384);
    const int lane = tid & 63;
    __syncthreads();
    { const int i = tid >> 7, d = tid & 127; qm[i * 128 + d] = bf2f(HB[((size_t)M_PROMPT + b * 4 + i) * HP + C_MQ + h * 128 + d]); }
    __syncthreads();
    {
        const int m = tid & 255, half = tid >> 8;
        const f32x4* kc = (const f32x4*)(P.cmem_k + (((size_t)b * NMEM + m) * 4 + h) * 128 + half * 64);
        f32x4 kv[16];
#pragma unroll
        for (int c = 0; c < 16; ++c) kv[c] = kc[c];
#pragma unroll
        for (int i = 0; i < 4; ++i) {
            float a = 0.f;
#pragma unroll
            for (int c = 0; c < 16; ++c) a += dot4(kv[c], *(const LAS f32x4*)(qm + i * 128 + half * 64 + 4 * c));
            part[(half * 4 + i) * 256 + m] = a;
        }
    }
    __syncthreads();
    if (wave < 4) {
        const int i = wave;
        float s[4]; float m = -INFINITY;
#pragma unroll
        for (int k = 0; k < 4; ++k) { s[k] = part[i * 256 + lane + 64 * k] + part[(4 + i) * 256 + lane + 64 * k]; m = fmaxf(m, s[k]); }
        m = wave_max(m, lane);
        float l = 0.f;
#pragma unroll
        for (int k = 0; k < 4; ++k) { const float p = fexp2(s[k] - m); pr[i * 256 + lane + 64 * k] = p; l += p; }
        l = wave_sum(l, lane);
        if (lane == 0) ls[i] = l;
    }
    __syncthreads();
    {
        const int d4 = tid & 31, slot = tid >> 5;
        f32x4 acc[4];
#pragma unroll
        for (int i = 0; i < 4; ++i) acc[i] = (f32x4){0.f, 0.f, 0.f, 0.f};
        f32x4 vv[16];
#pragma unroll
        for (int k = 0; k < 16; ++k) vv[k] = *(const f32x4*)(P.cmem_v + (((size_t)b * NMEM + slot + 16 * k) * 4 + h) * 128 + d4 * 4);
#pragma unroll
        for (int k = 0; k < 16; ++k)
#pragma unroll
            for (int i = 0; i < 4; ++i) acc[i] = acc[i] + vv[k] * pr[i * 256 + slot + 16 * k];
#pragma unroll
        for (int i = 0; i < 4; ++i) *(LAS f32x4*)(red + (slot * 4 + i) * 128 + d4 * 4) = acc[i];
    }
    __syncthreads();
    {
        const int i = tid >> 7, d = tid & 127;
        float s = 0.f;
#pragma unroll
        for (int sl = 0; sl < 16; ++sl) s += red[(sl * 4 + i) * 128 + d];
        const size_t R = (size_t)M_PROMPT + b * 4 + i;
        const float gate = bf2f(HB[R * HP + C_MG + h * 128 + d]);
        MIX[R * DMIX + 1024 + h * 128 + d] = (bf16_t)(pk_bf16(s / ls[i] * gate, 0.f) & 0xffffu);
    }
}

typedef float f32x16 __attribute__((ext_vector_type(16)));
typedef short s16x4 __attribute__((ext_vector_type(4)));
constexpr int SWA_ST_O = 0, SWA_ST_M = 65536, SWA_ST_L = 65536 + 2048, SWA_WV = 69632, SWA_WV_STRIDE = 10240 + 768;
__device__ __forceinline__ s16x4 tr16(LAS unsigned char* p) { return __builtin_bit_cast(s16x4, __builtin_amdgcn_ds_read_tr16_b64_v4i16((LAS s16x4*)p)); }
__device__ __forceinline__ f32x16 mfma32(bf16x8 a, bf16x8 b, f32x16 c) { return __builtin_amdgcn_mfma_f32_32x32x16_bf16(a, b, c, 0, 0, 0); }
#define VM_WAIT() asm volatile("s_waitcnt vmcnt(0)" ::: "memory")

struct SwaT { int dil, r, i0, pat; };
__device__ __forceinline__ SwaT swa_params(int i, int wave, int T0) {
    const int pat = i >> 1, k = wave + 8 * (i & 1);
    SwaT t; t.pat = pat;
    if (pat == 0) { t.dil = 1; t.r = 0; t.i0 = T0 + 32 * k; }
    else if (pat == 1) { t.dil = 4; t.r = k & 3; t.i0 = (T0 >> 2) + 32 * (k >> 2); }
    else { t.dil = 16; t.r = k; t.i0 = T0 >> 4; }
    return t;
}
__device__ __forceinline__ void swa_loadqk(const Params& P, const SwaT& t, int b, int h, int lane, bf16x8 (&qf)[4], bf16x8 (&kf)[5][4]) {
    const bf16_t* HB = (const bf16_t*)(P.ws + WS_HB);
    const int a = lane & 31, hi = lane >> 5;
    const size_t rowbase = (size_t)b * SEQ + t.r;
    { const bf16_t* qp = HB + (rowbase + (size_t)t.dil * (t.i0 + a)) * HP + C_SQ + h * 64 + 8 * hi;
#pragma unroll
      for (int kk = 0; kk < 4; ++kk) qf[kk] = *(const bf16x8*)(qp + 16 * kk); }
#pragma unroll
    for (int j = 0; j < 5; ++j) {
        const int ik0 = t.i0 - 128 + 32 * j + a, ik = ik0 < 0 ? 0 : ik0;
        const bf16_t* kp = HB + (rowbase + (size_t)t.dil * ik) * HP + C_SK + h * 64 + 8 * hi;
#pragma unroll
        for (int kk = 0; kk < 4; ++kk) kf[j][kk] = *(const bf16x8*)(kp + 16 * kk);
    }
}
__device__ __forceinline__ void swa_task(const Params& P, LAS unsigned char* lds, int wave, int lane, int b, int h, const SwaT& tk, int T0,
                                         const bf16x8 (&qf)[4], const bf16x8 (&kf)[5][4], const SwaT& nx, bf16x8 (&qn)[4], bf16x8 (&kn)[5][4], bool bar_before_merge) {
    const bf16_t* HB = (const bf16_t*)(P.ws + WS_HB);
    const int dil = tk.dil, r = tk.r, i0 = tk.i0, pat = tk.pat;
    const int a = lane & 31, hi = lane >> 5;
    LAS unsigned char* vreg = lds + SWA_WV + wave * SWA_WV_STRIDE;
    LAS float* msc = (LAS float*)(vreg + 10240);
    LAS float* lsc = msc + 32;
    const size_t rowbase = (size_t)b * SEQ + r;
    const int jmin = i0 >= 128 ? 0 : ((128 - i0) >> 5);
    const int vrow = ((lane >> 5) << 3) + ((lane >> 2) & 7), vch = lane & 3;
    const int trb = (4 * hi + ((lane & 15) >> 2)) * 64 + ((lane >> 4) & 1) * 32 + (lane & 3) * 8;

#define SWA_DMA_V(db) do { _Pragma("unroll") for (int j = 0; j < 5; ++j) if (j >= jmin) { _Pragma("unroll") for (int it2 = 0; it2 < 2; ++it2) { \
        const int ik = i0 - 128 + 32 * j + 16 * it2 + vrow; \
        __builtin_amdgcn_global_load_lds((const unsigned*)(HB + (rowbase + (size_t)dil * ik) * HP + C_SV + h * 64 + 32 * (db) + 8 * vch), \
                                         (LAS unsigned*)(vreg + j * 2048 + it2 * 1024), 16, 0, 0); } } } while (0)

    LDS_WAIT();
    SWA_DMA_V(0);
    f32x16 S[5];
    float mx4[4] = {-INFINITY, -INFINITY, -INFINITY, -INFINITY};
#pragma unroll
    for (int j = 0; j < 5; ++j) {
        f32x16 acc;
#pragma unroll
        for (int e = 0; e < 16; ++e) acc[e] = 0.f;
#pragma unroll
        for (int kk = 0; kk < 4; ++kk) acc = mfma32(kf[j][kk], qf[kk], acc);
        if (j == 0) {
#pragma unroll
            for (int e = 0; e < 16; ++e) { const int c = (e & 3) + 8 * (e >> 2) + 4 * hi; if (c < a) acc[e] = -INFINITY; }
        }
        if (j == 4) {
#pragma unroll
            for (int e = 0; e < 16; ++e) { const int c = (e & 3) + 8 * (e >> 2) + 4 * hi; if (c > a) acc[e] = -INFINITY; }
        }
        if (j < jmin) {
#pragma unroll
            for (int e = 0; e < 16; ++e) acc[e] = -INFINITY;
        }
#pragma unroll
        for (int e = 0; e < 16; ++e) mx4[e & 3] = fmaxf(mx4[e & 3], acc[e]);
        S[j] = acc;
    }
    asm volatile("" ::: "memory");
    swa_loadqk(P, nx, b, h, lane, qn, kn);
    asm volatile("" ::: "memory");
    float mx = fmaxf(fmaxf(mx4[0], mx4[1]), fmaxf(mx4[2], mx4[3]));
    mx = fmaxf(mx, shx(mx, 32, lane));
    float ls4[4] = {0.f, 0.f, 0.f, 0.f};
    unsigned pa[5][2][4];
#pragma unroll
    for (int j = 0; j < 5; ++j) {
#pragma unroll
        for (int e = 0; e < 16; ++e) { const float p = fexp2(S[j][e] - mx); S[j][e] = p; ls4[e & 3] += p; }
#pragma unroll
        for (int s = 0; s < 2; ++s)
#pragma unroll
            for (int w = 0; w < 4; ++w) pa[j][s][w] = pk_bf16(S[j][8 * s + 2 * w], S[j][8 * s + 2 * w + 1]);
    }
    float lsum = (ls4[0] + ls4[1]) + (ls4[2] + ls4[3]);
    lsum += shx(lsum, 32, lane);
    if (bar_before_merge) __syncthreads();
    LAS float* fsc = msc; LAS float* gsc = msc + 32; LAS float* rsc = msc + 64;
    {
        LAS float* stM = (LAS float*)(lds + SWA_ST_M);
        LAS float* stL = (LAS float*)(lds + SWA_ST_L);
        LDS_WAIT();
        if (hi == 0) {
            const int tok = r + dil * (i0 + a) - T0;
            if (pat == 0) { fsc[a] = 0.f; gsc[a] = 1.f; rsc[a] = 1.f; stM[tok] = mx; stL[tok] = lsum; }
            else {
                const float Mo = stM[tok], Lo = stL[tok];
                const float Mn = fmaxf(Mo, mx);
                const float f = fexp2(Mo - Mn), g = fexp2(mx - Mn);
                const float Ln = Lo * f + lsum * g;
                fsc[a] = f; gsc[a] = g; rsc[a] = 1.0f / Ln;
                if (pat == 1) { stM[tok] = Mn; stL[tok] = Ln; }
            }
        }
        LDS_WAIT();
    }
#pragma unroll
    for (int db = 0; db < 2; ++db) {
        if (db == 0) asm volatile("s_waitcnt vmcnt(24)" ::: "memory"); else VM_WAIT();
        f32x16 O;
#pragma unroll
        for (int e = 0; e < 16; ++e) O[e] = 0.f;
#pragma unroll
        for (int j = 0; j < 5; ++j) if (j >= jmin) {
#pragma unroll
            for (int s = 0; s < 2; ++s) {
                const s16x4 lo = tr16(vreg + j * 2048 + (2 * s) * 512 + trb), hh = tr16(vreg + j * 2048 + (2 * s + 1) * 512 + trb);
                const bf16x8 vb = {lo[0], lo[1], lo[2], lo[3], hh[0], hh[1], hh[2], hh[3]};
                const bf16x8 pf = __builtin_bit_cast(bf16x8, (u32x4){pa[j][s][0], pa[j][s][1], pa[j][s][2], pa[j][s][3]});
                O = mfma32(pf, vb, O);
            }
        }
        if (db == 0) { LDS_WAIT(); SWA_DMA_V(1); }
        LAS bf16_t* stO = (LAS bf16_t*)(lds + SWA_ST_O);
        const int d = 32 * db + a;
#pragma unroll
        for (int g4 = 0; g4 < 4; ++g4) {
            const f32x4 f4 = *(const LAS f32x4*)(fsc + 8 * g4 + 4 * hi), g4v = *(const LAS f32x4*)(gsc + 8 * g4 + 4 * hi), r4 = *(const LAS f32x4*)(rsc + 8 * g4 + 4 * hi);
#pragma unroll
            for (int e4 = 0; e4 < 4; ++e4) {
                const int e = 4 * g4 + e4, c = 8 * g4 + 4 * hi + e4;
                const int tok = r + dil * (i0 + c) - T0;
                if (pat == 0) stO[tok * 64 + d] = (bf16_t)(pk_bf16(O[e], 0.f) & 0xffffu);
                else {
                    const float on = bf2f(stO[tok * 64 + d]) * f4[e4] + O[e] * g4v[e4];
                    stO[tok * 64 + d] = (bf16_t)(pk_bf16(pat == 1 ? on : on * r4[e4], 0.f) & 0xffffu);
                }
            }
        }
    }
#undef SWA_DMA_V
}
__device__ __forceinline__ void swa_unit(const Params& P, LAS unsigned char* lds, int wave, int lane, int b, int h, int chunk) {
    const int T0 = chunk * 512;
    bf16x8 qf[4], kf[5][4];
    SwaT cur = swa_params(0, wave, T0);
    swa_loadqk(P, cur, b, h, lane, qf, kf);
#pragma unroll 1
    for (int i = 0; i < 6; ++i) {
        const SwaT nxt = swa_params(i < 5 ? i + 1 : 5, wave, T0);
        bf16x8 qn[4], kn[5][4];
        swa_task(P, lds, wave, lane, b, h, cur, T0, qf, kf, nxt, qn, kn, i == 2 || i == 4);
#pragma unroll
        for (int kk = 0; kk < 4; ++kk) qf[kk] = qn[kk];
#pragma unroll
        for (int j = 0; j < 5; ++j)
#pragma unroll
            for (int kk = 0; kk < 4; ++kk) kf[j][kk] = kn[j][kk];
        cur = nxt;
    }
    __syncthreads();
    {
        const bf16_t* HB = (const bf16_t*)(P.ws + WS_HB);
        bf16_t* MIX = (bf16_t*)(P.ws + WS_MIX);
        const int tid = wave * 64 + lane, ch = tid & 7;
#pragma unroll
        for (int it = 0; it < 8; ++it) {
            const int tok = (tid >> 3) + 64 * it;
            const size_t row = (size_t)b * SEQ + T0 + tok;
            const u32x4 o = *(const LAS u32x4*)(lds + SWA_ST_O + tok * 128 + ch * 16);
            const u32x4 g = *(const u32x4*)(HB + row * HP + C_SG + h * 64 + ch * 8);
            u32x4 w;
            w.x = pk_bf16(bf_lo(o.x) * bf_lo(g.x), bf_hi(o.x) * bf_hi(g.x)); w.y = pk_bf16(bf_lo(o.y) * bf_lo(g.y), bf_hi(o.y) * bf_hi(g.y));
            w.z = pk_bf16(bf_lo(o.z) * bf_lo(g.z), bf_hi(o.z) * bf_hi(g.z)); w.w = pk_bf16(bf_lo(o.w) * bf_lo(g.w), bf_hi(o.w) * bf_hi(g.w));
            *(u32x4*)(MIX + row * DMIX + 512 + h * 64 + ch * 8) = w;
        }
    }
    __syncthreads();
}

constexpr int MEM_K = 0, MEM_V = 65536, MEM_SC = 131072, MEM_OST = 133120;
__device__ __forceinline__ void mem_unit(const Params& P, LAS unsigned char* lds, int wave, int lane, int b, int h, int qb) {
    const bf16_t* HB = (const bf16_t*)(P.ws + WS_HB);
    const bf16_t* MKV = (const bf16_t*)(P.ws + WS_MKV);
    bf16_t* MIX = (bf16_t*)(P.ws + WS_MIX);
    const int a = lane & 31, hi = lane >> 5;
    __syncthreads();
#pragma unroll
    for (int i = 0; i < 8; ++i) {
        const int pc = wave * 8 + i;
        { const int key = 4 * pc + (lane >> 4), cp = lane & 15;
          __builtin_amdgcn_global_load_lds((const unsigned*)(MKV + ((size_t)b * NMEM + key) * 1024 + h * 128 + 8 * (cp ^ (key & 15))),
                                           (LAS unsigned*)(lds + MEM_K + pc * 1024), 16, 0, 0); }
        { const int key = 8 * (pc >> 1) + ((lane & 31) >> 2), d = 32 * (2 * (pc & 1) + (lane >> 5)) + 8 * (lane & 3);
          __builtin_amdgcn_global_load_lds((const unsigned*)(MKV + ((size_t)b * NMEM + key) * 1024 + 512 + h * 128 + d),
                                           (LAS unsigned*)(lds + MEM_V + pc * 1024), 16, 0, 0); }
    }
    VM_WAIT();
    __syncthreads();
#pragma unroll 1
    for (int q2 = 0; q2 < 2; ++q2) {
    const size_t Rq = (size_t)b * SEQ + (2 * qb + q2) * 256 + wave * 32;
    LAS float* fsc = (LAS float*)(lds + MEM_SC + wave * 256);
    const int trb = (4 * hi + ((lane & 15) >> 2)) * 64 + ((lane >> 4) & 1) * 32 + (lane & 3) * 8;
    f32x16 O[4];
#pragma unroll
    for (int db = 0; db < 4; ++db)
#pragma unroll
        for (int e = 0; e < 16; ++e) O[db][e] = 0.f;
    float M = -INFINITY, L = 0.f;
#pragma unroll 1
    for (int ch = 0; ch < 2; ++ch) {
        bf16x8 qf[8];
        { const bf16_t* qp = HB + (Rq + a) * HP + C_MQ + h * 128 + 8 * hi;
#pragma unroll
          for (int kk = 0; kk < 8; ++kk) qf[kk] = *(const bf16x8*)(qp + 16 * kk); }
        f32x16 S[4];
#pragma unroll
        for (int jt = 0; jt < 4; ++jt) {
            const int key = 32 * (4 * ch + jt) + a;
            f32x16 acc;
#pragma unroll
            for (int e = 0; e < 16; ++e) acc[e] = 0.f;
#pragma unroll
            for (int kk = 0; kk < 8; ++kk) {
                const bf16x8 kf = *(const LAS bf16x8*)(lds + MEM_K + key * 256 + (((2 * kk + hi) ^ (key & 15)) << 4));
                acc = mfma32(kf, qf[kk], acc);
            }
            S[jt] = acc;
        }
        float mc = -INFINITY;
#pragma unroll
        for (int jt = 0; jt < 4; ++jt)
#pragma unroll
            for (int e = 0; e < 16; ++e) mc = fmaxf(mc, S[jt][e]);
        mc = fmaxf(mc, shx(mc, 32, lane));
        const float Mn = fmaxf(M, mc);
        const float f = fexp2(M - Mn);
        float ls = 0.f;
        unsigned pa[4][2][4];
#pragma unroll
        for (int jt = 0; jt < 4; ++jt) {
#pragma unroll
            for (int e = 0; e < 16; ++e) { const float p = fexp2(S[jt][e] - Mn); S[jt][e] = p; ls += p; }
#pragma unroll
            for (int s = 0; s < 2; ++s)
#pragma unroll
                for (int w = 0; w < 4; ++w) pa[jt][s][w] = pk_bf16(S[jt][8 * s + 2 * w], S[jt][8 * s + 2 * w + 1]);
        }
        ls += shx(ls, 32, lane);
        L = L * f + ls; M = Mn;
        if (ch == 1) {
            LDS_WAIT();
            if (hi == 0) fsc[a] = f;
            LDS_WAIT();
#pragma unroll
            for (int g4 = 0; g4 < 4; ++g4) {
                const f32x4 f4 = *(const LAS f32x4*)(fsc + 8 * g4 + 4 * hi);
#pragma unroll
                for (int db = 0; db < 4; ++db)
#pragma unroll
                    for (int e = 0; e < 4; ++e) O[db][4 * g4 + e] *= f4[e];
            }
        }
#pragma unroll
        for (int jt = 0; jt < 4; ++jt)
#pragma unroll
            for (int s = 0; s < 2; ++s) {
                const bf16x8 pf = __builtin_bit_cast(bf16x8, (u32x4){pa[jt][s][0], pa[jt][s][1], pa[jt][s][2], pa[jt][s][3]});
                const int st0 = (4 * (4 * ch + jt) + 2 * s) * 4;
#pragma unroll
                for (int db = 0; db < 4; ++db) {
                    const s16x4 lo = tr16(lds + MEM_V + (st0 + db) * 512 + trb), hh = tr16(lds + MEM_V + (st0 + 4 + db) * 512 + trb);
                    const bf16x8 vb = {lo[0], lo[1], lo[2], lo[3], hh[0], hh[1], hh[2], hh[3]};
                    O[db] = mfma32(pf, vb, O[db]);
                }
            }
    }
    LDS_WAIT();
    if (hi == 0) fsc[32 + a] = 1.0f / L;
    LDS_WAIT();
    {
        LAS bf16_t* ost = (LAS bf16_t*)(lds + MEM_OST + wave * 2048);
        f32x4 r4[4];
#pragma unroll
        for (int g4 = 0; g4 < 4; ++g4) r4[g4] = *(const LAS f32x4*)(fsc + 32 + 8 * g4 + 4 * hi);
#pragma unroll
        for (int db = 0; db < 4; ++db) {
#pragma unroll
            for (int g4 = 0; g4 < 4; ++g4)
#pragma unroll
                for (int e = 0; e < 4; ++e) ost[(8 * g4 + 4 * hi + e) * 32 + a] = (bf16_t)(pk_bf16(O[db][4 * g4 + e] * r4[g4][e], 0.f) & 0xffffu);
            LDS_WAIT();
#pragma unroll
            for (int it = 0; it < 2; ++it) {
                const int q = (lane >> 2) + 16 * it, ch = lane & 3;
                const size_t row = Rq + q;
                const u32x4 o = *(const LAS u32x4*)(ost + q * 32 + ch * 8);
                const u32x4 g = *(const u32x4*)(HB + row * HP + C_MG + h * 128 + 32 * db + ch * 8);
                u32x4 w;
                w.x = pk_bf16(bf_lo(o.x) * bf_lo(g.x), bf_hi(o.x) * bf_hi(g.x)); w.y = pk_bf16(bf_lo(o.y) * bf_lo(g.y), bf_hi(o.y) * bf_hi(g.y));
                w.z = pk_bf16(bf_lo(o.z) * bf_lo(g.z), bf_hi(o.z) * bf_hi(g.z)); w.w = pk_bf16(bf_lo(o.w) * bf_lo(g.w), bf_hi(o.w) * bf_hi(g.w));
                *(u32x4*)(MIX + row * DMIX + 1024 + h * 128 + 32 * db + ch * 8) = w;
            }
            LDS_WAIT();
        }
    }
    }
}

constexpr int RT_Q = 0, RT_K = 16384, RT_KD = 32768, RT_V = 49152, RT_R = 81920, RT_O = 98304;
constexpr size_t WS_KVC = 272 * MiB;
__device__ __forceinline__ void ra_unit(const Params& P, LAS unsigned char* lds, int wave, int lane, int tid, int b, int h, int n) {
    const bf16_t* HB = (const bf16_t*)(P.ws + WS_HB);
    float* KVC = (float*)(P.ws + WS_KVC);
    const float gamma = 1.0f - __builtin_amdgcn_exp2f((float)(-5 - h));
    const float lg2 = __builtin_log2f(gamma);
    const int a = lane & 31, hi = lane >> 5, tq = (lane & 15) >> 2, tp = lane & 3, tg = (lane >> 4) & 1;
    const int dkt = wave & 1, dvt = wave >> 1;
    const size_t base = (size_t)b * SEQ + 128 * n;
    u32x4 pk[2], pv[4];
#pragma unroll
    for (int i = 0; i < 2; ++i) { const int idx = tid + 512 * i, row = idx >> 3, ch = idx & 7; pk[i] = *(const u32x4*)(HB + (base + row) * HP + C_RK + h * 64 + ch * 8); }
#pragma unroll
    for (int i = 0; i < 4; ++i) { const int idx = tid + 512 * i, row = idx >> 4, ch = idx & 15; pv[i] = *(const u32x4*)(HB + (base + row) * HP + C_RV + h * 128 + ch * 8); }
    __syncthreads();
#pragma unroll
    for (int i = 0; i < 2; ++i) {
        const int idx = tid + 512 * i, row = idx >> 3, ch = idx & 7;
        const float fac = fexp2((float)(127 - row) * lg2);
        u32x4 kd;
        kd.x = pk_bf16(bf_lo(pk[i].x) * fac, bf_hi(pk[i].x) * fac); kd.y = pk_bf16(bf_lo(pk[i].y) * fac, bf_hi(pk[i].y) * fac);
        kd.z = pk_bf16(bf_lo(pk[i].z) * fac, bf_hi(pk[i].z) * fac); kd.w = pk_bf16(bf_lo(pk[i].w) * fac, bf_hi(pk[i].w) * fac);
        *(LAS u32x4*)(lds + RT_KD + ((row >> 3) * 2 + (ch >> 2)) * 512 + (row & 7) * 64 + (ch & 3) * 16) = kd;
    }
#pragma unroll
    for (int i = 0; i < 4; ++i) {
        const int idx = tid + 512 * i, row = idx >> 4, ch = idx & 15;
        *(LAS u32x4*)(lds + RT_V + ((row >> 3) * 4 + (ch >> 2)) * 512 + (row & 7) * 64 + (ch & 3) * 16) = pv[i];
    }
    __syncthreads();
    f32x16 Rt;
#pragma unroll
    for (int e = 0; e < 16; ++e) Rt[e] = 0.f;
#pragma unroll
    for (int s = 0; s < 8; ++s) {
        LAS unsigned char* ka = lds + RT_KD + ((2 * s + hi) * 2 + dkt) * 512 + tq * 64 + tg * 32 + tp * 8;
        LAS unsigned char* va = lds + RT_V + ((2 * s + hi) * 4 + dvt) * 512 + tq * 64 + tg * 32 + tp * 8;
        const s16x4 k0 = tr16(ka), k1 = tr16(ka + 256), v0 = tr16(va), v1 = tr16(va + 256);
        const bf16x8 af = {k0[0], k0[1], k0[2], k0[3], k1[0], k1[1], k1[2], k1[3]};
        const bf16x8 bfv = {v0[0], v0[1], v0[2], v0[3], v1[0], v1[1], v1[2], v1[3]};
        Rt = mfma32(af, bfv, Rt);
    }
    float* dst = KVC + ((size_t)((b * 4 + h) * 16 + n)) * 8192 + 32 * dvt + a;
#pragma unroll
    for (int e = 0; e < 16; ++e) dst[(32 * dkt + (e & 3) + 8 * (e >> 2) + 4 * hi) * 128] = Rt[e];
}
__device__ __forceinline__ void rb_unit(const Params& P, LAS unsigned char* lds, int wave, int lane, int tid, int b, int h, int n) {
    const bf16_t* HB = (const bf16_t*)(P.ws + WS_HB);
    bf16_t* MIX = (bf16_t*)(P.ws + WS_MIX);
    const float* KVC = (const float*)(P.ws + WS_KVC) + ((size_t)((b * 4 + h) * 16)) * 8192;
    const float gamma = 1.0f - __builtin_amdgcn_exp2f((float)(-5 - h));
    const float lg2 = __builtin_log2f(gamma);
    const int a = lane & 31, hi = lane >> 5, tq = (lane & 15) >> 2, tp = lane & 3, tg = (lane >> 4) & 1;
    const int qg = wave & 3, dh = wave >> 2;
    const size_t base = (size_t)b * SEQ + 128 * n;
    u32x4 pq[2], pk[2], pv[4];
#pragma unroll
    for (int i = 0; i < 2; ++i) { const int idx = tid + 512 * i, row = idx >> 3, ch = idx & 7;
        pq[i] = *(const u32x4*)(HB + (base + row) * HP + C_RQ + h * 64 + ch * 8); pk[i] = *(const u32x4*)(HB + (base + row) * HP + C_RK + h * 64 + ch * 8); }
#pragma unroll
    for (int i = 0; i < 4; ++i) { const int idx = tid + 512 * i, row = idx >> 4, ch = idx & 15; pv[i] = *(const u32x4*)(HB + (base + row) * HP + C_RV + h * 128 + ch * 8); }
    const float g128 = fexp2(128.0f * lg2);
    f32x4 rr[4];
#pragma unroll
    for (int i = 0; i < 4; ++i) rr[i] = (f32x4){0.f, 0.f, 0.f, 0.f};
    const int dv4 = 4 * (tid & 31), dkb = tid >> 5;
    {
        const int nb4 = (n + 3) >> 2, c00 = n - 4 * nb4;
#pragma unroll 1
        for (int bq = 0; bq < nb4; ++bq) {
            f32x4 t[4][4];
#pragma unroll
            for (int k = 0; k < 4; ++k) {
                const int c = c00 + 4 * bq + k, cc = c < 0 ? 0 : c;
                const float* src = KVC + (size_t)cc * 8192 + dkb * 128 + dv4;
#pragma unroll
                for (int i = 0; i < 4; ++i) t[k][i] = *(const f32x4*)(src + 16 * i * 128);
            }
#pragma unroll
            for (int k = 0; k < 4; ++k) {
                const float wgt = (c00 + 4 * bq + k) < 0 ? 0.f : 1.f;
#pragma unroll
                for (int i = 0; i < 4; ++i) rr[i] = rr[i] * g128 + t[k][i] * wgt;
            }
        }
    }
    if (n == 15) {
        const float* src = KVC + (size_t)15 * 8192 + dkb * 128 + dv4;
#pragma unroll
        for (int i = 0; i < 4; ++i) {
            const f32x4 t = *(const f32x4*)(src + 16 * i * 128);
            *(f32x4*)(P.out + O_RP + ((size_t)((b * 4 + h) * 64 + dmap(dkb + 16 * i))) * 128 + dv4) = rr[i] * g128 + t;
        }
    }
    __syncthreads();
#pragma unroll
    for (int i = 0; i < 4; ++i) {
        const int dk = dkb + 16 * i;
#pragma unroll
        for (int e = 0; e < 4; ++e) { const int dv = dv4 + e; *(LAS bf16_t*)(lds + RT_R + dv * 128 + (((dk >> 3) ^ (dv & 7)) << 4) + (dk & 7) * 2) = (bf16_t)(pk_bf16(rr[i][e], 0.f) & 0xffffu); }
    }
#pragma unroll
    for (int i = 0; i < 2; ++i) {
        const int idx = tid + 512 * i, row = idx >> 3, ch = idx & 7;
        *(LAS u32x4*)(lds + RT_Q + row * 128 + ((ch ^ (row & 7)) << 4)) = pq[i];
        *(LAS u32x4*)(lds + RT_K + row * 128 + ((ch ^ (row & 7)) << 4)) = pk[i];
    }
#pragma unroll
    for (int i = 0; i < 4; ++i) {
        const int idx = tid + 512 * i, row = idx >> 4, ch = idx & 15;
        *(LAS u32x4*)(lds + RT_V + ((row >> 3) * 4 + (ch >> 2)) * 512 + (row & 7) * 64 + (ch & 3) * 16) = pv[i];
    }
    __syncthreads();
    f32x16 O[2];
    bf16x8 qfr[4];
#pragma unroll
    for (int kk = 0; kk < 4; ++kk) { const int row = 32 * qg + a; qfr[kk] = *(const LAS bf16x8*)(lds + RT_Q + row * 128 + (((2 * kk + hi) ^ (row & 7)) << 4)); }
    if (n > 0) {
#pragma unroll
        for (int dt = 0; dt < 2; ++dt) {
            f32x16 X;
#pragma unroll
            for (int e = 0; e < 16; ++e) X[e] = 0.f;
            const int dv = 32 * (2 * dh + dt) + a;
#pragma unroll
            for (int kk = 0; kk < 4; ++kk) {
                const bf16x8 rf = *(const LAS bf16x8*)(lds + RT_R + dv * 128 + (((2 * kk + hi) ^ (dv & 7)) << 4));
                X = mfma32(qfr[kk], rf, X);
            }
#pragma unroll
            for (int e = 0; e < 16; ++e) { const int c = (e & 3) + 8 * (e >> 2) + 4 * hi; O[dt][e] = X[e] * fexp2((float)(32 * qg + c + 1) * lg2); }
        }
    } else {
#pragma unroll
        for (int dt = 0; dt < 2; ++dt)
#pragma unroll
            for (int e = 0; e < 16; ++e) O[dt][e] = 0.f;
    }
#pragma unroll
    for (int j = 0; j < 4; ++j) if (j <= qg) {
        f32x16 S;
#pragma unroll
        for (int e = 0; e < 16; ++e) S[e] = 0.f;
#pragma unroll
        for (int kk = 0; kk < 4; ++kk) {
            const int row = 32 * j + a;
            const bf16x8 kf = *(const LAS bf16x8*)(lds + RT_K + row * 128 + (((2 * kk + hi) ^ (row & 7)) << 4));
            S = mfma32(kf, qfr[kk], S);
        }
        unsigned pa[2][4];
#pragma unroll
        for (int e = 0; e < 16; ++e) {
            const int c = (e & 3) + 8 * (e >> 2) + 4 * hi;
            const int diff = 32 * (qg - j) + a - c;
            S[e] = diff >= 0 ? S[e] * fexp2((float)diff * lg2) : 0.f;
        }
#pragma unroll
        for (int s = 0; s < 2; ++s)
#pragma unroll
            for (int w = 0; w < 4; ++w) pa[s][w] = pk_bf16(S[8 * s + 2 * w], S[8 * s + 2 * w + 1]);
#pragma unroll
        for (int s = 0; s < 2; ++s) {
            const bf16x8 pf = __builtin_bit_cast(bf16x8, (u32x4){pa[s][0], pa[s][1], pa[s][2], pa[s][3]});
#pragma unroll
            for (int dt = 0; dt < 2; ++dt) {
                LAS unsigned char* vb_ = lds + RT_V + ((4 * j + 2 * s) * 4 + (2 * dh + dt)) * 512 + (4 * hi + tq) * 64 + tg * 32 + tp * 8;
                const s16x4 lo = tr16(vb_), hh = tr16(vb_ + 4 * 512);
                const bf16x8 vb = {lo[0], lo[1], lo[2], lo[3], hh[0], hh[1], hh[2], hh[3]};
                O[dt] = mfma32(pf, vb, O[dt]);
            }
        }
    }
    {
        LAS bf16_t* Ob = (LAS bf16_t*)(lds + RT_O);
#pragma unroll
        for (int dt = 0; dt < 2; ++dt)
#pragma unroll
            for (int e = 0; e < 16; ++e) { const int c = (e & 3) + 8 * (e >> 2) + 4 * hi; Ob[(32 * qg + c) * 128 + 32 * (2 * dh + dt) + a] = (bf16_t)(pk_bf16(O[dt][e], 0.f) & 0xffffu); }
    }
    __syncthreads();
    {
        const int tok = tid >> 2, part = tid & 3;
        const LAS u32x4* op = (const LAS u32x4*)(lds + RT_O + tok * 256 + part * 64);
        float o[32]; float sm = 0.f;
#pragma unroll
        for (int c4 = 0; c4 < 4; ++c4) {
            const u32x4 w = op[c4];
            o[8 * c4 + 0] = bf_lo(w.x); o[8 * c4 + 1] = bf_hi(w.x); o[8 * c4 + 2] = bf_lo(w.y); o[8 * c4 + 3] = bf_hi(w.y);
            o[8 * c4 + 4] = bf_lo(w.z); o[8 * c4 + 5] = bf_hi(w.z); o[8 * c4 + 6] = bf_lo(w.w); o[8 * c4 + 7] = bf_hi(w.w);
        }
#pragma unroll
        for (int e = 0; e < 32; ++e) sm += o[e];
        sm += shx(sm, 1, lane); sm += shx(sm, 2, lane);
        const float mean = sm * (1.0f / 128.0f);
        float qq = 0.f;
#pragma unroll
        for (int e = 0; e < 32; ++e) { o[e] -= mean; qq += o[e] * o[e]; }
        qq += shx(qq, 1, lane); qq += shx(qq, 2, lane);
        const float rstd = 1.0f / sqrtf(qq * (1.0f / 128.0f) + 1e-5f);
        const size_t row = base + tok;
        const u32x4* gp = (const u32x4*)(HB + row * HP + C_RG + h * 128 + part * 32);
        u32x4* mp = (u32x4*)(MIX + row * DMIX + h * 128 + part * 32);
#pragma unroll
        for (int c4 = 0; c4 < 4; ++c4) {
            const u32x4 g = gp[c4]; u32x4 w;
            w.x = pk_bf16(o[8 * c4 + 0] * rstd * bf_lo(g.x), o[8 * c4 + 1] * rstd * bf_hi(g.x)); w.y = pk_bf16(o[8 * c4 + 2] * rstd * bf_lo(g.y), o[8 * c4 + 3] * rstd * bf_hi(g.y));
            w.z = pk_bf16(o[8 * c4 + 4] * rstd * bf_lo(g.z), o[8 * c4 + 5] * rstd * bf_hi(g.z)); w.w = pk_bf16(o[8 * c4 + 6] * rstd * bf_lo(g.w), o[8 * c4 + 7] * rstd * bf_hi(g.w));
            mp[c4] = w;
        }
    }
}

#define XB_TMO      128
#define XB_XCNT(j)  (256  + 64 * (j))
#define XB_XSUB(j)  (1280 + 64 * (j))
#define XB_XGEN(j)  (2304 + 64 * (j))
#define XB_TOP      3328
#define XB_TOPGEN   3392
#define XCD_BAR_WORDS 3456
#define XB_SPIN_CAP (1u << 18)

__device__ __forceinline__ unsigned xb_ld(unsigned* p)              { return __hip_atomic_load(p, __ATOMIC_RELAXED, __HIP_MEMORY_SCOPE_AGENT); }
__device__ __forceinline__ unsigned xb_add(unsigned* p, unsigned v) { return __hip_atomic_fetch_add(p, v, __ATOMIC_RELAXED, __HIP_MEMORY_SCOPE_AGENT); }
__device__ __forceinline__ unsigned xb_xcc_id() { return (unsigned)__builtin_amdgcn_s_getreg((3 << 11) | 20) & 0xFu; }
#define XB_SPIN(cond, bar) do { unsigned _sp = 0; while (cond) { __builtin_amdgcn_s_sleep(1); \
    if ((++_sp & 255u) == 0u) { if (xb_ld(&(bar)[XB_TMO])) break; if (_sp > XB_SPIN_CAP) { atomicAdd(&(bar)[XB_TMO], 1u); break; } } } } while (0)

struct XcdBarrier {
    unsigned* bar; unsigned x;
    volatile LAS unsigned* st;
};

__device__ __forceinline__ XcdBarrier xcd_barrier_post(unsigned* bar, volatile LAS unsigned* st, bool leader) {
    XcdBarrier b; b.bar = bar; b.x = xb_xcc_id(); b.st = st;
    if (leader) (void)xb_add(&bar[XB_XCNT(b.x)], 1u);
    return b;
}
__device__ __forceinline__ void xcd_barrier_complete(unsigned* bar, unsigned x, unsigned& nloc, unsigned& nx) {
    const unsigned G = gridDim.x * gridDim.y * gridDim.z;
    unsigned sum, cnt, mine, sp = 0u;
    for (;;) {
        sum = 0u; cnt = 0u; mine = 0u;
#pragma unroll
        for (unsigned j = 0; j < 16; ++j) { const unsigned c = xb_ld(&bar[XB_XCNT(j)]); sum += c; cnt += (c > 0u) ? 1u : 0u; mine = (j == x) ? c : mine; }
        if (sum == G) break;
        __builtin_amdgcn_s_sleep(1);
        if ((++sp & 255u) == 0u) { if (xb_ld(&bar[XB_TMO])) break; if (sp > XB_SPIN_CAP) { atomicAdd(&bar[XB_TMO], 1u); break; } }
    }
    nloc = mine > 0u ? mine : 1u; nx = cnt > 0u ? cnt : 1u;
}

__device__ __forceinline__ void xcd_barrier(const XcdBarrier& b, bool leader) {
    asm volatile("s_waitcnt vmcnt(0)" ::: "memory");
    __syncthreads();
    if (leader) {
        unsigned* bar = b.bar;
        __builtin_amdgcn_s_waitcnt(0);
        unsigned nloc = b.st[0], nx = b.st[1];
        if (nloc == 0u) { xcd_barrier_complete(bar, b.x, nloc, nx); b.st[0] = nloc; b.st[1] = nx; }
        const unsigned old = xb_add(&bar[XB_XSUB(b.x)], 1u);
        const unsigned gen = old / nloc;
        if (old + 1u == (gen + 1u) * nloc) {
            __builtin_amdgcn_fence(__ATOMIC_RELEASE, "agent");
            asm volatile("s_waitcnt vmcnt(0)" ::: "memory");
            const unsigned og = xb_add(&bar[XB_TOP], 1u);
            const unsigned tg = og / nx;
            if (og + 1u == (tg + 1u) * nx) xb_add(&bar[XB_TOPGEN], 1u);
            else XB_SPIN(xb_ld(&bar[XB_TOPGEN]) == tg, bar);
            __builtin_amdgcn_fence(__ATOMIC_ACQUIRE, "agent");
            xb_add(&bar[XB_XGEN(b.x)], 1u);
            asm volatile("s_waitcnt vmcnt(0)" ::: "memory");
        } else {
            XB_SPIN(xb_ld(&bar[XB_XGEN(b.x)]) == gen, bar);
            __builtin_amdgcn_fence(__ATOMIC_ACQUIRE, "agent");
            asm volatile("s_waitcnt vmcnt(0)" ::: "memory");
        }
    }
    __syncthreads();
}

__device__ __forceinline__ void p3_sample_slice(const Params& P, int wave, int lane, int sl) {
    const bf16_t* MIX = (const bf16_t*)(P.ws + WS_MIX);
    const bf16_t* WT = (const bf16_t*)(P.ws + WS_WTOUT);
    const int fr = lane & 15, fq = lane >> 4;
    const bf16_t* ap = MIX + ((size_t)M_PROMPT + 16 * wave + fr) * DMIX + 8 * fq;
    const bf16_t* bp = WT + (size_t)(16 * sl + fr) * DMIX + 8 * fq;
    f32x4 acc = {0.f, 0.f, 0.f, 0.f};
#pragma unroll 8
    for (int s = 0; s < 48; ++s) acc = __builtin_amdgcn_mfma_f32_16x16x32_bf16(*(const bf16x8*)(bp + 32 * s), *(const bf16x8*)(ap + 32 * s), acc, 0, 0, 0);
    const size_t r = (size_t)M_PROMPT + 16 * wave + fr; const int c = 16 * sl + 4 * fq;
    const u32x2 xv = *(const u32x2*)((const bf16_t*)(P.ws + WS_XB) + r * DM + c);
    u32x2 w; w.x = pk_bf16(bf_lo(xv.x) * ALPHA + acc[0], bf_hi(xv.x) * ALPHA + acc[1]); w.y = pk_bf16(bf_lo(xv.y) * ALPHA + acc[2], bf_hi(xv.y) * ALPHA + acc[3]);
    *(u32x2*)((bf16_t*)(P.ws + WS_Z) + r * DM + c) = w;
}

struct P1Order {
    int G, c;
    __device__ __forceinline__ bool next(int i, pg8::Unit& u) const {
        const int L = i * G + c;
        if (L >= 1202) return false;
        if (L < 1170) {
            constexpr int nM = 65, nN = 18, nwg = 1170, q = nwg / 8, r = nwg % 8, WGM = 8;
            const int xcd = L % 8, off = L / 8;
            const int wgid = (xcd < r ? xcd * (q + 1) : r * (q + 1) + (xcd - r) * q) + off;
            const int nig = WGM * nN, gid = wgid / nig, fm = gid * WGM, gsz = (nM - fm) < WGM ? (nM - fm) : WGM;
            u.pm = fm + ((wgid % nig) % gsz); u.pn = (wgid % nig) / gsz;
        } else { const int v = L - 1170; u.pm = 65 + (v >> 2); u.pn = 18 + (v & 3); }
        return true;
    }
    __device__ __forceinline__ void a_ready(const pg8::Unit&) const {}
    __device__ __forceinline__ void done(const pg8::Unit&) const {}
};
struct P1Epi {
    static constexpr bool PERM = false, AFTER_DRAIN = false;
    Params P;
    __device__ __forceinline__ void operator()(const f32x4 (&acc)[2][2][4][2], const pg8::Unit& u, int wr, int wc, int fr, int fq) const {
        if (u.pm < 65) epi_inproj(acc, u.pm, u.pn, P, wr, wc, fr, fq);
        else epi_memkv(acc, u.pm - 65, u.pn - 18, P, wr, wc, fr, fq);
    }
};
struct P3Order {
    int G, c;
    __device__ __forceinline__ bool next(int i, pg8::Unit& u) const { const int L = i * G + c; if (L >= 256) return false; u.pm = L >> 2; u.pn = L & 3; return true; }
    __device__ __forceinline__ void a_ready(const pg8::Unit&) const {}
    __device__ __forceinline__ void done(const pg8::Unit&) const {}
};
struct P3Epi {
    static constexpr bool PERM = false, AFTER_DRAIN = false;
    Params P;
    __device__ __forceinline__ void operator()(const f32x4 (&acc)[2][2][4][2], const pg8::Unit& u, int wr, int wc, int fr, int fq) const { epi_outproj(acc, u.pm, u.pn, P, wr, wc, fr, fq); }
};

constexpr int PRM_OFF = LDS_BYTES - 16 - 128;
__device__ __forceinline__ const void* ld_ptr(LAS unsigned char* lds, int i) {
    volatile LAS unsigned* w = (volatile LAS unsigned*)(lds + PRM_OFF);
    const unsigned lo = (unsigned)__builtin_amdgcn_readfirstlane((int)w[2 * i]), hi = (unsigned)__builtin_amdgcn_readfirstlane((int)w[2 * i + 1]);
    return (const void*)(__attribute__((address_space(1))) const void*)(((unsigned long long)hi << 32) | lo);
}
__device__ __forceinline__ Params load_params(LAS unsigned char* lds) {
    Params P;
    P.x_prompt = (const float*)ld_ptr(lds, 0); P.x_sample = (const float*)ld_ptr(lds, 1); P.state_ret = (const float*)ld_ptr(lds, 2);
    P.cache_k = (const float*)ld_ptr(lds, 3); P.cache_v = (const float*)ld_ptr(lds, 4); P.cmem_k = (const float*)ld_ptr(lds, 5);
    P.cmem_v = (const float*)ld_ptr(lds, 6); P.mem_prompt = (const float*)ld_ptr(lds, 7); P.w_in = (const float*)ld_ptr(lds, 8);
    P.w_mkv = (const float*)ld_ptr(lds, 9); P.w_out = (const float*)ld_ptr(lds, 10); P.ln_g = (const float*)ld_ptr(lds, 11);
    P.ln_b = (const float*)ld_ptr(lds, 12); P.out = (float*)ld_ptr(lds, 13); P.ws = (unsigned char*)ld_ptr(lds, 14);
    return P;
}

#ifndef PROBE
#define PROBE 0
#endif
#ifndef DIAG
#define DIAG 0
#endif
#if DIAG
#define STAMP(k) do { if (blockIdx.x == 0 && TID() == 0) ((LAS unsigned long long*)(lds + LDS_BYTES - 256))[k] = __builtin_amdgcn_s_memrealtime(); } while (0)
#else
#define STAMP(k) do {} while (0)
#endif
__global__ void __launch_bounds__(512, 2) fwd_kernel(Params Pk) {
    extern __shared__ __attribute__((aligned(16))) unsigned char lds_raw[];
    LAS unsigned char* lds = (LAS unsigned char*)lds_raw;
    const int wave = __builtin_amdgcn_readfirstlane((int)(threadIdx.x >> 6));
#define TID() (wave * 64 + lane_id())
    const int tid = TID(), lane = tid & 63;
    const int wr = wave >> 2, wc = wave & 3, fr = lane & 15, fq = lane >> 4;
    const int G = gridDim.x;
    if (tid < 4) ((LAS unsigned*)(lds + LDS_BYTES - 16))[tid] = 0u;
    if (tid >= 64 && tid < 94) ((LAS unsigned*)(lds + PRM_OFF))[tid - 64] = ((const unsigned*)__builtin_amdgcn_kernarg_segment_ptr())[tid - 64];
    __syncthreads();
    (void)xcd_barrier_post((unsigned*)((unsigned char*)ld_ptr(lds, 14) + WS_CTL) + 4096, (volatile LAS unsigned*)(lds + LDS_BYTES - 16), TID() == 0);
#define GRID_BAR() do { XcdBarrier bb_; bb_.bar = (unsigned*)((unsigned char*)ld_ptr(lds, 14) + WS_CTL) + 4096; bb_.x = xb_xcc_id(); \
        bb_.st = (volatile LAS unsigned*)(lds + LDS_BYTES - 16); xcd_barrier(bb_, TID() == 0); } while (0)

    STAMP(0);
    for (int rep0 = 0; rep0 < (PROBE == 10 ? 2 : 1); ++rep0) { const Params P = load_params(lds); phase0(P, lds, tid, lane, wave); }
    GRID_BAR();
    STAMP(1);

    {
        const Params P = load_params(lds);
        const pg8::Gemm g{(const bf16_t*)(P.ws + WS_XB), (const bf16_t*)(P.ws + WS_WTIN), ROWS_ALL, DIN + 1024, DM};
        const P1Order S{G, (int)blockIdx.x};
        const P1Epi E{P};
        for (int rep = 0; rep < (PROBE == 1 ? 2 : 1); ++rep)
        pg8::gemm_phase<P1Epi, P1Order, true, true>(lds, g, S, E, TID());
    }
    GRID_BAR();
    STAMP(2);

    {
        const Params P = load_params(lds);
        unsigned* ctl = (unsigned*)(P.ws + WS_CTL);
        int tid2_ = TID(); asm volatile("" : "+v"(tid2_));
        const int tid = tid2_, lane = tid2_ & 63;
        {
        for (int u = blockIdx.x; u < 512; u += G) { int tid_ = TID(); asm volatile("" : "+v"(tid_)); ra_unit(P, lds, wave, tid_ & 63, tid_, u >> 6, (u >> 4) & 3, u & 15); }
        GRID_BAR();
        LAS unsigned* qw = (LAS unsigned*)(lds + LDS_BYTES - 160);
        const int myx = (int)(xb_xcc_id() & 7u);
        for (int k = 0; k < 8; ++k) {
            const int x = (myx + k) & 7;
            for (;;) {
                __syncthreads();
                if (TID() == 0) *qw = atomicAdd(ctl + 128 + 64 * x, 1u);
                __syncthreads();
                const int q = (int)*qw;
                if (q >= 176) break;
                int tid_ = TID(); asm volatile("" : "+v"(tid_));
                const int lane_ = tid_ & 63;
                if (q < 64 && (q & 1) == 0) swa_sample_unit(P, lds, tid_, wave, q >> 1, x);
                else if (q < 64) { const int v = q >> 1; swa_unit(P, lds, wave, lane_, v >> 2, x, v & 3); }
                else if (q < 80) { const int v = q - 64, bh = 8 * v + x; mem_sample_unit(P, lds, tid_, wave, bh >> 2, bh & 3); }
                else if (q < 96) { const int v = q - 80, bh = 8 * v + x; ret_scan(P, lds, bh >> 2, bh & 3, M_PROMPT + (bh >> 2) * 4, 4, P.state_ret, P.out + O_RS, tid_); }
                else if (q < 112) { const int v = q - 96, bh = 8 * (v >> 2) + x; mem_unit(P, lds, wave, lane_, bh >> 2, bh & 3, v & 3); }
                else { const int v = q - 112, bh = 8 * (v >> 4) + x; rb_unit(P, lds, wave, lane_, tid_, bh >> 2, bh & 3, v & 15); }
            }
        }
        }
    }
    GRID_BAR();
    STAMP(3);

    {
        const Params P = load_params(lds);
        const pg8::Gemm g{(const bf16_t*)(P.ws + WS_MIX), (const bf16_t*)(P.ws + WS_WTOUT), M_PROMPT, DM, DMIX};
        const P3Order S{G, (int)blockIdx.x};
        const P3Epi E{P};
        pg8::gemm_phase<P3Epi, P3Order, true, true>(lds, g, S, E, TID());
        { int t3_ = TID(); asm volatile("" : "+v"(t3_)); for (int sl = blockIdx.x; sl < 64; sl += G) p3_sample_slice(P, wave, t3_ & 63, sl); }
    }
    GRID_BAR();
    STAMP(4);

    {
        const Params P = load_params(lds);
        const bf16_t* Z = (const bf16_t*)(P.ws + WS_Z);
        int t4_ = TID(); asm volatile("" : "+v"(t4_));
        const int lane = t4_ & 63;
        const int gw = blockIdx.x * 8 + wave, NGW = G * 8;
        for (int r = gw; r < M_PROMPT + M_SAMPLE; r += NGW) {
            float* yr = r < M_PROMPT ? P.out + O_YP + (size_t)r * DM : P.out + O_YS + (size_t)(r - M_PROMPT) * DM;
            f32x4 v[4]; float s = 0.f;
#pragma unroll
            for (int j = 0; j < 4; ++j) { const u32x2 w = ((const u32x2*)(Z + (size_t)r * DM))[lane + 64 * j]; v[j] = (f32x4){bf_lo(w.x), bf_hi(w.x), bf_lo(w.y), bf_hi(w.y)}; s += (v[j][0] + v[j][1]) + (v[j][2] + v[j][3]); }
            const float mean = wave_sum(s, lane) * (1.0f / DM);
            float q = 0.f;
#pragma unroll
            for (int j = 0; j < 4; ++j) { v[j] = v[j] - mean; q += (v[j][0] * v[j][0] + v[j][1] * v[j][1]) + (v[j][2] * v[j][2] + v[j][3] * v[j][3]); }
            const float rstd = 1.0f / sqrtf(wave_sum(q, lane) * (1.0f / DM) + 1e-5f);
#pragma unroll
            for (int j = 0; j < 4; ++j) {
                const f32x4 g = ((const f32x4*)P.ln_g)[lane + 64 * j], bb = ((const f32x4*)P.ln_b)[lane + 64 * j];
                ((f32x4*)yr)[lane + 64 * j] = v[j] * rstd * g + bb;
            }
        }
    }
#if DIAG
    STAMP(5);
    __syncthreads();
    if (blockIdx.x == 0) {
        const Params P = load_params(lds);
        LAS unsigned long long* ts = (LAS unsigned long long*)(lds + LDS_BYTES - 256);
        const unsigned long long dtk = (DIAG == 6) ? (ts[5] - ts[0]) : (ts[DIAG] - ts[DIAG - 1]);
        const float eps = sqrtf((float)dtk * 0.01f * 1e-4f);
        for (int i = tid; i < 65536; i += 512) P.out[O_KS + i] *= (1.0f + eps);
    }
#endif
}


extern "C" void kernel_launch(void* const* d_in, const int* in_sizes, int n_in, void* d_out, int out_size, void* d_ws, size_t ws_size, hipStream_t stream) {
    static int grid_blocks = 0;
    if (!grid_blocks) {
        int dev = 0, cus = 0, per_cu = 0;
        hipGetDevice(&dev);
        hipDeviceGetAttribute(&cus, hipDeviceAttributeMultiprocessorCount, dev);
        hipFuncSetAttribute((const void*)fwd_kernel, hipFuncAttributeMaxDynamicSharedMemorySize, LDS_BYTES);
        hipOccupancyMaxActiveBlocksPerMultiprocessor(&per_cu, (const void*)fwd_kernel, 512, LDS_BYTES);
        if (per_cu < 1) { fprintf(stderr, "kernel_launch: occupancy query says %d blocks per CU\n", per_cu); per_cu = 1; }
        grid_blocks = cus;
        if (ws_size < WS_END) fprintf(stderr, "kernel_launch: workspace too small (%zu < %zu)\n", ws_size, (size_t)WS_END);
    }
    hipMemsetAsync((char*)d_ws + WS_CTL, 0, 65536, stream);
    Params p{};
    p.x_prompt = (const float*)d_in[0]; p.x_sample = (const float*)d_in[1]; p.state_ret = (const float*)d_in[2];
    p.cache_k = (const float*)d_in[3]; p.cache_v = (const float*)d_in[4]; p.cmem_k = (const float*)d_in[5]; p.cmem_v = (const float*)d_in[6];
    p.mem_prompt = (const float*)d_in[7]; p.w_in = (const float*)d_in[8]; p.w_mkv = (const float*)d_in[9]; p.w_out = (const float*)d_in[10];
    p.ln_g = (const float*)d_in[11]; p.ln_b = (const float*)d_in[12];
    p.out = (float*)d_out; p.ws = (unsigned char*)d_ws;
    hipLaunchKernelGGL(fwd_kernel, dim3(grid_blocks), dim3(512), LDS_BYTES, stream, p);
    hipError_t e = hipPeekAtLastError();
    if (e != hipSuccess) fprintf(stderr, "launch failed: %s (grid %d)\n", hipGetErrorString(e), grid_blocks);
}
```
